# Optimizing an MI355X kernel written in HIP

```python
import math
import jax, jax.numpy as jnp
from jax import lax
import numpy as np

D_MODEL = 1024
BATCH = 32
SEQ = 256
DEPTH = 4
DEC_BATCH = 4
DEC_SEQ = 4096
PAST_LEN = 256

GRID_W = 64
N_EVEN = (DEPTH + 1) // 2
N_ODD = DEPTH // 2
BRANCH = D_MODEL // 2
GLA_HEADS = 4
GLA_DK = BRANCH // (2 * GLA_HEADS)
GLA_DV = BRANCH // GLA_HEADS
GLA_RANK = 16
GLA_GATE_NORM = 16.0
GLA_CHUNK = 64
S5_GROUP = 16
S5_GROUPS = BRANCH // S5_GROUP
S5_STATE = 64
ATT_HEADS = 8
ATT_KV_HEADS = 2
ATT_GROUPS = ATT_HEADS // ATT_KV_HEADS
ATT_HD = BRANCH // ATT_HEADS
WINDOW = 128
BLK = 128
ROPE_BASE = 10000.0
CONV_W = 3
EPS = 1e-6
NEG = -1e30

E_SIZES = (GLA_HEADS * GLA_DK, GLA_HEADS * GLA_DK, BRANCH, GLA_RANK, GLA_RANK, BRANCH, BRANCH, BRANCH)
E_IN = sum(E_SIZES)
O_SIZES = (BRANCH, ATT_KV_HEADS * ATT_HD, ATT_KV_HEADS * ATT_HD, BRANCH, BRANCH, BRANCH, BRANCH, BRANCH)
O_IN = sum(O_SIZES)

kernel_name = "hybrid_gla_s5_swa_conv_diffusion_step"


def split_cols(x, sizes):
    out, start = [], 0
    for s in sizes:
        out.append(x[..., start:start + s])
        start += s
    return out


def rmsnorm(x, w):
    xf = x.astype(jnp.float32)
    y = xf * lax.rsqrt(jnp.mean(xf * xf, axis=-1, keepdims=True) + EPS) * w.astype(jnp.float32)
    return y.astype(x.dtype)


def adaln(cvec, w, b):
    return (jax.nn.silu(cvec) @ w + b)[:, None, :]


def modulate(x, norm_w, mod):
    shift, scale, gate = jnp.split(mod, 3, axis=-1)
    h = rmsnorm(x, norm_w) * (1.0 + scale) + shift
    return h, gate


def _rotate(x, ang):
    nf = ang.shape[-1]
    cos, sin = jnp.cos(ang), jnp.sin(ang)
    x1, x2 = x[..., :nf], x[..., nf:]
    return jnp.concatenate([x1 * cos - x2 * sin, x2 * cos + x1 * sin], axis=-1)


def rope_axial(x):
    L, d = x.shape[-2], x.shape[-1]
    rows = L // GRID_W
    row = jnp.repeat(jnp.arange(rows), GRID_W).astype(jnp.float32)
    col = jnp.tile(jnp.arange(GRID_W), rows).astype(jnp.float32)
    nf = d // 4
    freq = ROPE_BASE ** (-jnp.arange(nf, dtype=jnp.float32) / nf)
    xf = x.astype(jnp.float32)
    half = d // 2
    out = jnp.concatenate([_rotate(xf[..., :half], row[:, None] * freq),
                           _rotate(xf[..., half:], col[:, None] * freq)], axis=-1)
    return out.astype(x.dtype)


def gla_chunked(q, k, v, g, s0):
    Bsz, H, L, dk = q.shape
    dv = v.shape[-1]
    n = L // GLA_CHUNK

    def chunks(t):
        return t.astype(jnp.float32).reshape(Bsz, H, n, GLA_CHUNK, t.shape[-1]).transpose(2, 0, 1, 3, 4)

    causal = jnp.tril(jnp.ones((GLA_CHUNK, GLA_CHUNK), dtype=bool))[:, :, None]

    def step(S, inp):
        qc, kc, vc, gc = inp
        b = jnp.cumsum(gc, axis=2)
        o_inter = jnp.einsum('bhcd,bhde->bhce', qc * jnp.exp(b), S)
        diff = b[:, :, :, None, :] - b[:, :, None, :, :]
        decay = jnp.where(causal, jnp.exp(jnp.where(causal, diff, 0.0)), 0.0)
        att = jnp.einsum('bhid,bhjd,bhijd->bhij', qc, kc, decay)
        o = o_inter + jnp.einsum('bhij,bhje->bhie', att, vc)
        b_last = b[:, :, -1:, :]
        S_new = jnp.exp(b_last)[:, :, 0, :, None] * S + jnp.einsum('bhcd,bhce->bhde', kc * jnp.exp(b_last - b), vc)
        return S_new, o

    S, o = lax.scan(step, s0.astype(jnp.float32), (chunks(q), chunks(k), chunks(v), chunks(g)))
    o = o.transpose(1, 2, 0, 3, 4).reshape(Bsz, H, L, dv)
    return o, S


def gla_bidir(q, k, v, gf, gb, s0f, s0b):
    o_f, s_f = gla_chunked(q, k, v, gf, s0f)
    fl = lambda t: jnp.flip(t, axis=2)
    o_b, s_b = gla_chunked(fl(q), fl(k), fl(v), fl(gb), s0b)
    return o_f + fl(o_b), s_f, s_b


def s5_scan(u, lam_re, lam_im, log_dt, b_re, b_im, h0_re, h0_im):
    dt = jnp.exp(log_dt.astype(jnp.float32))[:, None]
    lam_re = lam_re.astype(jnp.float32)
    lam_im = lam_im.astype(jnp.float32)
    mag = jnp.exp(lam_re * dt)
    lb_re, lb_im = mag * jnp.cos(lam_im * dt), mag * jnp.sin(lam_im * dt)
    den = lam_re * lam_re + lam_im * lam_im
    nr, ni = lb_re - 1.0, lb_im
    cr = (nr * lam_re + ni * lam_im) / den
    ci = (ni * lam_re - nr * lam_im) / den
    b_re = b_re.astype(jnp.float32)
    b_im = b_im.astype(jnp.float32)
    bb_re = cr[..., None] * b_re - ci[..., None] * b_im
    bb_im = cr[..., None] * b_im + ci[..., None] * b_re
    bu_re = jnp.einsum('blgh,gph->blgp', u, bb_re)
    bu_im = jnp.einsum('blgh,gph->blgp', u, bb_im)
    h0_re = h0_re.astype(jnp.float32)
    h0_im = h0_im.astype(jnp.float32)
    bu_re = bu_re.at[:, 0].add(lb_re * h0_re - lb_im * h0_im)
    bu_im = bu_im.at[:, 0].add(lb_re * h0_im + lb_im * h0_re)
    a_re = jnp.broadcast_to(lb_re, bu_re.shape)
    a_im = jnp.broadcast_to(lb_im, bu_im.shape)

    def combine(e1, e2):
        ar1, ai1, br1, bi1 = e1
        ar2, ai2, br2, bi2 = e2
        return (ar2 * ar1 - ai2 * ai1, ar2 * ai1 + ai2 * ar1,
                ar2 * br1 - ai2 * bi1 + br2, ar2 * bi1 + ai2 * br1 + bi2)

    _, _, h_re, h_im = lax.associative_scan(combine, (a_re, a_im, bu_re, bu_im), axis=1)
    return h_re, h_im


def even_mixer(h, w_in, w_out, gla_w2, gla_b2, gla_onorm, lam_re, lam_im, log_dt, b_re, b_im,
               c_re, c_im, s5_d, w_glu, b_glu, gla_s0, s5_h0_re, s5_h0_im):
    Bsz, L, _ = h.shape
    q, k, v, lf, lb, z_gla, u, z_s5 = split_cols(h @ w_in, E_SIZES)
    heads = lambda t, d: t.reshape(Bsz, L, GLA_HEADS, d).transpose(0, 2, 1, 3)
    q = heads(q, GLA_DK) * (GLA_DK ** -0.5)
    k = heads(k, GLA_DK)
    v = heads(v, GLA_DV)
    gate = lambda lr, d: heads(jax.nn.log_sigmoid(lr.astype(jnp.float32) @ gla_w2[d].astype(jnp.float32)
                                                  + gla_b2[d].astype(jnp.float32)) / GLA_GATE_NORM, GLA_DK)
    o, s_f, s_b = gla_bidir(q, k, v, gate(lf, 0), gate(lb, 1), gla_s0[:, 0], gla_s0[:, 1])
    o = rmsnorm(o, gla_onorm).transpose(0, 2, 1, 3).reshape(Bsz, L, BRANCH)
    y_gla = o.astype(h.dtype) * jax.nn.silu(z_gla)

    uf = u.astype(jnp.float32)
    ug = uf.reshape(Bsz, L, S5_GROUPS, S5_GROUP)
    hf_re, hf_im = s5_scan(ug, lam_re[0], lam_im[0], log_dt[0], b_re, b_im, s5_h0_re[:, 0], s5_h0_im[:, 0])
    hb_re, hb_im = s5_scan(jnp.flip(ug, axis=1), lam_re[1], lam_im[1], log_dt[1], b_re, b_im,
                           s5_h0_re[:, 1], s5_h0_im[:, 1])
    last_re = jnp.stack([hf_re[:, -1], hb_re[:, -1]], axis=1)
    last_im = jnp.stack([hf_im[:, -1], hb_im[:, -1]], axis=1)
    h_re = hf_re + jnp.flip(hb_re, axis=1)
    h_im = hf_im + jnp.flip(hb_im, axis=1)
    y5 = (jnp.einsum('blgp,ghp->blgh', h_re, c_re.astype(jnp.float32))
          - jnp.einsum('blgp,ghp->blgh', h_im, c_im.astype(jnp.float32))).reshape(Bsz, L, BRANCH)
    y5 = y5 + s5_d.astype(jnp.float32) * uf
    z = jax.nn.gelu(y5)
    y5 = z * jax.nn.sigmoid(z @ w_glu.astype(jnp.float32) + b_glu.astype(jnp.float32))
    y_s5 = y5.astype(h.dtype) * jax.nn.silu(z_s5)

    out = jnp.concatenate([y_gla, y_s5], axis=-1) @ w_out
    return out, jnp.stack([s_f, s_b], axis=1), last_re, last_im


def _attend(qblk, key_sets, sink):
    qf = qblk.astype(jnp.float32) * (ATT_HD ** -0.5)
    scores = []
    for kk, vv, mask in key_sets:
        s = jnp.einsum('bkgqd,bksd->bkgqs', qf, kk.astype(jnp.float32))
        if mask is not None:
            s = jnp.where(mask, s, NEG)
        scores.append(s)
    s_sink = jnp.broadcast_to(sink.astype(jnp.float32).reshape(1, ATT_KV_HEADS, ATT_GROUPS, 1, 1),
                              scores[0].shape[:-1] + (1,))
    p = jax.nn.softmax(jnp.concatenate(scores + [s_sink], axis=-1), axis=-1)
    out, off = 0.0, 0
    for (kk, vv, _), s in zip(key_sets, scores):
        n = s.shape[-1]
        out = out + jnp.einsum('bkgqs,bksd->bkgqd', p[..., off:off + n], vv.astype(jnp.float32))
        off += n
    return out


def ctx_attention(q, k, v, sink):
    Bsz, Hk, G, L, d = q.shape
    nb = L // BLK
    qb = q.reshape(Bsz, Hk, G, nb, BLK, d).transpose(3, 0, 1, 2, 4, 5)
    o = lax.map(lambda qblk: _attend(qblk, [(k, v, None)], sink), qb)
    return o.transpose(1, 2, 3, 0, 4, 5).reshape(Bsz, Hk, G, L, d)


def latent_attention(q, k, v, k_ctx, v_ctx, sink):
    Bsz, Hk, G, L, d = q.shape
    nb = L // BLK
    kp = jnp.pad(k, ((0, 0), (0, 0), (BLK, BLK), (0, 0)))
    vp = jnp.pad(v, ((0, 0), (0, 0), (BLK, BLK), (0, 0)))
    qi = jnp.arange(BLK)[:, None]
    kj = jnp.arange(3 * BLK)[None, :]
    band = jnp.abs(kj - BLK - qi) <= WINDOW

    def one(n):
        start = n * BLK
        qblk = lax.dynamic_slice_in_dim(q, start, BLK, axis=3)
        kw = lax.dynamic_slice_in_dim(kp, start, 3 * BLK, axis=2)
        vw = lax.dynamic_slice_in_dim(vp, start, 3 * BLK, axis=2)
        kpos = start - BLK + kj
        mask = band & (kpos >= 0) & (kpos < L)
        return _attend(qblk, [(kw, vw, mask), (k_ctx, v_ctx, None)], sink)

    o = lax.map(one, jnp.arange(nb))
    return o.transpose(1, 2, 3, 0, 4, 5).reshape(Bsz, Hk, G, L, d)


def short_conv(x, w, b):
    xp = jnp.pad(x, ((0, 0), (1, 1), (0, 0)))
    return xp[:, :-2] * w[0] + xp[:, 1:-1] * w[1] + xp[:, 2:] * w[2] + b


def odd_mixer(h, w_in, w_out, q_norm_w, k_norm_w, sink, conv_w, conv_b, k_ctx=None, v_ctx=None):
    Bsz, L, _ = h.shape
    q, k, v, z_att, xc, bg, cg, z_conv = split_cols(h @ w_in, O_SIZES)
    q = rmsnorm(q.reshape(Bsz, L, ATT_KV_HEADS, ATT_GROUPS, ATT_HD), q_norm_w).transpose(0, 2, 3, 1, 4)
    k = rmsnorm(k.reshape(Bsz, L, ATT_KV_HEADS, ATT_HD), k_norm_w).transpose(0, 2, 1, 3)
    v = v.reshape(Bsz, L, ATT_KV_HEADS, ATT_HD).transpose(0, 2, 1, 3)
    if k_ctx is None:
        o = ctx_attention(q, k, v, sink)
    else:
        o = latent_attention(rope_axial(q), rope_axial(k), v, k_ctx, v_ctx, sink)
    o = o.transpose(0, 3, 1, 2, 4).reshape(Bsz, L, BRANCH).astype(h.dtype)
    y_att = o * jax.nn.silu(z_att)
    y_conv = bg * short_conv(cg * xc, conv_w, conv_b) * jax.nn.silu(z_conv)
    out = jnp.concatenate([y_att, y_conv], axis=-1) @ w_out
    return out, k, v


def setup_inputs(seed: int = 0) -> dict:
    key = jax.random.key(seed)
    ks = iter(jax.random.split(key, 48))
    nrm = lambda shape, s: jax.random.normal(next(ks), shape, jnp.float32) * s
    lam_im = jnp.pi * jnp.arange(S5_STATE, dtype=jnp.float32)
    return {
        "x_prompt": nrm((BATCH, SEQ, D_MODEL), 1.0),
        "x_sample": nrm((DEC_BATCH, DEC_SEQ, D_MODEL), 1.0),
        "c": nrm((DEC_BATCH, D_MODEL), 1.0),
        "state_gla": nrm((DEC_BATCH, N_EVEN, 2, GLA_HEADS, GLA_DK, GLA_DV), 1.0),
        "state_s5_re": nrm((DEC_BATCH, N_EVEN, 2, S5_GROUPS, S5_STATE), 1.0),
        "state_s5_im": nrm((DEC_BATCH, N_EVEN, 2, S5_GROUPS, S5_STATE), 1.0),
        "cache_k": nrm((DEC_BATCH, N_ODD, ATT_KV_HEADS, PAST_LEN, ATT_HD), 1.0),
        "cache_v": nrm((DEC_BATCH, N_ODD, ATT_KV_HEADS, PAST_LEN, ATT_HD), 1.0),
        "c_ctx": nrm((D_MODEL,), 1.0),
        "norm_w": 1.0 + nrm((DEPTH, D_MODEL), 0.02),
        "w_ada": nrm((DEPTH, D_MODEL, 3 * D_MODEL), 0.5 * D_MODEL ** -0.5),
        "b_ada": nrm((DEPTH, 3 * D_MODEL), 0.01),
        "w_in_e": nrm((N_EVEN, D_MODEL, E_IN), D_MODEL ** -0.5),
        "w_out_e": nrm((N_EVEN, 2 * BRANCH, D_MODEL), (2 * BRANCH) ** -0.5),
        "gla_w2": nrm((N_EVEN, 2, GLA_RANK, GLA_HEADS * GLA_DK), GLA_RANK ** -0.5),
        "gla_b2": nrm((N_EVEN, 2, GLA_HEADS * GLA_DK), 0.01),
        "gla_onorm": 1.0 + nrm((N_EVEN, GLA_DV), 0.02),
        "s5_lam_re": -0.5 + nrm((N_EVEN, 2, S5_GROUPS, S5_STATE), 0.01),
        "s5_lam_im": lam_im + nrm((N_EVEN, 2, S5_GROUPS, S5_STATE), 0.01),
        "s5_log_dt": jax.random.uniform(next(ks), (N_EVEN, 2, S5_GROUPS), jnp.float32,
                                        minval=math.log(1e-3), maxval=math.log(1e-1)),
        "s5_b_re": nrm((N_EVEN, S5_GROUPS, S5_STATE, S5_GROUP), (2 * S5_GROUP) ** -0.5),
        "s5_b_im": nrm((N_EVEN, S5_GROUPS, S5_STATE, S5_GROUP), (2 * S5_GROUP) ** -0.5),
        "s5_c_re": nrm((N_EVEN, S5_GROUPS, S5_GROUP, S5_STATE), (2 * S5_STATE) ** -0.5),
        "s5_c_im": nrm((N_EVEN, S5_GROUPS, S5_GROUP, S5_STATE), (2 * S5_STATE) ** -0.5),
        "s5_d": nrm((N_EVEN, BRANCH), 0.5),
        "s5_w_glu": nrm((N_EVEN, BRANCH, BRANCH), BRANCH ** -0.5),
        "s5_b_glu": nrm((N_EVEN, BRANCH), 0.01),
        "w_in_o": nrm((N_ODD, D_MODEL, O_IN), D_MODEL ** -0.5),
        "w_out_o": nrm((N_ODD, 2 * BRANCH, D_MODEL), (2 * BRANCH) ** -0.5),
        "q_norm_w": 1.0 + nrm((N_ODD, ATT_HD), 0.02),
        "k_norm_w": 1.0 + nrm((N_ODD, ATT_HD), 0.02),
        "sink": nrm((N_ODD, ATT_HEADS), 1.0),
        "conv_w": nrm((N_ODD, CONV_W, BRANCH), CONV_W ** -0.5),
        "conv_b": nrm((N_ODD, BRANCH), 0.01),
    }


def reference(x_prompt, x_sample, c, state_gla, state_s5_re, state_s5_im, cache_k, cache_v,
              c_ctx, norm_w, w_ada, b_ada, w_in_e, w_out_e, gla_w2, gla_b2, gla_onorm,
              s5_lam_re, s5_lam_im, s5_log_dt, s5_b_re, s5_b_im, s5_c_re, s5_c_im, s5_d,
              s5_w_glu, s5_b_glu, w_in_o, w_out_o, q_norm_w, k_norm_w, sink, conv_w, conv_b):
    xp, xs = x_prompt, x_sample
    bp = x_prompt.shape[0]
    new_gla, new_s5_re, new_s5_im, new_k, new_v = [], [], [], [], []
    for l in range(DEPTH):
        e = l // 2
        mod_ctx = adaln(c_ctx[None, :], w_ada[l], b_ada[l])
        mod_lat = adaln(c, w_ada[l], b_ada[l])
        hp, gp = modulate(xp, norm_w[l], mod_ctx)
        hs, gs = modulate(xs, norm_w[l], mod_lat)
        if l % 2 == 0:
            ep = (w_in_e[e], w_out_e[e], gla_w2[e], gla_b2[e], gla_onorm[e], s5_lam_re[e], s5_lam_im[e],
                  s5_log_dt[e], s5_b_re[e], s5_b_im[e], s5_c_re[e], s5_c_im[e], s5_d[e], s5_w_glu[e], s5_b_glu[e])
            z_gla = jnp.zeros((bp, 2, GLA_HEADS, GLA_DK, GLA_DV), jnp.float32)
            z_s5 = jnp.zeros((bp, 2, S5_GROUPS, S5_STATE), jnp.float32)
            op, sg, sr, si = even_mixer(hp, *ep, z_gla, z_s5, z_s5)
            os_, _, _, _ = even_mixer(hs, *ep, state_gla[:, e], state_s5_re[:, e], state_s5_im[:, e])
            new_gla.append(sg)
            new_s5_re.append(sr)
            new_s5_im.append(si)
        else:
            op_params = (w_in_o[e], w_out_o[e], q_norm_w[e], k_norm_w[e], sink[e], conv_w[e], conv_b[e])
            op, kc, vc = odd_mixer(hp, *op_params)
            os_, _, _ = odd_mixer(hs, *op_params, k_ctx=cache_k[:, e], v_ctx=cache_v[:, e])
            new_k.append(kc)
            new_v.append(vc)
        xp = xp + gp * op
        xs = xs + gs * os_
    new_state_gla = jnp.stack(new_gla, axis=1)
    new_state_s5_re = jnp.stack(new_s5_re, axis=1)
    new_state_s5_im = jnp.stack(new_s5_im, axis=1)
    new_cache_k = jnp.stack(new_k, axis=1)
    new_cache_v = jnp.stack(new_v, axis=1)
    return (xp, xs, new_state_gla, new_state_s5_re, new_state_s5_im, new_cache_k, new_cache_v)
```

```cpp
#include <hip/hip_runtime.h>
#include <hip/hip_cooperative_groups.h>
#include <cstdio>
namespace cg = cooperative_groups;

typedef unsigned short bf16_t;
using bf16x8 = __attribute__((ext_vector_type(8))) short;
using s16x4  = __attribute__((ext_vector_type(4))) short;
using f32x16 = __attribute__((ext_vector_type(16))) float;
#define DI __device__ __forceinline__

#define NTOK    24576
#define NTOK_P  8192
#define DM      1024
#define LDP_E   2688
#define LDP_O   3328
#define EPSF    1e-6f

#define PE_Q   0
#define PE_K   256
#define PE_V   512
#define PE_ZG  1024
#define PE_U   1536
#define PE_ZS  2048
#define PE_LF  2560
#define PO_Q   0
#define PO_K   512
#define PO_V   640
#define PO_ZA  768
#define PO_XC  1280
#define PO_BG  1792
#define PO_CG  2304
#define PO_ZC  2816

#define OUT_GLA  25165824
#define OUT_S5R  29360128
#define OUT_S5I  29622272
#define OUT_CK   29884416
#define OUT_CV   31981568

#define OFF_WIN   0ull
#define OFF_WOUT  6815744ull
#define OFF_WGLU  8912896ull
#define OFF_MOD   9437184ull
#define OFF_LB    9682944ull
#define OFF_LB256 (OFF_LB + 65536ull)
#define OFF_BBT   (OFF_LB256 + 65536ull)
#define OFF_CM    (OFF_BBT + 524288ull)
#define OFF_ROPE  (OFF_CM + 524288ull)
#define OFF_S5ES  (OFF_ROPE + 8192ull)
#define OFF_GLAL  (OFF_S5ES + 2097152ull)
#define OFF_GLAD  (OFF_GLAL + 16777216ull)
#define OFF_HY    (OFF_GLAD + 131072ull)
#define OFF_P     (OFF_HY + 50331648ull)
#define OFF_Z5    (OFF_P + 132120576ull)
#define OFF_BAR   (OFF_P + 163577856ull)
#define WS_NEED   (OFF_BAR + 16384ull)

#define SMEM_BYTES 80896

struct Params {
  const float* in[34];
  float* out;
  char* ws;
};

enum { I_XP = 0, I_XS, I_C, I_SGLA, I_S5R, I_S5I, I_CK, I_CV, I_CCTX, I_NORMW, I_WADA, I_BADA, I_WINE, I_WOUTE,
       I_GW2, I_GB2, I_GON, I_LAMR, I_LAMI, I_LOGDT, I_BRE, I_BIM, I_CRE, I_CIM, I_S5D, I_WGLU, I_BGLU,
       I_WINO, I_WOUTO, I_QNW, I_KNW, I_SINK, I_CONVW, I_CONVB };

DI int otid() { int t = threadIdx.x; asm volatile("" : "+v"(t)); return t; }
typedef __bf16 hbf16x2 __attribute__((ext_vector_type(2)));
typedef float hf32x2 __attribute__((ext_vector_type(2)));
DI unsigned pack2(float a, float b) { hf32x2 v = {a, b}; return __builtin_bit_cast(unsigned, __builtin_convertvector(v, hbf16x2)); }
DI bf16_t f2bf(float x) { return (bf16_t)(pack2(x, x) & 0xffffu); }
DI float bf2f(bf16_t b) { return __uint_as_float(((unsigned)b) << 16); }
DI float siluf(float x) { return x * __builtin_amdgcn_rcpf(1.f + __expf(-x)); }
DI float sigmf(float x) { return __builtin_amdgcn_rcpf(1.f + __expf(-x)); }
DI int crow(int q, int h) { return (q & 3) + 8 * (q >> 2) + 4 * h; }
DI f32x16 mfma(bf16x8 a, bf16x8 b, f32x16 c) { return __builtin_amdgcn_mfma_f32_32x32x16_bf16(a, b, c, 0, 0, 0); }
DI f32x16 zero16() { f32x16 z; for (int i = 0; i < 16; ++i) z[i] = 0.f; return z; }

template <int K>
DI void mma_tile(f32x16& acc, const bf16_t* A, int lda, const bf16_t* Bt, int ldb, int lane) {
  const int r = lane & 31, h = lane >> 5;
#pragma unroll
  for (int s = 0; s < K / 16; ++s) {
    bf16x8 a = *(const bf16x8*)(A + r * lda + s * 16 + h * 8);
    bf16x8 b = *(const bf16x8*)(Bt + r * ldb + s * 16 + h * 8);
    acc = mfma(a, b, acc);
  }
}

#define XB_TMO      128
#define XB_XCNT(j)  (256  + 64 * (j))
#define XB_XSUB(j)  (1280 + 64 * (j))
#define XB_XGEN(j)  (2304 + 64 * (j))
#define XB_TOP      3328
#define XB_TOPGEN   3392
#define XCD_BAR_WORDS 3456
#define XB_SPIN_CAP (1u << 18)
#define LAS __attribute__((address_space(3)))

__device__ __forceinline__ unsigned xb_ld(unsigned* p)              { return __hip_atomic_load(p, __ATOMIC_RELAXED, __HIP_MEMORY_SCOPE_AGENT); }
__device__ __forceinline__ unsigned xb_add(unsigned* p, unsigned v) { return __hip_atomic_fetch_add(p, v, __ATOMIC_RELAXED, __HIP_MEMORY_SCOPE_AGENT); }
__device__ __forceinline__ unsigned xb_xcc_id() { return (unsigned)__builtin_amdgcn_s_getreg((3 << 11) | 20) & 0xFu; }
#define XB_SPIN(cond, bar) do { unsigned _sp = 0; while (cond) { __builtin_amdgcn_s_sleep(1); \
    if ((++_sp & 255u) == 0u) { if (xb_ld(&(bar)[XB_TMO])) break; if (_sp > XB_SPIN_CAP) { atomicAdd(&(bar)[XB_TMO], 1u); break; } } } } while (0)

struct XcdBarrier {
    unsigned* bar; unsigned x;
    volatile LAS unsigned* st;
};

__device__ __forceinline__ XcdBarrier xcd_barrier_post(unsigned* bar, volatile LAS unsigned* st) {
    XcdBarrier b; b.bar = bar; b.x = xb_xcc_id(); b.st = st;
    if (threadIdx.x == 0) (void)xb_add(&bar[XB_XCNT(b.x)], 1u);
    return b;
}
__device__ __forceinline__ void xcd_barrier_complete(unsigned* bar, unsigned x, unsigned& nloc, unsigned& nx) {
    const unsigned G = gridDim.x * gridDim.y * gridDim.z;
    unsigned sum, cnt, mine, sp = 0u;
    for (;;) {
        sum = 0u; cnt = 0u; mine = 0u;
#pragma unroll
        for (unsigned j = 0; j < 16; ++j) { const unsigned c = xb_ld(&bar[XB_XCNT(j)]); sum += c; cnt += (c > 0u) ? 1u : 0u; mine = (j == x) ? c : mine; }
        if (sum == G) break;
        __builtin_amdgcn_s_sleep(1);
        if ((++sp & 255u) == 0u) { if (xb_ld(&bar[XB_TMO])) break; if (sp > XB_SPIN_CAP) { atomicAdd(&bar[XB_TMO], 1u); break; } }
    }
    nloc = mine > 0u ? mine : 1u; nx = cnt > 0u ? cnt : 1u;
}

__device__ __forceinline__ void xcd_barrier(const XcdBarrier& b) {
    asm volatile("s_waitcnt vmcnt(0)" ::: "memory");
    __syncthreads();
    if (threadIdx.x == 0) {
        unsigned* bar = b.bar;
        __builtin_amdgcn_s_waitcnt(0);
        unsigned nloc = b.st[0], nx = b.st[1];
        if (nloc == 0u) { xcd_barrier_complete(bar, b.x, nloc, nx); b.st[0] = nloc; b.st[1] = nx; }
        const unsigned old = xb_add(&bar[XB_XSUB(b.x)], 1u);
        const unsigned gen = old / nloc;
        if (old + 1u == (gen + 1u) * nloc) {
            __builtin_amdgcn_fence(__ATOMIC_RELEASE, "agent");
            asm volatile("s_waitcnt vmcnt(0)" ::: "memory");
            const unsigned og = xb_add(&bar[XB_TOP], 1u);
            const unsigned tg = og / nx;
            if (og + 1u == (tg + 1u) * nx) xb_add(&bar[XB_TOPGEN], 1u);
            else XB_SPIN(xb_ld(&bar[XB_TOPGEN]) == tg, bar);
            __builtin_amdgcn_fence(__ATOMIC_ACQUIRE, "agent");
            xb_add(&bar[XB_XGEN(b.x)], 1u);
            asm volatile("s_waitcnt vmcnt(0)" ::: "memory");
        } else {
            XB_SPIN(xb_ld(&bar[XB_XGEN(b.x)]) == gen, bar);
            __builtin_amdgcn_fence(__ATOMIC_ACQUIRE, "agent");
            asm volatile("s_waitcnt vmcnt(0)" ::: "memory");
        }
    }
    __syncthreads();
}


DI void phase0(const Params& p, char* smem) {
  const int tid = otid();
  float* sc = (float*)smem;
  float* red = sc + 5 * 1024;
  float* MOD = (float*)(p.ws + OFF_MOD);
  const int NU = 384 + 128 + 1;
  for (int u = blockIdx.x; u < NU; u += gridDim.x) {
    if (u < 384) {
      const int l = u / 96, nc = u % 96;
      __syncthreads();
      for (int i = tid; i < 5 * 1024; i += 256) {
        int j = i >> 10, k = i & 1023;
        float v = (j == 0) ? p.in[I_CCTX][k] : p.in[I_C][(j - 1) * 1024 + k];
        sc[i] = v / (1.f + expf(-v));
      }
      __syncthreads();
      const int col = tid & 31, kg = tid >> 5;
      const float* w = p.in[I_WADA] + (size_t)l * 1024 * 3072 + nc * 32 + col;
      float a0 = 0, a1 = 0, a2 = 0, a3 = 0, a4 = 0;
#pragma unroll 16
      for (int k = kg; k < 1024; k += 8) {
        float wv = w[(size_t)k * 3072];
        a0 += sc[k] * wv; a1 += sc[1024 + k] * wv; a2 += sc[2048 + k] * wv; a3 += sc[3072 + k] * wv; a4 += sc[4096 + k] * wv;
      }
      red[(kg * 5 + 0) * 32 + col] = a0; red[(kg * 5 + 1) * 32 + col] = a1; red[(kg * 5 + 2) * 32 + col] = a2;
      red[(kg * 5 + 3) * 32 + col] = a3; red[(kg * 5 + 4) * 32 + col] = a4;
      __syncthreads();
      if (tid < 160) {
        int j = tid >> 5, c2 = tid & 31;
        float s = 0;
        for (int g = 0; g < 8; ++g) s += red[(g * 5 + j) * 32 + c2];
        int n = nc * 32 + c2;
        MOD[(l * 5 + j) * 3072 + n] = s + p.in[I_BADA][l * 3072 + n];
      }
    } else if (u < 384 + 128) {
      const int v = u - 384;
      const int e = v >> 6, dir = (v >> 5) & 1, g = v & 31;
      if (tid < 64) {
        const int pp = tid;
        const int idx = ((e * 2 + dir) * 32 + g) * 64 + pp;
        double dt = exp((double)p.in[I_LOGDT][(e * 2 + dir) * 32 + g]);
        double lr = (double)p.in[I_LAMR][idx], li = (double)p.in[I_LAMI][idx];
        double mag = exp(lr * dt);
        double ang = li * dt;
        double tw = 6.283185307179586476925286766559;
        double kq = rint(ang / tw);
        double ra = ang - kq * tw;
        double lbr = mag * cos(ra), lbi = mag * sin(ra);
        double den = lr * lr + li * li;
        double nr = lbr - 1.0, ni = lbi;
        double cr = (nr * lr + ni * li) / den, ci = (ni * lr - nr * li) / den;
        float* LB = (float*)(p.ws + OFF_LB);
        float* LB256 = (float*)(p.ws + OFF_LB256);
        LB[idx * 2] = (float)lbr; LB[idx * 2 + 1] = (float)lbi;
        double pr = lbr, pi = lbi;
        for (int i = 0; i < 8; ++i) { double t = pr * pr - pi * pi; pi = 2.0 * pr * pi; pr = t; }
        LB256[idx * 2] = (float)pr; LB256[idx * 2 + 1] = (float)pi;
        bf16_t* BBT = (bf16_t*)(p.ws + OFF_BBT) + (size_t)((e * 2 + dir) * 32 + g) * 128 * 16;
        const float* bre = p.in[I_BRE] + ((size_t)(e * 32 + g) * 64 + pp) * 16;
        const float* bim = p.in[I_BIM] + ((size_t)(e * 32 + g) * 64 + pp) * 16;
        for (int hh = 0; hh < 16; ++hh) {
          double br = bre[hh], bi = bim[hh];
          const int nre = (pp >> 5) * 64 + (pp & 31);
          BBT[nre * 16 + hh] = f2bf((float)(cr * br - ci * bi));
          BBT[(nre + 32) * 16 + hh] = f2bf((float)(cr * bi + ci * br));
        }
        if (dir == 0) {
          bf16_t* CM = (bf16_t*)(p.ws + OFF_CM) + (size_t)(e * 32 + g) * 32 * 128;
          for (int hh = 0; hh < 32; ++hh) {
            float cre = 0.f, cim = 0.f;
            if (hh < 16) {
              cre = p.in[I_CRE][((size_t)(e * 32 + g) * 16 + hh) * 64 + pp];
              cim = p.in[I_CIM][((size_t)(e * 32 + g) * 16 + hh) * 64 + pp];
            }
            CM[hh * 128 + 2 * pp] = f2bf(cre);
            CM[hh * 128 + 2 * pp + 1] = f2bf(-cim);
          }
        }
      }
    } else {
      float* RT = (float*)(p.ws + OFF_ROPE);
      for (int i = tid; i < 64 * 16; i += 256) {
        int pos = i >> 4, f = i & 15;
        double fr = exp(-(double)f / 16.0 * 9.2103403719761827360719658187375);
        double ang = (double)pos * fr;
        double tw = 6.283185307179586476925286766559;
        double ra = ang - rint(ang / tw) * tw;
        RT[i * 2] = (float)cos(ra); RT[i * 2 + 1] = (float)sin(ra);
      }
    }
  }
}

DI void convert_tile(const float* src, int nsrc, bf16_t* dst, int K, int n0, int k0, int mapmode, int tid) {
  const int n = n0 + (tid & 63), kq = tid >> 6;
  int sc = n;
  if (mapmode == 1) {
    if (n < 1024) sc = n;
    else if (n < 2560) sc = n + 32;
    else if (n < 2592) sc = n - 1536;
    else sc = -1;
  }
  unsigned w[8];
#pragma unroll
  for (int i = 0; i < 8; ++i) {
    int k = k0 + kq * 16 + 2 * i;
    float a = 0.f, b = 0.f;
    if (sc >= 0) { a = src[(size_t)k * nsrc + sc]; b = src[(size_t)(k + 1) * nsrc + sc]; }
    w[i] = pack2(a, b);
  }
  uint4* d = (uint4*)(dst + (size_t)n * K + k0 + kq * 16);
  d[0] = make_uint4(w[0], w[1], w[2], w[3]);
  d[1] = make_uint4(w[4], w[5], w[6], w[7]);
}

DI void phaseA(const Params& p, int l) {
  const int tid = otid();
  const int odd = l & 1, e = l >> 1;
  const int n_in = (odd ? 52 : 42) * 16;
  const int n_out = 256;
  const int n_glu = odd ? 0 : 64;
  const int n_norm = NTOK / 16;
  const int total = n_in + n_out + n_glu + n_norm;
  bf16_t* WIN = (bf16_t*)(p.ws + OFF_WIN);
  bf16_t* WOUT = (bf16_t*)(p.ws + OFF_WOUT);
  bf16_t* WGLU = (bf16_t*)(p.ws + OFF_WGLU);
  bf16_t* H = (bf16_t*)(p.ws + OFF_HY);
  const float* MOD = (const float*)(p.ws + OFF_MOD);
  for (int u = blockIdx.x; u < total; u += gridDim.x) {
    if (u < n_in) {
      int nt = u >> 4, kt = u & 15;
      if (odd) convert_tile(p.in[I_WINO] + (size_t)e * 1024 * 3328, 3328, WIN, 1024, nt * 64, kt * 64, 0, tid);
      else convert_tile(p.in[I_WINE] + (size_t)e * 1024 * 2592, 2592, WIN, 1024, nt * 64, kt * 64, 1, tid);
    } else if (u < n_in + n_out) {
      int v = u - n_in; int nt = v >> 4, kt = v & 15;
      const float* src = (odd ? p.in[I_WOUTO] : p.in[I_WOUTE]) + (size_t)e * 1024 * 1024;
      convert_tile(src, 1024, WOUT, 1024, nt * 64, kt * 64, 0, tid);
    } else if (u < n_in + n_out + n_glu) {
      int v = u - n_in - n_out; int nt = v >> 3, kt = v & 7;
      convert_tile(p.in[I_WGLU] + (size_t)e * 512 * 512, 512, WGLU, 512, nt * 64, kt * 64, 0, tid);
    } else {
      int v = u - n_in - n_out - n_glu;
      const int tok0 = v * 16 + (tid >> 6) * 4;
      const int lane = tid & 63;
      const float* x;
      if (l == 0) x = (tok0 < NTOK_P) ? p.in[I_XP] + (size_t)tok0 * DM : p.in[I_XS] + (size_t)(tok0 - NTOK_P) * DM;
      else x = p.out + (size_t)tok0 * DM;
      const int j = (tok0 < NTOK_P) ? 0 : 1 + ((tok0 - NTOK_P) >> 12);
      const float* mod = MOD + (l * 5 + j) * 3072;
      const float* nw = p.in[I_NORMW] + l * 1024;
      float4 xv[4][4];
#pragma unroll
      for (int rr = 0; rr < 4; ++rr)
#pragma unroll
        for (int i = 0; i < 4; ++i) xv[rr][i] = *(const float4*)(x + (size_t)rr * DM + lane * 4 + 256 * i);
      float rstd[4];
#pragma unroll
      for (int rr = 0; rr < 4; ++rr) {
        float ss = 0.f;
#pragma unroll
        for (int i = 0; i < 4; ++i) ss += xv[rr][i].x * xv[rr][i].x + xv[rr][i].y * xv[rr][i].y + xv[rr][i].z * xv[rr][i].z + xv[rr][i].w * xv[rr][i].w;
#pragma unroll
        for (int o = 32; o >= 1; o >>= 1) ss += __shfl_xor(ss, o);
        rstd[rr] = rsqrtf(ss * (1.f / 1024.f) + EPSF);
      }
#pragma unroll
      for (int i = 0; i < 4; ++i) {
        const int k = lane * 4 + 256 * i;
        float4 w4 = *(const float4*)(nw + k);
        float4 sh = *(const float4*)(mod + k);
        float4 scl = *(const float4*)(mod + 1024 + k);
        const float c0 = w4.x * (1.f + scl.x), c1 = w4.y * (1.f + scl.y), c2 = w4.z * (1.f + scl.z), c3 = w4.w * (1.f + scl.w);
#pragma unroll
        for (int rr = 0; rr < 4; ++rr) {
          float h0 = xv[rr][i].x * rstd[rr] * c0 + sh.x;
          float h1 = xv[rr][i].y * rstd[rr] * c1 + sh.y;
          float h2 = xv[rr][i].z * rstd[rr] * c2 + sh.z;
          float h3 = xv[rr][i].w * rstd[rr] * c3 + sh.w;
          *(uint2*)(H + (size_t)(tok0 + rr) * DM + k) = make_uint2(pack2(h0, h1), pack2(h2, h3));
        }
      }
    }
  }
}

#define GLD 72
enum { EPI_P = 0, EPI_RES = 1, EPI_GLU = 2 };

template <int EPI, int KT>
DI void gemm_phase(const Params& p, int l, const bf16_t* A, int lda, const bf16_t* Bt, int ldb,
                           int NT, int ldp, char* smem) {
  const int tid = otid(), lane = tid & 63, w = tid >> 6;
  const int r = lane & 31, h = lane >> 5;
  const int wm = w >> 1, wn = w & 1;
  bf16_t* As = (bf16_t*)smem;
  bf16_t* Bs = As + 2 * 128 * GLD;
  const int lr = tid >> 3, lc = (tid & 7) * 8;
  const int MT = NTOK / 128;
  const int total = MT * NT;
  const float* MOD = (const float*)(p.ws + OFF_MOD);
  const int nslot = gridDim.x >> 3;
  if (blockIdx.x >= (gridDim.x >> 1)) { __builtin_amdgcn_s_sleep(112); }
  for (int k = 0;; ++k) {
    const int t = ((blockIdx.x & 7) + 8 * k) * nslot + (blockIdx.x >> 3);
    if (t >= total) break;
    const int band = t / (8 * NT), rem = t - band * 8 * NT;
    const int nt = rem >> 3, mt = band * 8 + (rem & 7);
    const int m0 = mt * 128, n0 = nt * 128;
    const bf16_t* Ag = A + (size_t)(m0 + lr) * lda + lc;
    const bf16_t* Bg = Bt + (size_t)(n0 + lr) * ldb + lc;
    uint4 xa0, xa1, xa2, xa3, xb0, xb1, xb2, xb3;
    uint4 ya0, ya1, ya2, ya3, yb0, yb1, yb2, yb3;
#define GLOADS(S, KOFS) \
    S##a0 = *(const uint4*)(Ag + (KOFS)); S##a1 = *(const uint4*)(Ag + (size_t)32 * lda + (KOFS)); \
    S##a2 = *(const uint4*)(Ag + (size_t)64 * lda + (KOFS)); S##a3 = *(const uint4*)(Ag + (size_t)96 * lda + (KOFS)); \
    S##b0 = *(const uint4*)(Bg + (KOFS)); S##b1 = *(const uint4*)(Bg + (size_t)32 * ldb + (KOFS)); \
    S##b2 = *(const uint4*)(Bg + (size_t)64 * ldb + (KOFS)); S##b3 = *(const uint4*)(Bg + (size_t)96 * ldb + (KOFS));
#define LSTORES(S, ST) \
    *(uint4*)(As + (ST) * 128 * GLD + (lr) * GLD + lc) = S##a0; *(uint4*)(As + (ST) * 128 * GLD + (lr + 32) * GLD + lc) = S##a1; \
    *(uint4*)(As + (ST) * 128 * GLD + (lr + 64) * GLD + lc) = S##a2; *(uint4*)(As + (ST) * 128 * GLD + (lr + 96) * GLD + lc) = S##a3; \
    *(uint4*)(Bs + (ST) * 128 * GLD + (lr) * GLD + lc) = S##b0; *(uint4*)(Bs + (ST) * 128 * GLD + (lr + 32) * GLD + lc) = S##b1; \
    *(uint4*)(Bs + (ST) * 128 * GLD + (lr + 64) * GLD + lc) = S##b2; *(uint4*)(Bs + (ST) * 128 * GLD + (lr + 96) * GLD + lc) = S##b3;
    bf16x8 fa0[4], fa1[4], fb0[4], fb1[4];
#define FRAGS(ST) { \
      const bf16_t* as = As + (ST) * 128 * GLD + (wm * 64 + r) * GLD + h * 8; \
      const bf16_t* bs = Bs + (ST) * 128 * GLD + (wn * 64 + r) * GLD + h * 8; \
      _Pragma("unroll") for (int s = 0; s < 4; ++s) { \
        fa0[s] = *(const bf16x8*)(as + s * 16); \
        fb0[s] = *(const bf16x8*)(bs + s * 16); \
        fa1[s] = *(const bf16x8*)(as + 32 * GLD + s * 16); \
        fb1[s] = *(const bf16x8*)(bs + 32 * GLD + s * 16); \
      } \
      __builtin_amdgcn_sched_barrier(0); }
#define MFMAS() { \
      _Pragma("unroll") for (int s = 0; s < 4; ++s) { \
        acc00 = mfma(fa0[s], fb0[s], acc00); acc01 = mfma(fa0[s], fb1[s], acc01); \
        acc10 = mfma(fa1[s], fb0[s], acc10); acc11 = mfma(fa1[s], fb1[s], acc11); \
      } \
      _Pragma("unroll") for (int g = 0; g < 8; ++g) { \
        __builtin_amdgcn_sched_group_barrier(0x008, 2, 0); \
        __builtin_amdgcn_sched_group_barrier(0x200, 1, 0); \
        __builtin_amdgcn_sched_group_barrier(0x020, 1, 0); \
      } }
    GLOADS(x, 0)
    LSTORES(x, 0)
    GLOADS(x, 64)
    GLOADS(y, 128)
    __syncthreads();
    f32x16 acc00 = zero16(), acc01 = zero16(), acc10 = zero16(), acc11 = zero16();
#pragma unroll
    for (int kt = 0; kt < KT; kt += 2) {
      FRAGS(0)
      LSTORES(x, 1)
      if (kt + 3 < KT) { GLOADS(x, (kt + 3) * 64) }
      MFMAS()
      __syncthreads();
      __builtin_amdgcn_sched_barrier(0);
      FRAGS(1)
      if (kt + 2 < KT) { LSTORES(y, 0) }
      if (kt + 4 < KT) { GLOADS(y, (kt + 4) * 64) }
      MFMAS()
      __syncthreads();
      __builtin_amdgcn_sched_barrier(0);
    }
#undef FRAGS
#undef MFMAS
#undef GLOADS
#undef LSTORES
    {
      float* Cs = (float*)smem;
#pragma unroll
      for (int q = 0; q < 16; ++q) {
        const int rr = wm * 64 + crow(q, h), cc = wn * 64 + r;
        Cs[rr * 132 + cc] = acc00[q];
        Cs[rr * 132 + cc + 32] = acc01[q];
        Cs[(rr + 32) * 132 + cc] = acc10[q];
        Cs[(rr + 32) * 132 + cc + 32] = acc11[q];
      }
      __syncthreads();
      const int er = tid >> 4, ec = (tid & 15) * 8;
      const int jm = (m0 < NTOK_P) ? 0 : 1 + ((m0 - NTOK_P) >> 12);
#pragma unroll 2
      for (int ps = 0; ps < 8; ++ps) {
        const int row = ps * 16 + er;
        const float4 c0 = *(const float4*)(Cs + row * 132 + ec);
        const float4 c1 = *(const float4*)(Cs + row * 132 + ec + 4);
        const size_t grow = (size_t)(m0 + row);
        const int gcol = n0 + ec;
        if (EPI == EPI_P) {
          bf16_t* P = (bf16_t*)(p.ws + OFF_P);
          *(uint4*)(P + grow * ldp + gcol) = make_uint4(pack2(c0.x, c0.y), pack2(c0.z, c0.w), pack2(c1.x, c1.y), pack2(c1.z, c1.w));
        } else if (EPI == EPI_RES) {
          const float* gate = MOD + (l * 5 + jm) * 3072 + 2048 + gcol;
          const float* xsrc;
          if (l == 0) xsrc = (m0 < NTOK_P) ? p.in[I_XP] : p.in[I_XS] - (size_t)NTOK_P * DM;
          else xsrc = p.out;
          const float4 g0 = *(const float4*)gate, g1 = *(const float4*)(gate + 4);
          const float4 x0 = *(const float4*)(xsrc + grow * DM + gcol), x1 = *(const float4*)(xsrc + grow * DM + gcol + 4);
          float4 o0, o1;
          o0.x = x0.x + g0.x * c0.x; o0.y = x0.y + g0.y * c0.y; o0.z = x0.z + g0.z * c0.z; o0.w = x0.w + g0.w * c0.w;
          o1.x = x1.x + g1.x * c1.x; o1.y = x1.y + g1.y * c1.y; o1.z = x1.z + g1.z * c1.z; o1.w = x1.w + g1.w * c1.w;
          *(float4*)(p.out + grow * DM + gcol) = o0;
          *(float4*)(p.out + grow * DM + gcol + 4) = o1;
        } else {
          const bf16_t* P = (const bf16_t*)(p.ws + OFF_P);
          const bf16_t* Z5 = (const bf16_t*)(p.ws + OFF_Z5);
          bf16_t* Y = (bf16_t*)(p.ws + OFF_HY);
          const float* bglu = p.in[I_BGLU] + (l >> 1) * 512 + gcol;
          const float4 b0 = *(const float4*)bglu, b1 = *(const float4*)(bglu + 4);
          const uint4 zv = *(const uint4*)(Z5 + grow * 512 + gcol);
          const uint4 zs = *(const uint4*)(P + grow * LDP_E + PE_ZS + gcol);
#define GLU1(ZW, SW, CA, CB, BA, BB) pack2(__uint_as_float((ZW) << 16) * sigmf((CA) + (BA)) * siluf(__uint_as_float((SW) << 16)), \
                                           __uint_as_float((ZW) & 0xffff0000u) * sigmf((CB) + (BB)) * siluf(__uint_as_float((SW) & 0xffff0000u)))
          uint4 o;
          o.x = GLU1(zv.x, zs.x, c0.x, c0.y, b0.x, b0.y);
          o.y = GLU1(zv.y, zs.y, c0.z, c0.w, b0.z, b0.w);
          o.z = GLU1(zv.z, zs.z, c1.x, c1.y, b1.x, b1.y);
          o.w = GLU1(zv.w, zs.w, c1.z, c1.w, b1.z, b1.w);
#undef GLU1
          *(uint4*)(Y + grow * DM + 512 + gcol) = o;
        }
      }
      __syncthreads();
    }
  }
}

#define GL 72
struct GlaSmem {
  bf16_t Qd[64 * GL];
  bf16_t Kn[64 * GL];
  bf16_t KdT[64 * GL];
  bf16_t Att[64 * GL];
  bf16_t VT[128 * GL];
  bf16_t ST[128 * GL];
  float lfS[64 * 16];
  float qtot[4 * 64];
  float Dl[64];
  float Gtot[64];
};
#define OLD 132
static_assert(sizeof(GlaSmem) <= SMEM_BYTES, "GLA smem");

template <bool FULL>
DI void gla_sweep(const Params& p, int e, int hd, int dir, int tok0, f32x16 (&sacc)[2], GlaSmem& S) {
  const int tid = otid(), lane = tid & 63, w = tid >> 6;
  const int r = lane & 31, h = lane >> 5;
  const bf16_t* P = (const bf16_t*)(p.ws + OFF_P);
  bf16_t* Y = (bf16_t*)(p.ws + OFF_HY);
  const int tq = tid >> 6;
  if (tid < 64) S.Gtot[tid] = 0.f;
  unsigned w2p[8];
  float bias;
  {
    const int d0 = tid & 63;
#pragma unroll
    for (int i = 0; i < 8; ++i)
      w2p[i] = pack2(p.in[I_GW2][((size_t)(e * 2 + dir) * 16 + 2 * i) * 256 + hd * 64 + d0],
                     p.in[I_GW2][((size_t)(e * 2 + dir) * 16 + 2 * i + 1) * 256 + hd * 64 + d0]);
    bias = p.in[I_GB2][(e * 2 + dir) * 256 + hd * 64 + d0];
  }
  __syncthreads();
  if (FULL) {
#pragma unroll
    for (int ni = 0; ni < 2; ++ni)
#pragma unroll
      for (int q = 0; q < 16; ++q) S.ST[(w * 32 + crow(q, h)) * GL + ni * 32 + r] = f2bf(sacc[ni][q]);
  }
  uint4 pq0, pq1, pk0, pk1;
  bf16_t plf[4];
  pq0 = pq1 = pk0 = pk1 = make_uint4(0, 0, 0, 0);
  plf[0] = plf[1] = plf[2] = plf[3] = 0;
#pragma unroll 1
  for (int cc = 0; cc < 4; ++cc) {
    const int c = dir ? 3 - cc : cc;
    const int ct0 = tok0 + c * 64;
    const int tv = tid & 63, cgp = tid >> 6;
    uint4 v0, v1, v2, v3;
    {
      const bf16_t* vsrc = P + (size_t)(ct0 + tv) * LDP_E + PE_V + hd * 128 + cgp * 32;
      v0 = *(const uint4*)(vsrc); v1 = *(const uint4*)(vsrc + 8); v2 = *(const uint4*)(vsrc + 16); v3 = *(const uint4*)(vsrc + 24);
    }
    {
      const int row = tid >> 2, c8 = (tid & 3) * 16;
      if (cc == 0) {
        const bf16_t* src = P + (size_t)(ct0 + row) * LDP_E + hd * 64 + c8;
        pk0 = *(const uint4*)(src + PE_K); pk1 = *(const uint4*)(src + PE_K + 8);
        if (FULL) { pq0 = *(const uint4*)(src + PE_Q); pq1 = *(const uint4*)(src + PE_Q + 8); }
#pragma unroll
        for (int i = 0; i < 4; ++i) {
          int idx = tid + 256 * i; int t = idx >> 4, rr = idx & 15;
          plf[i] = P[(size_t)(ct0 + t) * LDP_E + PE_LF + dir * 16 + rr];
        }
      }
#pragma unroll
      for (int i = 0; i < 4; ++i) S.lfS[tid + 256 * i] = bf2f(plf[i]);
      *(uint4*)(S.Kn + row * GL + c8) = pk0; *(uint4*)(S.Kn + row * GL + c8 + 8) = pk1;
      if (FULL) { *(uint4*)(S.Qd + row * GL + c8) = pq0; *(uint4*)(S.Qd + row * GL + c8 + 8) = pq1; }
      if (cc < 3) {
        const int cn = dir ? 2 - cc : cc + 1;
        const int cn0 = tok0 + cn * 64;
        const bf16_t* src = P + (size_t)(cn0 + row) * LDP_E + hd * 64 + c8;
        pk0 = *(const uint4*)(src + PE_K); pk1 = *(const uint4*)(src + PE_K + 8);
        if (FULL) { pq0 = *(const uint4*)(src + PE_Q); pq1 = *(const uint4*)(src + PE_Q + 8); }
#pragma unroll
        for (int i = 0; i < 4; ++i) {
          int idx = tid + 256 * i; int t = idx >> 4, rr = idx & 15;
          plf[i] = P[(size_t)(cn0 + t) * LDP_E + PE_LF + dir * 16 + rr];
        }
      }
    }
    __syncthreads();
    const int d = tid & 63;
    float w2r[16];
#pragma unroll
    for (int i = 0; i < 8; ++i) { w2r[2 * i] = __uint_as_float(w2p[i] << 16); w2r[2 * i + 1] = __uint_as_float(w2p[i] & 0xffff0000u); }
    float g[16];
    float run = 0.f;
#pragma unroll
    for (int i = 0; i < 16; ++i) {
      int t = tq * 16 + i;
      float x = bias;
#pragma unroll
      for (int rr = 0; rr < 16; ++rr) x += S.lfS[t * 16 + rr] * w2r[rr];
      float ls = fminf(x, 0.f) - __logf(1.f + __expf(-fabsf(x)));
      g[i] = ls * (1.f / 16.f);
      run += g[i];
    }
    S.qtot[tq * 64 + d] = run;
    __syncthreads();
    float q0 = S.qtot[d], q1 = S.qtot[64 + d], q2 = S.qtot[128 + d], q3 = S.qtot[192 + d];
    const float total = q0 + q1 + q2 + q3;
    float off;
    if (dir == 0) off = (tq > 0 ? q0 : 0.f) + (tq > 1 ? q1 : 0.f) + (tq > 2 ? q2 : 0.f);
    else off = (tq < 1 ? q1 : 0.f) + (tq < 2 ? q2 : 0.f) + (tq < 3 ? q3 : 0.f);
    float b[16];
    if (dir == 0) {
      float a = off;
#pragma unroll
      for (int i = 0; i < 16; ++i) { a += g[i]; b[i] = a; }
    } else {
      float a = off;
#pragma unroll
      for (int i = 15; i >= 0; --i) { a += g[i]; b[i] = a; }
    }
    if (tq == 0) { S.Dl[d] = __expf(total); S.Gtot[d] += total; }
    {
      unsigned kd[8];
      float kprev = 0.f;
#pragma unroll
      for (int i = 0; i < 16; ++i) {
        int t = tq * 16 + i;
        float kv = bf2f(S.Kn[t * GL + d]);
        if (FULL) {
          float qv = bf2f(S.Qd[t * GL + d]);
          S.Qd[t * GL + d] = f2bf(qv * 0.125f * __expf(b[i]));
          S.Kn[t * GL + d] = f2bf(kv * __expf(-b[i]));
        }
        float kdv = kv * __expf(total - b[i]);
        if (i & 1) kd[i >> 1] = pack2(kprev, kdv); else kprev = kdv;
      }
      uint4* dst = (uint4*)(S.KdT + d * GL + tq * 16);
      dst[0] = make_uint4(kd[0], kd[1], kd[2], kd[3]);
      dst[1] = make_uint4(kd[4], kd[5], kd[6], kd[7]);
    }
    {
      bf16_t* vd = S.VT + (cgp * 32) * GL + tv;
#define VTW(VV, B) vd[((B) + 0) * GL] = (bf16_t)(VV.x & 0xffffu); vd[((B) + 1) * GL] = (bf16_t)(VV.x >> 16); \
                   vd[((B) + 2) * GL] = (bf16_t)(VV.y & 0xffffu); vd[((B) + 3) * GL] = (bf16_t)(VV.y >> 16); \
                   vd[((B) + 4) * GL] = (bf16_t)(VV.z & 0xffffu); vd[((B) + 5) * GL] = (bf16_t)(VV.z >> 16); \
                   vd[((B) + 6) * GL] = (bf16_t)(VV.w & 0xffffu); vd[((B) + 7) * GL] = (bf16_t)(VV.w >> 16);
      VTW(v0, 0) VTW(v1, 8) VTW(v2, 16) VTW(v3, 24)
#undef VTW
    }
    __syncthreads();
    const int mi = w >> 1;
    f32x16 oacc[2];
    bf16_t* orec = Y + (size_t)(ct0 + mi * 32 + h * 16 + (r >> 1)) * DM + hd * 128 + (w & 1) * 64 + (r & 1) * 16;
    uint4 of0 = make_uint4(0, 0, 0, 0), of1 = of0, of2 = of0, of3 = of0, zg0 = of0, zg1 = of0, zg2 = of0, zg3 = of0;
    if (FULL && dir) {
      of0 = *(const uint4*)(orec); of1 = *(const uint4*)(orec + 8);
      of2 = *(const uint4*)(orec + 32); of3 = *(const uint4*)(orec + 40);
      const bf16_t* zg = P + (size_t)(ct0 + (tid >> 2)) * LDP_E + PE_ZG + hd * 128 + (tid & 3) * 32;
      zg0 = *(const uint4*)(zg); zg1 = *(const uint4*)(zg + 8); zg2 = *(const uint4*)(zg + 16); zg3 = *(const uint4*)(zg + 24);
    }
    if (FULL) {
      const int ni = w & 1;
      const bool skip = dir ? (ni < mi) : (ni > mi);
      f32x16 a = zero16();
      if (!skip) mma_tile<64>(a, S.Qd + mi * 32 * GL, GL, S.Kn + ni * 32 * GL, GL, lane);
#pragma unroll
      for (int q = 0; q < 16; ++q) {
        int i = mi * 32 + crow(q, h), j = ni * 32 + r;
        bool keep = dir ? (j >= i) : (j <= i);
        S.Att[i * GL + j] = f2bf(keep ? a[q] : 0.f);
      }
#pragma unroll
      for (int jj = 0; jj < 2; ++jj) {
        int nj = (w & 1) * 2 + jj;
        oacc[jj] = zero16();
        mma_tile<64>(oacc[jj], S.Qd + mi * 32 * GL, GL, S.ST + nj * 32 * GL, GL, lane);
      }
      __syncthreads();
#pragma unroll
      for (int jj = 0; jj < 2; ++jj) {
        int nj = (w & 1) * 2 + jj;
        mma_tile<64>(oacc[jj], S.Att + mi * 32 * GL, GL, S.VT + nj * 32 * GL, GL, lane);
      }
    }
#pragma unroll
    for (int ni = 0; ni < 2; ++ni) {
      float dec = S.Dl[ni * 32 + r];
#pragma unroll
      for (int q = 0; q < 16; ++q) sacc[ni][q] *= dec;
      mma_tile<64>(sacc[ni], S.VT + w * 32 * GL, GL, S.KdT + ni * 32 * GL, GL, lane);
    }
    __syncthreads();
    if (FULL) {
#pragma unroll
      for (int ni = 0; ni < 2; ++ni)
#pragma unroll
        for (int q = 0; q < 16; ++q) S.ST[(w * 32 + crow(q, h)) * GL + ni * 32 + r] = f2bf(sacc[ni][q]);
      if (dir == 0) {
#pragma unroll
        for (int jj = 0; jj < 2; ++jj) {
          *(uint4*)(orec + jj * 32) = make_uint4(pack2(oacc[jj][0], oacc[jj][1]), pack2(oacc[jj][2], oacc[jj][3]), pack2(oacc[jj][4], oacc[jj][5]), pack2(oacc[jj][6], oacc[jj][7]));
          *(uint4*)(orec + jj * 32 + 8) = make_uint4(pack2(oacc[jj][8], oacc[jj][9]), pack2(oacc[jj][10], oacc[jj][11]), pack2(oacc[jj][12], oacc[jj][13]), pack2(oacc[jj][14], oacc[jj][15]));
        }
      } else {
        float* Ob = (float*)S.Qd;
        {
          const unsigned ofw[16] = {of0.x, of0.y, of0.z, of0.w, of1.x, of1.y, of1.z, of1.w, of2.x, of2.y, of2.z, of2.w, of3.x, of3.y, of3.z, of3.w};
#pragma unroll
          for (int jj = 0; jj < 2; ++jj) {
            int cl = ((w & 1) * 2 + jj) * 32 + r;
#pragma unroll
            for (int q = 0; q < 16; ++q) {
              int tl = mi * 32 + crow(q, h);
              const unsigned wv = ofw[jj * 8 + (q >> 1)];
              float prev = (q & 1) ? __uint_as_float(wv & 0xffff0000u) : __uint_as_float(wv << 16);
              Ob[tl * OLD + cl] = oacc[jj][q] + prev;
            }
          }
        }
        __syncthreads();
        {
          const int tl = tid >> 2, qtr = tid & 3;
          float ss = 0.f;
#pragma unroll
          for (int i = 0; i < 32; ++i) { float v = Ob[tl * OLD + qtr * 32 + i]; ss += v * v; }
          ss += __shfl_xor(ss, 1);
          ss += __shfl_xor(ss, 2);
          const float rstd = rsqrtf(ss * (1.f / 128.f) + EPSF);
          const float* onw = p.in[I_GON] + e * 128 + qtr * 32;
          bf16_t* yo = Y + (size_t)(ct0 + tl) * DM + hd * 128 + qtr * 32;
          const unsigned zgw[16] = {zg0.x, zg0.y, zg0.z, zg0.w, zg1.x, zg1.y, zg1.z, zg1.w, zg2.x, zg2.y, zg2.z, zg2.w, zg3.x, zg3.y, zg3.z, zg3.w};
#pragma unroll
          for (int i = 0; i < 32; i += 2) {
            unsigned zz = zgw[i >> 1];
            float y0 = Ob[tl * OLD + qtr * 32 + i] * rstd * onw[i] * siluf(__uint_as_float(zz << 16));
            float y1 = Ob[tl * OLD + qtr * 32 + i + 1] * rstd * onw[i + 1] * siluf(__uint_as_float(zz & 0xffff0000u));
            *(unsigned*)(yo + i) = pack2(y0, y1);
          }
        }
        __syncthreads();
      }
    }
  }
}

DI void gla_pass1_unit(const Params& p, int e, int u, char* smem) {
  GlaSmem& S = *(GlaSmem*)smem;
  const int tid = otid(), lane = tid & 63, w = tid >> 6;
  const int r = lane & 31, h = lane >> 5;
  const int seg = u >> 3, hd = (u >> 1) & 3, dir = u & 1;
  const int tok0 = NTOK_P + seg * 256;
  f32x16 sacc[2];
  sacc[0] = zero16(); sacc[1] = zero16();
  __syncthreads();
  gla_sweep<false>(p, e, hd, dir, tok0, sacc, S);
  float* L = (float*)(p.ws + OFF_GLAL) + (size_t)((seg * 4 + hd) * 2 + dir) * 8192;
#pragma unroll
  for (int ni = 0; ni < 2; ++ni)
#pragma unroll
    for (int q = 0; q < 16; ++q) L[(w * 32 + crow(q, h)) * 64 + ni * 32 + r] = sacc[ni][q];
  if (tid < 64) {
    float* D = (float*)(p.ws + OFF_GLAD) + ((seg * 4 + hd) * 2 + dir) * 64;
    D[tid] = expf(S.Gtot[tid]);
  }
  __syncthreads();
}

DI void gla_pass3_unit(const Params& p, int e, int u, char* smem) {
  GlaSmem& S = *(GlaSmem*)smem;
  const int tid = otid(), lane = tid & 63, w = tid >> 6;
  const int r = lane & 31, h = lane >> 5;
  const int seg = ((u >> 2) + 32) % 96, hd = u & 3;
  const int tok0 = seg * 256;
  const bool samp = seg >= 32;
  const int sb = samp ? (seg - 32) >> 4 : 0, sl = samp ? (seg - 32) & 15 : 0;
  const float* Lb = (const float*)(p.ws + OFF_GLAL);
  const float* Db = (const float*)(p.ws + OFF_GLAD);
  for (int dir = 0; dir < 2; ++dir) {
    f32x16 sacc[2];
    sacc[0] = zero16(); sacc[1] = zero16();
    if (samp) {
      const float* s0 = p.in[I_SGLA] + (size_t)(((sb * 2 + e) * 2 + dir) * 4 + hd) * 8192;
#pragma unroll
      for (int ni = 0; ni < 2; ++ni)
#pragma unroll
        for (int q = 0; q < 16; ++q) sacc[ni][q] = s0[(ni * 32 + r) * 128 + w * 32 + crow(q, h)];
      const int nst = dir ? 15 - sl : sl;
      float Lc[32], dc[2];
      {
        const int sp0 = dir ? 15 : 0;
        const int sidx0 = ((sb * 16 + sp0) * 4 + hd) * 2 + dir;
        const float* L0 = Lb + (size_t)sidx0 * 8192;
        const float* D0 = Db + sidx0 * 64;
#pragma unroll
        for (int ni = 0; ni < 2; ++ni) {
          dc[ni] = D0[ni * 32 + r];
#pragma unroll
          for (int q = 0; q < 16; ++q) Lc[ni * 16 + q] = L0[(w * 32 + crow(q, h)) * 64 + ni * 32 + r];
        }
      }
#pragma unroll 1
      for (int k = 0; k < nst; ++k) {
        float Ln[32], dn[2];
        const int kn = (k + 1 < nst) ? k + 1 : k;
        const int sp = dir ? 15 - kn : kn;
        const int sidx = ((sb * 16 + sp) * 4 + hd) * 2 + dir;
        const float* L = Lb + (size_t)sidx * 8192;
        const float* D = Db + sidx * 64;
#pragma unroll
        for (int ni = 0; ni < 2; ++ni) {
          dn[ni] = D[ni * 32 + r];
#pragma unroll
          for (int q = 0; q < 16; ++q) Ln[ni * 16 + q] = L[(w * 32 + crow(q, h)) * 64 + ni * 32 + r];
        }
#pragma unroll
        for (int ni = 0; ni < 2; ++ni)
#pragma unroll
          for (int q = 0; q < 16; ++q) sacc[ni][q] = sacc[ni][q] * dc[ni] + Lc[ni * 16 + q];
#pragma unroll
        for (int i = 0; i < 32; ++i) Lc[i] = Ln[i];
        dc[0] = dn[0]; dc[1] = dn[1];
      }
    }
    __syncthreads();
    gla_sweep<true>(p, e, hd, dir, tok0, sacc, S);
    if (!samp) {
      float* o = p.out + OUT_GLA + (size_t)(((seg * 2 + e) * 2 + dir) * 4 + hd) * 8192;
#pragma unroll
      for (int ni = 0; ni < 2; ++ni)
#pragma unroll
        for (int q = 0; q < 16; ++q) o[(ni * 32 + r) * 128 + w * 32 + crow(q, h)] = sacc[ni][q];
    }
    __syncthreads();
  }
}

#define XLD 136
#define WSYNC() do { __builtin_amdgcn_fence(__ATOMIC_RELEASE, "wavefront"); __builtin_amdgcn_wave_barrier(); __builtin_amdgcn_fence(__ATOMIC_ACQUIRE, "wavefront"); } while (0)
DI void s5_sweep(const Params& p, int e, int g, int dir, int mode, int tok0, float& hr, float& hi, bf16_t* X) {
  const int lane = otid() & 63;
  const int r = lane & 31, h = lane >> 5;
  const bf16_t* P = (const bf16_t*)(p.ws + OFF_P);
  bf16_t* Z5 = (bf16_t*)(p.ws + OFF_Z5);
  bf16_t* Yb = (bf16_t*)(p.ws + OFF_HY);
  const float* LB = (const float*)(p.ws + OFF_LB) + (size_t)(((e * 2 + dir) * 32 + g) * 64 + lane) * 2;
  const float lbr = LB[0], lbi = LB[1];
  const bf16_t* BBT = (const bf16_t*)(p.ws + OFF_BBT) + (size_t)((e * 2 + dir) * 32 + g) * 128 * 16;
  const bf16_t* CM = (const bf16_t*)(p.ws + OFF_CM) + (size_t)(e * 32 + g) * 32 * 128;
  bf16x8 bfr[4];
#pragma unroll
  for (int j = 0; j < 4; ++j) bfr[j] = *(const bf16x8*)(BBT + (32 * j + r) * 16 + 8 * h);
  bf16x8 cfr[8];
#pragma unroll
  for (int s = 0; s < 8; ++s) cfr[s] = *(const bf16x8*)(CM + r * 128 + s * 16 + h * 8);
  bf16x8 dfr;
  {
    const short dv = (r < 16) ? (short)f2bf(p.in[I_S5D][e * 512 + g * 16 + r]) : (short)0;
#pragma unroll
    for (int j = 0; j < 8; ++j) dfr[j] = (8 * h + j == r) ? dv : (short)0;
  }
  const bf16_t* Ub = P + (size_t)(tok0 + r) * LDP_E + PE_U + g * 16 + 8 * h;
  bf16x8 a_cur = *(const bf16x8*)(Ub + (size_t)((dir ? 7 : 0) * 32) * LDP_E);
#pragma unroll 1
  for (int ss = 0; ss < 8; ++ss) {
    const int sc = dir ? 7 - ss : ss;
    const int t0 = tok0 + sc * 32;
    bf16x8 a_nxt = a_cur;
    if (ss < 7) a_nxt = *(const bf16x8*)(Ub + (size_t)((dir ? 6 - ss : ss + 1) * 32) * LDP_E);
    bf16_t* prec = Yb + (size_t)(t0 + 16 * h + (r & 15)) * DM + 512 + g * 16;
    uint4 pp0 = make_uint4(0, 0, 0, 0), pp1 = make_uint4(0, 0, 0, 0);
    if (mode == 2 && r < 16) { pp0 = *(const uint4*)prec; pp1 = *(const uint4*)(prec + 8); }
#pragma unroll
    for (int jp = 0; jp < 2; ++jp) {
      f32x16 are = mfma(a_cur, bfr[2 * jp], zero16());
      f32x16 aim = mfma(a_cur, bfr[2 * jp + 1], zero16());
#pragma unroll
      for (int q = 0; q < 16; ++q) *(unsigned*)(X + crow(q, h) * XLD + 2 * (32 * jp + r)) = pack2(are[q], aim[q]);
    }
    WSYNC();
#define S5STEP(T) { float br = __uint_as_float(wv[T] << 16), bi = __uint_as_float(wv[T] & 0xffff0000u); \
        float nr = lbr * hr - lbi * hi + br; float ni = lbr * hi + lbi * hr + bi; hr = nr; hi = ni; wv[T] = pack2(nr, ni); }
#pragma unroll
    for (int hf = 0; hf < 2; ++hf) {
      bf16_t* Xh = X + ((dir ? 1 - hf : hf) * 16) * XLD + 2 * lane;
      unsigned wv[16];
#pragma unroll
      for (int tt = 0; tt < 16; ++tt) wv[tt] = *(const unsigned*)(Xh + tt * XLD);
      if (dir == 0) {
#pragma unroll
        for (int tt = 0; tt < 16; ++tt) S5STEP(tt)
      } else {
#pragma unroll
        for (int tt = 15; tt >= 0; --tt) S5STEP(tt)
      }
#pragma unroll
      for (int tt = 0; tt < 16; ++tt) *(unsigned*)(Xh + tt * XLD) = wv[tt];
    }
#undef S5STEP
    WSYNC();
    if (mode >= 1) {
      f32x16 acc = zero16();
#pragma unroll
      for (int s = 0; s < 8; ++s) {
        bf16x8 xa = *(const bf16x8*)(X + r * XLD + s * 16 + h * 8);
        acc = mfma(xa, cfr[s], acc);
      }
      if (mode == 2) acc = mfma(a_cur, dfr, acc);
      if (r < 16) {
        if (mode == 1) {
          *(uint4*)prec = make_uint4(pack2(acc[0], acc[1]), pack2(acc[2], acc[3]), pack2(acc[4], acc[5]), pack2(acc[6], acc[7]));
          *(uint4*)(prec + 8) = make_uint4(pack2(acc[8], acc[9]), pack2(acc[10], acc[11]), pack2(acc[12], acc[13]), pack2(acc[14], acc[15]));
        } else {
          const unsigned pw[8] = {pp0.x, pp0.y, pp0.z, pp0.w, pp1.x, pp1.y, pp1.z, pp1.w};
          const int col = g * 16 + r;
#pragma unroll
          for (int q = 0; q < 16; ++q) {
            const float prev = (q & 1) ? __uint_as_float(pw[q >> 1] & 0xffff0000u) : __uint_as_float(pw[q >> 1] << 16);
            const float y = acc[q] + prev;
            const float t3 = 1.5957691216057308f * (y + 0.044715f * y * y * y);
            Z5[(size_t)(t0 + crow(q, h)) * 512 + col] = f2bf(y * sigmf(t3));
          }
        }
      }
    }
    WSYNC();
    a_cur = a_nxt;
  }
}

DI void s5_pass1_unit(const Params& p, int e, int u, char* smem) {
  const int tid = otid(), lane = tid & 63, w = tid >> 6;
  const int seg = u >> 3, g = (u & 7) * 4 + w;
  bf16_t* X = (bf16_t*)smem + w * 32 * XLD;
  float* ES = (float*)(p.ws + OFF_S5ES);
  for (int dir = 0; dir < 2; ++dir) {
    float hr = 0.f, hi = 0.f;
    s5_sweep(p, e, g, dir, 0, NTOK_P + seg * 256, hr, hi, X);
    size_t o = ((size_t)((seg * 32 + g) * 2 + dir) * 64 + lane) * 2;
    ES[o] = hr; ES[o + 1] = hi;
  }
}

DI void s5_pass3_unit(const Params& p, int e, int u, char* smem) {
  const int tid = otid(), lane = tid & 63, w = tid >> 6;
  const int seg = u >> 3, g = (u & 7) * 4 + w;
  bf16_t* X = (bf16_t*)smem + w * 32 * XLD;
  const bool samp = seg >= 32;
  const int sb = samp ? (seg - 32) >> 4 : 0, sl = samp ? (seg - 32) & 15 : 0;
  const float* ES = (const float*)(p.ws + OFF_S5ES);
  for (int dir = 0; dir < 2; ++dir) {
    float hr = 0.f, hi = 0.f;
    if (samp) {
      const size_t si = (size_t)(((sb * 2 + e) * 2 + dir) * 32 + g) * 64 + lane;
      hr = p.in[I_S5R][si]; hi = p.in[I_S5I][si];
      const float* L2 = (const float*)(p.ws + OFF_LB256) + (size_t)(((e * 2 + dir) * 32 + g) * 64 + lane) * 2;
      const float ar = L2[0], ai = L2[1];
      const int nst = dir ? 15 - sl : sl;
      float er[15], ei[15];
#pragma unroll
      for (int k = 0; k < 15; ++k) {
        const int kk = k < nst ? k : 0;
        const int sp = dir ? 15 - kk : kk;
        size_t o = ((size_t)(((sb * 16 + sp) * 32 + g) * 2 + dir) * 64 + lane) * 2;
        float2 ev = *(const float2*)(ES + o);
        er[k] = ev.x; ei[k] = ev.y;
      }
#pragma unroll
      for (int k = 0; k < 15; ++k) {
        if (k < nst) {
          float nr = ar * hr - ai * hi + er[k];
          float ni = ar * hi + ai * hr + ei[k];
          hr = nr; hi = ni;
        }
      }
    }
    s5_sweep(p, e, g, dir, dir + 1, seg * 256, hr, hi, X);
    if (!samp) {
      const size_t so = (size_t)(((seg * 2 + e) * 2 + dir) * 32 + g) * 64 + lane;
      p.out[OUT_S5R + so] = hr;
      p.out[OUT_S5I + so] = hi;
    }
  }
}

#define AL 72
template <int W>
DI void qk_prep(const bf16_t* src, const float* nw, bool rope, int pos, float mult, int sub, const float* RT,
                bf16_t* dst, float* fdst) {
  float x[4][W];
#pragma unroll
  for (int c = 0; c < 4; ++c) {
    if (W == 4) {
      uint2 v = *(const uint2*)(src + 16 * c + 4 * sub);
      x[c][0] = __uint_as_float(v.x << 16); x[c][1] = __uint_as_float(v.x & 0xffff0000u);
      x[c][2] = __uint_as_float(v.y << 16); x[c][3] = __uint_as_float(v.y & 0xffff0000u);
    } else {
      uint4 v = *(const uint4*)(src + 16 * c + 8 * sub);
      x[c][0] = __uint_as_float(v.x << 16); x[c][1] = __uint_as_float(v.x & 0xffff0000u);
      x[c][2] = __uint_as_float(v.y << 16); x[c][3] = __uint_as_float(v.y & 0xffff0000u);
      x[c][4 % W] = __uint_as_float(v.z << 16); x[c][5 % W] = __uint_as_float(v.z & 0xffff0000u);
      x[c][6 % W] = __uint_as_float(v.w << 16); x[c][7 % W] = __uint_as_float(v.w & 0xffff0000u);
    }
  }
  float ss = 0.f;
#pragma unroll
  for (int c = 0; c < 4; ++c)
#pragma unroll
    for (int i = 0; i < W; ++i) ss += x[c][i] * x[c][i];
  ss += __shfl_xor(ss, 1);
  if (W == 4) ss += __shfl_xor(ss, 2);
  const float rstd = rsqrtf(ss * (1.f / 64.f) + EPSF);
#pragma unroll
  for (int c = 0; c < 4; ++c)
#pragma unroll
    for (int i = 0; i < W; ++i) x[c][i] *= rstd * nw[16 * c + W * sub + i];
  if (rope) {
    const int row = pos >> 6, col = pos & 63;
#pragma unroll
    for (int i = 0; i < W; ++i) {
      const int f = W * sub + i;
      float cs = RT[(row * 16 + f) * 2], sn = RT[(row * 16 + f) * 2 + 1];
      float x1 = x[0][i], x2 = x[1][i];
      x[0][i] = x1 * cs - x2 * sn; x[1][i] = x2 * cs + x1 * sn;
      cs = RT[(col * 16 + f) * 2]; sn = RT[(col * 16 + f) * 2 + 1];
      x1 = x[2][i]; x2 = x[3][i];
      x[2][i] = x1 * cs - x2 * sn; x[3][i] = x2 * cs + x1 * sn;
    }
  }
#pragma unroll
  for (int c = 0; c < 4; ++c)
#pragma unroll
    for (int i = 0; i < W; ++i) {
      dst[16 * c + W * sub + i] = f2bf(x[c][i] * mult);
      if (fdst) fdst[16 * c + W * sub + i] = x[c][i];
    }
}

DI void attn_unit(const Params& p, int e, int u, char* smem) {
  const int tid = otid(), lane = tid & 63, w = tid >> 6;
  const int r = lane & 31, h = lane >> 5;
  bf16_t* Ks = (bf16_t*)smem;
  bf16_t* Vt = Ks + 64 * AL;
  bf16_t* Qs = Vt + 64 * AL;
  const bf16_t* P = (const bf16_t*)(p.ws + OFF_P);
  bf16_t* Y = (bf16_t*)(p.ws + OFF_HY);
  const float* RT = (const float*)(p.ws + OFF_ROPE);
  const bool lat = u >= 512;
  int b, kvh, qb;
  if (!lat) { b = u >> 4; kvh = (u >> 3) & 1; qb = u & 7; }
  else { int v = u - 512; b = v >> 8; kvh = (v >> 7) & 1; qb = v & 127; }
  const int tokbase = lat ? NTOK_P + b * 4096 : b * 256;
  const int q0 = qb * 32;
  const int hq = kvh * 4 + w;
  __syncthreads();
  {
    const int qi = lane >> 1, sub = lane & 1;
    const bf16_t* src = P + (size_t)(tokbase + q0 + qi) * LDP_O + PO_Q + hq * 64;
    qk_prep<8>(src, p.in[I_QNW] + e * 64, lat, q0 + qi, 0.125f, sub, RT, Qs + (w * 32 + qi) * AL, nullptr);
  }
  __syncthreads();
  bf16x8 qf[4];
#pragma unroll
  for (int ks = 0; ks < 4; ++ks) qf[ks] = *(const bf16x8*)(Qs + (w * 32 + r) * AL + ks * 16 + h * 8);
  float m_run = p.in[I_SINK][e * 8 + hq];
  float l_run = 1.f;
  f32x16 o[2];
  o[0] = zero16(); o[1] = zero16();
  const int kbase = lat ? (((q0 - 128) >> 6) << 6) : 0;
  const int ntile = lat ? 9 : 4;
  bf16_t* Ks1 = Qs + 4 * 32 * AL;
  bf16_t* Vt1 = Ks1 + 64 * AL;
  const int keyk = tid >> 2, s4 = tid & 3;
  const int keyv = tid & 63, cq = tid >> 6;
  const bool wr = (!lat) && (qb == 0);
  float knw[16];
#pragma unroll
  for (int c = 0; c < 4; ++c)
#pragma unroll
    for (int i = 0; i < 4; ++i) knw[c * 4 + i] = p.in[I_KNW][e * 64 + 16 * c + 4 * s4 + i];
  float ccs[4], csn[4];
#pragma unroll
  for (int i = 0; i < 4; ++i) { ccs[i] = RT[(keyk * 16 + 4 * s4 + i) * 2]; csn[i] = RT[(keyk * 16 + 4 * s4 + i) * 2 + 1]; }
  uint4 rk0, rk1, rk2, rk3, rv0, rv1, rv2, rv3;
  float rrc[4] = {1.f, 1.f, 1.f, 1.f}, rrs[4] = {0.f, 0.f, 0.f, 0.f};
  rk0 = rk1 = rk2 = rk3 = rv0 = rv1 = rv2 = rv3 = make_uint4(0, 0, 0, 0);
  int tlo = 0, thi = ntile - 1;
  if (lat) {
    tlo = kbase < 0 ? (-kbase) >> 6 : 0;
    thi = 4;
    while (kbase + thi * 64 >= 4096) --thi;
  }
#define TILE_NEXT(ti) (lat ? ((ti) < thi ? (ti) + 1 : ((ti) < 5 ? 5 : (ti) + 1)) : (ti) + 1)
#define TILE_LOAD(ti) { \
    const bool fc_ = lat && (ti) >= 5; \
    const int kt0_ = fc_ ? ((ti) - 5) * 64 : kbase + (ti) * 64; \
    if (fc_) { \
      const float* ck = p.in[I_CK] + ((size_t)((b * 2 + e) * 2 + kvh) * 256 + kt0_ + keyk) * 64 + 4 * s4; \
      const float* cv = p.in[I_CV] + ((size_t)((b * 2 + e) * 2 + kvh) * 256 + kt0_ + keyv) * 64 + cq * 16; \
      rk0 = *(const uint4*)(ck); rk1 = *(const uint4*)(ck + 16); rk2 = *(const uint4*)(ck + 32); rk3 = *(const uint4*)(ck + 48); \
      rv0 = *(const uint4*)(cv); rv1 = *(const uint4*)(cv + 4); rv2 = *(const uint4*)(cv + 8); rv3 = *(const uint4*)(cv + 12); \
    } else { \
      const bf16_t* ksrc = P + (size_t)(tokbase + kt0_ + keyk) * LDP_O + PO_K + kvh * 64 + 4 * s4; \
      const bf16_t* vsrc = P + (size_t)(tokbase + kt0_ + keyv) * LDP_O + PO_V + kvh * 64 + cq * 16; \
      uint2 t0_ = *(const uint2*)(ksrc), t1_ = *(const uint2*)(ksrc + 16), t2_ = *(const uint2*)(ksrc + 32), t3_ = *(const uint2*)(ksrc + 48); \
      rk0.x = t0_.x; rk0.y = t0_.y; rk1.x = t1_.x; rk1.y = t1_.y; rk2.x = t2_.x; rk2.y = t2_.y; rk3.x = t3_.x; rk3.y = t3_.y; \
      rv0 = *(const uint4*)(vsrc); rv1 = *(const uint4*)(vsrc + 8); \
      if (lat) { \
        const int row_ = kt0_ >> 6; \
        _Pragma("unroll") for (int i = 0; i < 4; ++i) { rrc[i] = RT[(row_ * 16 + 4 * s4 + i) * 2]; rrs[i] = RT[(row_ * 16 + 4 * s4 + i) * 2 + 1]; } \
      } \
    } }
#define VT4(VD, W0, W1) { (VD)[0] = (bf16_t)((W0) & 0xffffu); (VD)[AL] = (bf16_t)((W0) >> 16); (VD)[2 * AL] = (bf16_t)((W1) & 0xffffu); (VD)[3 * AL] = (bf16_t)((W1) >> 16); }
#define TILE_STORE(ti, KB, VB) { \
    const bool fc_ = lat && (ti) >= 5; \
    const int kt0_ = fc_ ? ((ti) - 5) * 64 : kbase + (ti) * 64; \
    if (fc_) { \
      bf16_t* kd = (KB) + keyk * AL + 4 * s4; \
      *(uint2*)(kd) = make_uint2(pack2(__uint_as_float(rk0.x), __uint_as_float(rk0.y)), pack2(__uint_as_float(rk0.z), __uint_as_float(rk0.w))); \
      *(uint2*)(kd + 16) = make_uint2(pack2(__uint_as_float(rk1.x), __uint_as_float(rk1.y)), pack2(__uint_as_float(rk1.z), __uint_as_float(rk1.w))); \
      *(uint2*)(kd + 32) = make_uint2(pack2(__uint_as_float(rk2.x), __uint_as_float(rk2.y)), pack2(__uint_as_float(rk2.z), __uint_as_float(rk2.w))); \
      *(uint2*)(kd + 48) = make_uint2(pack2(__uint_as_float(rk3.x), __uint_as_float(rk3.y)), pack2(__uint_as_float(rk3.z), __uint_as_float(rk3.w))); \
      bf16_t* vd = (VB) + (cq * 16) * AL + keyv; \
      VT4(vd, pack2(__uint_as_float(rv0.x), __uint_as_float(rv0.y)), pack2(__uint_as_float(rv0.z), __uint_as_float(rv0.w))) \
      VT4(vd + 4 * AL, pack2(__uint_as_float(rv1.x), __uint_as_float(rv1.y)), pack2(__uint_as_float(rv1.z), __uint_as_float(rv1.w))) \
      VT4(vd + 8 * AL, pack2(__uint_as_float(rv2.x), __uint_as_float(rv2.y)), pack2(__uint_as_float(rv2.z), __uint_as_float(rv2.w))) \
      VT4(vd + 12 * AL, pack2(__uint_as_float(rv3.x), __uint_as_float(rv3.y)), pack2(__uint_as_float(rv3.z), __uint_as_float(rv3.w))) \
    } else { \
      float x[4][4]; \
      const unsigned kw[8] = {rk0.x, rk0.y, rk1.x, rk1.y, rk2.x, rk2.y, rk3.x, rk3.y}; \
      _Pragma("unroll") for (int c = 0; c < 4; ++c) { \
        x[c][0] = __uint_as_float(kw[2 * c] << 16); x[c][1] = __uint_as_float(kw[2 * c] & 0xffff0000u); \
        x[c][2] = __uint_as_float(kw[2 * c + 1] << 16); x[c][3] = __uint_as_float(kw[2 * c + 1] & 0xffff0000u); } \
      float ss = 0.f; \
      _Pragma("unroll") for (int c = 0; c < 4; ++c) _Pragma("unroll") for (int i = 0; i < 4; ++i) ss += x[c][i] * x[c][i]; \
      ss += __shfl_xor(ss, 1); ss += __shfl_xor(ss, 2); \
      const float rstd = rsqrtf(ss * (1.f / 64.f) + EPSF); \
      _Pragma("unroll") for (int c = 0; c < 4; ++c) _Pragma("unroll") for (int i = 0; i < 4; ++i) x[c][i] *= rstd * knw[c * 4 + i]; \
      if (lat) { \
        _Pragma("unroll") for (int i = 0; i < 4; ++i) { \
          float x1 = x[0][i], x2 = x[1][i]; x[0][i] = x1 * rrc[i] - x2 * rrs[i]; x[1][i] = x2 * rrc[i] + x1 * rrs[i]; \
          x1 = x[2][i]; x2 = x[3][i]; x[2][i] = x1 * ccs[i] - x2 * csn[i]; x[3][i] = x2 * ccs[i] + x1 * csn[i]; } \
      } \
      bf16_t* kd = (KB) + keyk * AL + 4 * s4; \
      _Pragma("unroll") for (int c = 0; c < 4; ++c) *(uint2*)(kd + 16 * c) = make_uint2(pack2(x[c][0], x[c][1]), pack2(x[c][2], x[c][3])); \
      if (wr) { \
        float* fd = p.out + OUT_CK + ((size_t)((b * 2 + e) * 2 + kvh) * 256 + kt0_ + keyk) * 64 + 4 * s4; \
        _Pragma("unroll") for (int c = 0; c < 4; ++c) *(float4*)(fd + 16 * c) = make_float4(x[c][0], x[c][1], x[c][2], x[c][3]); \
        float* fv = p.out + OUT_CV + ((size_t)((b * 2 + e) * 2 + kvh) * 256 + kt0_ + keyv) * 64 + cq * 16; \
        *(float4*)(fv) = make_float4(__uint_as_float(rv0.x << 16), __uint_as_float(rv0.x & 0xffff0000u), __uint_as_float(rv0.y << 16), __uint_as_float(rv0.y & 0xffff0000u)); \
        *(float4*)(fv + 4) = make_float4(__uint_as_float(rv0.z << 16), __uint_as_float(rv0.z & 0xffff0000u), __uint_as_float(rv0.w << 16), __uint_as_float(rv0.w & 0xffff0000u)); \
        *(float4*)(fv + 8) = make_float4(__uint_as_float(rv1.x << 16), __uint_as_float(rv1.x & 0xffff0000u), __uint_as_float(rv1.y << 16), __uint_as_float(rv1.y & 0xffff0000u)); \
        *(float4*)(fv + 12) = make_float4(__uint_as_float(rv1.z << 16), __uint_as_float(rv1.z & 0xffff0000u), __uint_as_float(rv1.w << 16), __uint_as_float(rv1.w & 0xffff0000u)); \
      } \
      bf16_t* vd = (VB) + (cq * 16) * AL + keyv; \
      VT4(vd, rv0.x, rv0.y) VT4(vd + 4 * AL, rv0.z, rv0.w) VT4(vd + 8 * AL, rv1.x, rv1.y) VT4(vd + 12 * AL, rv1.z, rv1.w) \
    } }
  int cur = 0;
  {
    TILE_LOAD(tlo)
    TILE_STORE(tlo, Ks, Vt)
  }
  __syncthreads();
  for (int ti = tlo; ti < ntile;) {
    const bool fromcache = lat && ti >= 5;
    const int kt0 = fromcache ? (ti - 5) * 64 : kbase + ti * 64;
    const int tn = TILE_NEXT(ti);
    if (tn < ntile) { TILE_LOAD(tn) }
    const bf16_t* Kc = cur ? Ks1 : Ks;
    const bf16_t* Vc = cur ? Vt1 : Vt;
    f32x16 s[2];
#pragma unroll
    for (int mt = 0; mt < 2; ++mt) {
      s[mt] = zero16();
#pragma unroll
      for (int ks = 0; ks < 4; ++ks) {
        bf16x8 a = *(const bf16x8*)(Kc + (mt * 32 + r) * AL + ks * 16 + h * 8);
        s[mt] = mfma(a, qf[ks], s[mt]);
      }
    }
    if (lat && !fromcache) {
      const int qpos = q0 + r;
#pragma unroll
      for (int mt = 0; mt < 2; ++mt)
#pragma unroll
        for (int q = 0; q < 16; ++q) {
          int kpos = kt0 + mt * 32 + crow(q, h);
          int dd = kpos - qpos;
          if (dd > 128 || dd < -128) s[mt][q] = -1e30f;
        }
    }
    float mx = -3e38f;
#pragma unroll
    for (int mt = 0; mt < 2; ++mt)
#pragma unroll
      for (int q = 0; q < 16; ++q) mx = fmaxf(mx, s[mt][q]);
    mx = fmaxf(mx, __shfl_xor(mx, 32));
    const float m_new = fmaxf(m_run, mx);
    const float alpha = __expf(m_run - m_new);
    float rs = 0.f;
#pragma unroll
    for (int mt = 0; mt < 2; ++mt)
#pragma unroll
      for (int q = 0; q < 16; ++q) { float pv = __expf(s[mt][q] - m_new); s[mt][q] = pv; rs += pv; }
    rs += __shfl_xor(rs, 32);
    l_run = l_run * alpha + rs;
    m_run = m_new;
#pragma unroll
    for (int q = 0; q < 16; ++q) { o[0][q] *= alpha; o[1][q] *= alpha; }
#pragma unroll
    for (int mt = 0; mt < 2; ++mt)
#pragma unroll
      for (int sx = 0; sx < 2; ++sx) {
        bf16x8 pf;
#pragma unroll
        for (int j = 0; j < 8; ++j) pf[j] = (short)f2bf(s[mt][8 * sx + j]);
#pragma unroll
        for (int dvt = 0; dvt < 2; ++dvt) {
          const bf16_t* vp = Vc + (dvt * 32 + r) * AL + mt * 32 + 16 * sx + 4 * h;
          s16x4 lo = *(const s16x4*)vp;
          s16x4 hi4 = *(const s16x4*)(vp + 8);
          bf16x8 a = __builtin_shufflevector(lo, hi4, 0, 1, 2, 3, 4, 5, 6, 7);
          o[dvt] = mfma(a, pf, o[dvt]);
        }
      }
      if (tn < ntile) {
      if (cur) { TILE_STORE(tn, Ks, Vt) } else { TILE_STORE(tn, Ks1, Vt1) }
    }
    __syncthreads();
    ti = tn;
    cur ^= 1;
  }
#undef TILE_NEXT
#undef TILE_LOAD
#undef TILE_STORE
#undef VT4
  const float inv = 1.f / l_run;
  const int tok = tokbase + q0 + r;
#pragma unroll
  for (int dvt = 0; dvt < 2; ++dvt)
#pragma unroll
    for (int g4 = 0; g4 < 4; ++g4) {
      const int dv = dvt * 32 + 8 * g4 + 4 * h;
      uint2 zz = *(const uint2*)(P + (size_t)tok * LDP_O + PO_ZA + hq * 64 + dv);
      float z0 = __uint_as_float(zz.x << 16), z1 = __uint_as_float(zz.x & 0xffff0000u);
      float z2 = __uint_as_float(zz.y << 16), z3 = __uint_as_float(zz.y & 0xffff0000u);
      float y0 = o[dvt][4 * g4 + 0] * inv * siluf(z0);
      float y1 = o[dvt][4 * g4 + 1] * inv * siluf(z1);
      float y2 = o[dvt][4 * g4 + 2] * inv * siluf(z2);
      float y3 = o[dvt][4 * g4 + 3] * inv * siluf(z3);
      *(uint2*)(Y + (size_t)tok * DM + hq * 64 + dv) = make_uint2(pack2(y0, y1), pack2(y2, y3));
    }
}

DI void conv_unit(const Params& p, int e, int u) {
  const int tid = otid();
  const bf16_t* P = (const bf16_t*)(p.ws + OFF_P);
  bf16_t* Y = (bf16_t*)(p.ws + OFF_HY);
  const int t0 = u * 16;
  const int c = tid * 2;
  int seg0, seg1;
  if (t0 < NTOK_P) { seg0 = t0 & ~255; seg1 = seg0 + 256; }
  else { seg0 = NTOK_P + ((t0 - NTOK_P) & ~4095); seg1 = seg0 + 4096; }
  const float* cw = p.in[I_CONVW] + (size_t)e * 3 * 512;
  const float w00 = cw[c], w01 = cw[c + 1], w10 = cw[512 + c], w11 = cw[512 + c + 1], w20 = cw[1024 + c], w21 = cw[1024 + c + 1];
  const float b0 = p.in[I_CONVB][e * 512 + c], b1 = p.in[I_CONVB][e * 512 + c + 1];
  auto prod = [&](int t, float& a, float& b) {
    if (t < seg0 || t >= seg1) { a = 0.f; b = 0.f; return; }
    unsigned xc = *(const unsigned*)(P + (size_t)t * LDP_O + PO_XC + c);
    unsigned cg_ = *(const unsigned*)(P + (size_t)t * LDP_O + PO_CG + c);
    a = __uint_as_float(xc << 16) * __uint_as_float(cg_ << 16);
    b = __uint_as_float(xc & 0xffff0000u) * __uint_as_float(cg_ & 0xffff0000u);
  };
  float pa0, pa1, pb0, pb1, pc0, pc1;
  prod(t0 - 1, pa0, pa1);
  prod(t0, pb0, pb1);
#pragma unroll
  for (int i = 0; i < 16; ++i) {
    const int t = t0 + i;
    prod(t + 1, pc0, pc1);
    unsigned bg = *(const unsigned*)(P + (size_t)t * LDP_O + PO_BG + c);
    unsigned zc = *(const unsigned*)(P + (size_t)t * LDP_O + PO_ZC + c);
    float y0 = __uint_as_float(bg << 16) * (w00 * pa0 + w10 * pb0 + w20 * pc0 + b0) * siluf(__uint_as_float(zc << 16));
    float y1 = __uint_as_float(bg & 0xffff0000u) * (w01 * pa1 + w11 * pb1 + w21 * pc1 + b1) * siluf(__uint_as_float(zc & 0xffff0000u));
    *(unsigned*)(Y + (size_t)t * DM + 512 + c) = pack2(y0, y1);
    pa0 = pb0; pa1 = pb1; pb0 = pc0; pb1 = pc1;
  }
}


#define QCTR(l, ph) ((unsigned*)(p.ws + OFF_BAR) + 3584 + 16 * ((l) * 4 + (ph)))
DI int next_unit(unsigned* ctr, volatile int* sh) {
  __syncthreads();
  if (threadIdx.x == 0) *sh = (int)atomicAdd(ctr, 1u);
  __syncthreads();
  return *sh;
}
#ifndef REP_A
#define REP_A 1
#endif
#ifndef REP_INPROJ
#define REP_INPROJ 1
#endif
#ifndef REP_EVEN
#define REP_EVEN 1
#endif
#ifndef REP_ODD
#define REP_ODD 1
#endif
#define REP_G1 1
#define REP_S1 1
#define REP_G3 1
#define REP_S3 1
#ifndef REP_SYNC
#define REP_SYNC 1
#endif
#define GSYNC() do { _Pragma("unroll 1") for (int rs_ = 0; rs_ < REP_SYNC; ++rs_) xcd_barrier(xb); } while (0)
__global__ void __launch_bounds__(256, 2) fwd_megakernel(Params p) {
  cg::grid_group grid = cg::this_grid();
  __shared__ __attribute__((aligned(16))) char smem[SMEM_BYTES];
  __shared__ uint4 xb_words;
  __shared__ int qsh;
  if (threadIdx.x == 0) xb_words = make_uint4(0u, 0u, 0u, 0u);
  __syncthreads();
  XcdBarrier xb = xcd_barrier_post((unsigned*)(p.ws + OFF_BAR), (volatile LAS unsigned*)&xb_words);
  if (p.ws == nullptr) grid.sync();
  phase0(p, smem);
  GSYNC();
#pragma unroll 1
  for (int l = 0; l < 4; ++l) {
    const int e = l >> 1;
#pragma unroll 1
    for (int rep = 0; rep < REP_A; ++rep) {
      phaseA(p, l);
      GSYNC();
    }
    const int odd = l & 1;
#pragma unroll 1
    for (int rep = 0; rep < REP_INPROJ; ++rep) {
      gemm_phase<EPI_P, 16>(p, l, (const bf16_t*)(p.ws + OFF_HY), DM, (const bf16_t*)(p.ws + OFF_WIN), DM, odd ? LDP_O / 128 : LDP_E / 128, odd ? LDP_O : LDP_E, smem);
      GSYNC();
    }
    if (!odd) {
#pragma unroll 1
      for (int rep = 0; rep < REP_EVEN; ++rep) {
        for (int u = next_unit(QCTR(l, 0), &qsh); u < 512 + 512; u = next_unit(QCTR(l, 0), &qsh)) {
          if (u < 512) { _Pragma("unroll 1") for (int r2 = 0; r2 < REP_G1; ++r2) gla_pass1_unit(p, e, u, smem); }
          else { _Pragma("unroll 1") for (int r2 = 0; r2 < REP_S1; ++r2) s5_pass1_unit(p, e, u - 512, smem); }
        }
        GSYNC();
        for (int u = next_unit(QCTR(l, 1), &qsh); u < 384 + 768; u = next_unit(QCTR(l, 1), &qsh)) {
          if (u < 384) { _Pragma("unroll 1") for (int r2 = 0; r2 < REP_G3; ++r2) gla_pass3_unit(p, e, u, smem); }
          else { _Pragma("unroll 1") for (int r2 = 0; r2 < REP_S3; ++r2) s5_pass3_unit(p, e, u - 384, smem); }
        }
        GSYNC();
        gemm_phase<EPI_GLU, 8>(p, l, (const bf16_t*)(p.ws + OFF_Z5), 512, (const bf16_t*)(p.ws + OFF_WGLU), 512, 4, 0, smem);
        GSYNC();
      }
    } else {
#pragma unroll 1
      for (int rep = 0; rep < REP_ODD; ++rep) {
        for (int u = next_unit(QCTR(l, 2), &qsh); u < 1536 + 1536; u = next_unit(QCTR(l, 2), &qsh)) {
          if (u < 1024) attn_unit(p, e, u + 512, smem);
          else if (u < 1536) attn_unit(p, e, u - 1024, smem);
          else conv_unit(p, e, u - 1536);
        }
        GSYNC();
      }
    }
    gemm_phase<EPI_RES, 16>(p, l, (const bf16_t*)(p.ws + OFF_HY), DM, (const bf16_t*)(p.ws + OFF_WOUT), DM, 8, 0, smem);
    if (l < 3) GSYNC();
  }
}

extern "C" void kernel_launch(void* const* d_in, const int* in_sizes, int n_in, void* d_out, int out_size,
                              void* d_ws, size_t ws_size, hipStream_t stream) {
  static int grid_blocks = 0;
  if (!grid_blocks) {
    int dev = 0, cus = 0, per_cu = 0;
    hipGetDevice(&dev);
    hipDeviceGetAttribute(&cus, hipDeviceAttributeMultiprocessorCount, dev);
    hipOccupancyMaxActiveBlocksPerMultiprocessor(&per_cu, fwd_megakernel, 256, 0);
    if (per_cu > 2) per_cu = 2;
    if (per_cu < 1) per_cu = 1;
    grid_blocks = cus * per_cu;
  }
  if (ws_size < WS_NEED || n_in < 34) { fprintf(stderr, "workspace too small\n"); return; }
  Params p{};
  for (int i = 0; i < 34; ++i) p.in[i] = (const float*)d_in[i];
  p.out = (float*)d_out;
  p.ws = (char*)d_ws;
  (void)hipMemsetAsync((char*)d_ws + OFF_BAR, 0, 16384, stream);
  void* args[] = {&p};
  hipError_t err = hipLaunchCooperativeKernel((void*)fwd_megakernel, dim3(grid_blocks), dim3(256), args, 0, stream);
  if (err != hipSuccess) fprintf(stderr, "cooperative launch failed: %s (grid %d)\n", hipGetErrorString(err), grid_blocks);
}
```

```cpp
#include <hip/hip_runtime.h>
#include <hip/hip_cooperative_groups.h>
#include <cstdio>
namespace cg = cooperative_groups;

typedef unsigned short bf16_t;
using bf16x8 = __attribute__((ext_vector_type(8))) short;
using s16x4  = __attribute__((ext_vector_type(4))) short;
using f32x16 = __attribute__((ext_vector_type(16))) float;
#define DI __device__ __forceinline__

#define NTOK    24576
#define NTOK_P  8192
#define DM      1024
#define LDP_E   2688
#define LDP_O   3328
#define EPSF    1e-6f

#define PE_Q   0
#define PE_K   256
#define PE_V   512
#define PE_ZG  1024
#define PE_U   1536
#define PE_ZS  2048
#define PE_LF  2560
#define PO_Q   0
#define PO_K   512
#define PO_V   640
#define PO_ZA  768
#define PO_XC  1280
#define PO_BG  1792
#define PO_CG  2304
#define PO_ZC  2816

#define OUT_GLA  25165824
#define OUT_S5R  29360128
#define OUT_S5I  29622272
#define OUT_CK   29884416
#define OUT_CV   31981568

#define OFF_WIN   0ull
#define OFF_WOUT  6815744ull
#define OFF_WGLU  8912896ull
#define OFF_MOD   9437184ull
#define OFF_LB    9682944ull
#define OFF_LB256 (OFF_LB + 65536ull)
#define OFF_BBT   (OFF_LB256 + 65536ull)
#define OFF_CM    (OFF_BBT + 524288ull)
#define OFF_ROPE  (OFF_CM + 524288ull)
#define OFF_S5ES  (OFF_ROPE + 8192ull)
#define OFF_GLAL  (OFF_S5ES + 2097152ull)
#define OFF_GLAD  (OFF_GLAL + 16777216ull)
#define OFF_HY    (OFF_GLAD + 131072ull)
#define OFF_P     (OFF_HY + 50331648ull)
#define OFF_Z5    (OFF_P + 132120576ull)
#define OFF_BAR   (OFF_P + 163577856ull)
#define WS_NEED   (OFF_BAR + 16384ull)

#define SMEM_BYTES 80896

struct Params {
  const float* in[34];
  float* out;
  char* ws;
};

enum { I_XP = 0, I_XS, I_C, I_SGLA, I_S5R, I_S5I, I_CK, I_CV, I_CCTX, I_NORMW, I_WADA, I_BADA, I_WINE, I_WOUTE,
       I_GW2, I_GB2, I_GON, I_LAMR, I_LAMI, I_LOGDT, I_BRE, I_BIM, I_CRE, I_CIM, I_S5D, I_WGLU, I_BGLU,
       I_WINO, I_WOUTO, I_QNW, I_KNW, I_SINK, I_CONVW, I_CONVB };

DI int otid() { int t = threadIdx.x; asm volatile("" : "+v"(t)); return t; }
typedef __bf16 hbf16x2 __attribute__((ext_vector_type(2)));
typedef float hf32x2 __attribute__((ext_vector_type(2)));
DI unsigned pack2(float a, float b) { hf32x2 v = {a, b}; return __builtin_bit_cast(unsigned, __builtin_convertvector(v, hbf16x2)); }
DI bf16_t f2bf(float x) { return (bf16_t)(pack2(x, x) & 0xffffu); }
DI float bf2f(bf16_t b) { return __uint_as_float(((unsigned)b) << 16); }
DI float siluf(float x) { return x * __builtin_amdgcn_rcpf(1.f + __expf(-x)); }
DI float sigmf(float x) { return __builtin_amdgcn_rcpf(1.f + __expf(-x)); }
DI int crow(int q, int h) { return (q & 3) + 8 * (q >> 2) + 4 * h; }
DI f32x16 mfma(bf16x8 a, bf16x8 b, f32x16 c) { return __builtin_amdgcn_mfma_f32_32x32x16_bf16(a, b, c, 0, 0, 0); }
DI f32x16 zero16() { f32x16 z; for (int i = 0; i < 16; ++i) z[i] = 0.f; return z; }

template <int K>
DI void mma_tile(f32x16& acc, const bf16_t* A, int lda, const bf16_t* Bt, int ldb, int lane) {
  const int r = lane & 31, h = lane >> 5;
#pragma unroll
  for (int s = 0; s < K / 16; ++s) {
    bf16x8 a = *(const bf16x8*)(A + r * lda + s * 16 + h * 8);
    bf16x8 b = *(const bf16x8*)(Bt + r * ldb + s * 16 + h * 8);
    acc = mfma(a, b, acc);
  }
}

#define XB_TMO      128
#define XB_XCNT(j)  (256  + 64 * (j))
#define XB_XSUB(j)  (1280 + 64 * (j))
#define XB_XGEN(j)  (2304 + 64 * (j))
#define XB_TOP      3328
#define XB_TOPGEN   3392
#define XCD_BAR_WORDS 3456
#define XB_SPIN_CAP (1u << 18)
#define LAS __attribute__((address_space(3)))

__device__ __forceinline__ unsigned xb_ld(unsigned* p)              { return __hip_atomic_load(p, __ATOMIC_RELAXED, __HIP_MEMORY_SCOPE_AGENT); }
__device__ __forceinline__ unsigned xb_add(unsigned* p, unsigned v) { return __hip_atomic_fetch_add(p, v, __ATOMIC_RELAXED, __HIP_MEMORY_SCOPE_AGENT); }
__device__ __forceinline__ unsigned xb_xcc_id() { return (unsigned)__builtin_amdgcn_s_getreg((3 << 11) | 20) & 0xFu; }
#define XB_SPIN(cond, bar) do { unsigned _sp = 0; while (cond) { __builtin_amdgcn_s_sleep(1); \
    if ((++_sp & 255u) == 0u) { if (xb_ld(&(bar)[XB_TMO])) break; if (_sp > XB_SPIN_CAP) { atomicAdd(&(bar)[XB_TMO], 1u); break; } } } } while (0)

struct XcdBarrier {
    unsigned* bar; unsigned x;
    volatile LAS unsigned* st;
};

__device__ __forceinline__ XcdBarrier xcd_barrier_post(unsigned* bar, volatile LAS unsigned* st) {
    XcdBarrier b; b.bar = bar; b.x = xb_xcc_id(); b.st = st;
    if (threadIdx.x == 0) (void)xb_add(&bar[XB_XCNT(b.x)], 1u);
    return b;
}
__device__ __forceinline__ void xcd_barrier_complete(unsigned* bar, unsigned x, unsigned& nloc, unsigned& nx) {
    const unsigned G = gridDim.x * gridDim.y * gridDim.z;
    unsigned sum, cnt, mine, sp = 0u;
    for (;;) {
        sum = 0u; cnt = 0u; mine = 0u;
#pragma unroll
        for (unsigned j = 0; j < 16; ++j) { const unsigned c = xb_ld(&bar[XB_XCNT(j)]); sum += c; cnt += (c > 0u) ? 1u : 0u; mine = (j == x) ? c : mine; }
        if (sum == G) break;
        __builtin_amdgcn_s_sleep(1);
        if ((++sp & 255u) == 0u) { if (xb_ld(&bar[XB_TMO])) break; if (sp > XB_SPIN_CAP) { atomicAdd(&bar[XB_TMO], 1u); break; } }
    }
    nloc = mine > 0u ? mine : 1u; nx = cnt > 0u ? cnt : 1u;
}

__device__ __forceinline__ void xcd_barrier(const XcdBarrier& b) {
    asm volatile("s_waitcnt vmcnt(0)" ::: "memory");
    __syncthreads();
    if (threadIdx.x == 0) {
        unsigned* bar = b.bar;
        __builtin_amdgcn_s_waitcnt(0);
        unsigned nloc = b.st[0], nx = b.st[1];
        if (nloc == 0u) { xcd_barrier_complete(bar, b.x, nloc, nx); b.st[0] = nloc; b.st[1] = nx; }
        const unsigned old = xb_add(&bar[XB_XSUB(b.x)], 1u);
        const unsigned gen = old / nloc;
        if (old + 1u == (gen + 1u) * nloc) {
            __builtin_amdgcn_fence(__ATOMIC_RELEASE, "agent");
            asm volatile("s_waitcnt vmcnt(0)" ::: "memory");
            const unsigned og = xb_add(&bar[XB_TOP], 1u);
            const unsigned tg = og / nx;
            if (og + 1u == (tg + 1u) * nx) xb_add(&bar[XB_TOPGEN], 1u);
            else XB_SPIN(xb_ld(&bar[XB_TOPGEN]) == tg, bar);
            __builtin_amdgcn_fence(__ATOMIC_ACQUIRE, "agent");
            xb_add(&bar[XB_XGEN(b.x)], 1u);
            asm volatile("s_waitcnt vmcnt(0)" ::: "memory");
        } else {
            XB_SPIN(xb_ld(&bar[XB_XGEN(b.x)]) == gen, bar);
            __builtin_amdgcn_fence(__ATOMIC_ACQUIRE, "agent");
            asm volatile("s_waitcnt vmcnt(0)" ::: "memory");
        }
    }
    __syncthreads();
}


DI void phase0(const Params& p, char* smem) {
  const int tid = otid();
  float* sc = (float*)smem;
  float* red = sc + 5 * 1024;
  float* MOD = (float*)(p.ws + OFF_MOD);
  const int NU = 384 + 128 + 1;
  for (int u = blockIdx.x; u < NU; u += gridDim.x) {
    if (u < 384) {
      const int l = u / 96, nc = u % 96;
      __syncthreads();
      for (int i = tid; i < 5 * 1024; i += 256) {
        int j = i >> 10, k = i & 1023;
        float v = (j == 0) ? p.in[I_CCTX][k] : p.in[I_C][(j - 1) * 1024 + k];
        sc[i] = v / (1.f + expf(-v));
      }
      __syncthreads();
      const int col = tid & 31, kg = tid >> 5;
      const float* w = p.in[I_WADA] + (size_t)l * 1024 * 3072 + nc * 32 + col;
      float a0 = 0, a1 = 0, a2 = 0, a3 = 0, a4 = 0;
#pragma unroll 16
      for (int k = kg; k < 1024; k += 8) {
        float wv = w[(size_t)k * 3072];
        a0 += sc[k] * wv; a1 += sc[1024 + k] * wv; a2 += sc[2048 + k] * wv; a3 += sc[3072 + k] * wv; a4 += sc[4096 + k] * wv;
      }
      red[(kg * 5 + 0) * 32 + col] = a0; red[(kg * 5 + 1) * 32 + col] = a1; red[(kg * 5 + 2) * 32 + col] = a2;
      red[(kg * 5 + 3) * 32 + col] = a3; red[(kg * 5 + 4) * 32 + col] = a4;
      __syncthreads();
      if (tid < 160) {
        int j = tid >> 5, c2 = tid & 31;
        float s = 0;
        for (int g = 0; g < 8; ++g) s += red[(g * 5 + j) * 32 + c2];
        int n = nc * 32 + c2;
        MOD[(l * 5 + j) * 3072 + n] = s + p.in[I_BADA][l * 3072 + n];
      }
    } else if (u < 384 + 128) {
      const int v = u - 384;
      const int e = v >> 6, dir = (v >> 5) & 1, g = v & 31;
      if (tid < 64) {
        const int pp = tid;
        const int idx = ((e * 2 + dir) * 32 + g) * 64 + pp;
        double dt = exp((double)p.in[I_LOGDT][(e * 2 + dir) * 32 + g]);
        double lr = (double)p.in[I_LAMR][idx], li = (double)p.in[I_LAMI][idx];
        double mag = exp(lr * dt);
        double ang = li * dt;
        double tw = 6.283185307179586476925286766559;
        double kq = rint(ang / tw);
        double ra = ang - kq * tw;
        double lbr = mag * cos(ra), lbi = mag * sin(ra);
        double den = lr * lr + li * li;
        double nr = lbr - 1.0, ni = lbi;
        double cr = (nr * lr + ni * li) / den, ci = (ni * lr - nr * li) / den;
        float* LB = (float*)(p.ws + OFF_LB);
        float* LB256 = (float*)(p.ws + OFF_LB256);
        LB[idx * 2] = (float)lbr; LB[idx * 2 + 1] = (float)lbi;
        double pr = lbr, pi = lbi;
        for (int i = 0; i < 8; ++i) { double t = pr * pr - pi * pi; pi = 2.0 * pr * pi; pr = t; }
        LB256[idx * 2] = (float)pr; LB256[idx * 2 + 1] = (float)pi;
        bf16_t* BBT = (bf16_t*)(p.ws + OFF_BBT) + (size_t)((e * 2 + dir) * 32 + g) * 128 * 16;
        const float* bre = p.in[I_BRE] + ((size_t)(e * 32 + g) * 64 + pp) * 16;
        const float* bim = p.in[I_BIM] + ((size_t)(e * 32 + g) * 64 + pp) * 16;
        for (int hh = 0; hh < 16; ++hh) {
          double br = bre[hh], bi = bim[hh];
          const int nre = (pp >> 5) * 64 + (pp & 31);
          BBT[nre * 16 + hh] = f2bf((float)(cr * br - ci * bi));
          BBT[(nre + 32) * 16 + hh] = f2bf((float)(cr * bi + ci * br));
        }
        if (dir == 0) {
          bf16_t* CM = (bf16_t*)(p.ws + OFF_CM) + (size_t)(e * 32 + g) * 32 * 128;
          for (int hh = 0; hh < 32; ++hh) {
            float cre = 0.f, cim = 0.f;
            if (hh < 16) {
              cre = p.in[I_CRE][((size_t)(e * 32 + g) * 16 + hh) * 64 + pp];
              cim = p.in[I_CIM][((size_t)(e * 32 + g) * 16 + hh) * 64 + pp];
            }
            CM[hh * 128 + 2 * pp] = f2bf(cre);
            CM[hh * 128 + 2 * pp + 1] = f2bf(-cim);
          }
        }
      }
    } else {
      float* RT = (float*)(p.ws + OFF_ROPE);
      for (int i = tid; i < 64 * 16; i += 256) {
        int pos = i >> 4, f = i & 15;
        double fr = exp(-(double)f / 16.0 * 9.2103403719761827360719658187375);
        double ang = (double)pos * fr;
        double tw = 6.283185307179586476925286766559;
        double ra = ang - rint(ang / tw) * tw;
        RT[i * 2] = (float)cos(ra); RT[i * 2 + 1] = (float)sin(ra);
      }
    }
  }
}

DI void convert_tile(const float* src, int nsrc, bf16_t* dst, int K, int n0, int k0, int mapmode, int tid) {
  const int n = n0 + (tid & 63), kq = tid >> 6;
  int sc = n;
  if (mapmode == 1) {
    if (n < 1024) sc = n;
    else if (n < 2560) sc = n + 32;
    else if (n < 2592) sc = n - 1536;
    else sc = -1;
  }
  unsigned w[8];
#pragma unroll
  for (int i = 0; i < 8; ++i) {
    int k = k0 + kq * 16 + 2 * i;
    float a = 0.f, b = 0.f;
    if (sc >= 0) { a = src[(size_t)k * nsrc + sc]; b = src[(size_t)(k + 1) * nsrc + sc]; }
    w[i] = pack2(a, b);
  }
  uint4* d = (uint4*)(dst + (size_t)n * K + k0 + kq * 16);
  d[0] = make_uint4(w[0], w[1], w[2], w[3]);
  d[1] = make_uint4(w[4], w[5], w[6], w[7]);
}

DI void phaseA(const Params& p, int l) {
  const int tid = otid();
  const int odd = l & 1, e = l >> 1;
  const int n_in = (odd ? 52 : 42) * 16;
  const int n_out = 256;
  const int n_glu = odd ? 0 : 64;
  const int n_norm = NTOK / 16;
  const int total = n_in + n_out + n_glu + n_norm;
  bf16_t* WIN = (bf16_t*)(p.ws + OFF_WIN);
  bf16_t* WOUT = (bf16_t*)(p.ws + OFF_WOUT);
  bf16_t* WGLU = (bf16_t*)(p.ws + OFF_WGLU);
  bf16_t* H = (bf16_t*)(p.ws + OFF_HY);
  const float* MOD = (const float*)(p.ws + OFF_MOD);
  for (int u = blockIdx.x; u < total; u += gridDim.x) {
    if (u < n_in) {
      int nt = u >> 4, kt = u & 15;
      if (odd) convert_tile(p.in[I_WINO] + (size_t)e * 1024 * 3328, 3328, WIN, 1024, nt * 64, kt * 64, 0, tid);
      else convert_tile(p.in[I_WINE] + (size_t)e * 1024 * 2592, 2592, WIN, 1024, nt * 64, kt * 64, 1, tid);
    } else if (u < n_in + n_out) {
      int v = u - n_in; int nt = v >> 4, kt = v & 15;
      const float* src = (odd ? p.in[I_WOUTO] : p.in[I_WOUTE]) + (size_t)e * 1024 * 1024;
      convert_tile(src, 1024, WOUT, 1024, nt * 64, kt * 64, 0, tid);
    } else if (u < n_in + n_out + n_glu) {
      int v = u - n_in - n_out; int nt = v >> 3, kt = v & 7;
      convert_tile(p.in[I_WGLU] + (size_t)e * 512 * 512, 512, WGLU, 512, nt * 64, kt * 64, 0, tid);
    } else {
      int v = u - n_in - n_out - n_glu;
      const int tok0 = v * 16 + (tid >> 6) * 4;
      const int lane = tid & 63;
      const float* x;
      if (l == 0) x = (tok0 < NTOK_P) ? p.in[I_XP] + (size_t)tok0 * DM : p.in[I_XS] + (size_t)(tok0 - NTOK_P) * DM;
      else x = p.out + (size_t)tok0 * DM;
      const int j = (tok0 < NTOK_P) ? 0 : 1 + ((tok0 - NTOK_P) >> 12);
      const float* mod = MOD + (l * 5 + j) * 3072;
      const float* nw = p.in[I_NORMW] + l * 1024;
      float4 xv[4][4];
#pragma unroll
      for (int rr = 0; rr < 4; ++rr)
#pragma unroll
        for (int i = 0; i < 4; ++i) xv[rr][i] = *(const float4*)(x + (size_t)rr * DM + lane * 4 + 256 * i);
      float rstd[4];
#pragma unroll
      for (int rr = 0; rr < 4; ++rr) {
        float ss = 0.f;
#pragma unroll
        for (int i = 0; i < 4; ++i) ss += xv[rr][i].x * xv[rr][i].x + xv[rr][i].y * xv[rr][i].y + xv[rr][i].z * xv[rr][i].z + xv[rr][i].w * xv[rr][i].w;
#pragma unroll
        for (int o = 32; o >= 1; o >>= 1) ss += __shfl_xor(ss, o);
        rstd[rr] = rsqrtf(ss * (1.f / 1024.f) + EPSF);
      }
#pragma unroll
      for (int i = 0; i < 4; ++i) {
        const int k = lane * 4 + 256 * i;
        float4 w4 = *(const float4*)(nw + k);
        float4 sh = *(const float4*)(mod + k);
        float4 scl = *(const float4*)(mod + 1024 + k);
        const float c0 = w4.x * (1.f + scl.x), c1 = w4.y * (1.f + scl.y), c2 = w4.z * (1.f + scl.z), c3 = w4.w * (1.f + scl.w);
#pragma unroll
        for (int rr = 0; rr < 4; ++rr) {
          float h0 = xv[rr][i].x * rstd[rr] * c0 + sh.x;
          float h1 = xv[rr][i].y * rstd[rr] * c1 + sh.y;
          float h2 = xv[rr][i].z * rstd[rr] * c2 + sh.z;
          float h3 = xv[rr][i].w * rstd[rr] * c3 + sh.w;
          *(uint2*)(H + (size_t)(tok0 + rr) * DM + k) = make_uint2(pack2(h0, h1), pack2(h2, h3));
        }
      }
    }
  }
}

#define GLD 72
enum { EPI_P = 0, EPI_RES = 1, EPI_GLU = 2 };

template <int EPI, int KT>
DI void gemm_phase(const Params& p, int l, const bf16_t* A, int lda, const bf16_t* Bt, int ldb,
                           int NT, int ldp, char* smem) {
  const int tid = otid(), lane = tid & 63, w = tid >> 6;
  const int r = lane & 31, h = lane >> 5;
  const int wm = w >> 1, wn = w & 1;
  bf16_t* As = (bf16_t*)smem;
  bf16_t* Bs = As + 2 * 128 * GLD;
  const int lr = tid >> 3, lc = (tid & 7) * 8;
  const int MT = NTOK / 128;
  const int total = MT * NT;
  const float* MOD = (const float*)(p.ws + OFF_MOD);
  const int nslot = gridDim.x >> 3;
  if (blockIdx.x >= (gridDim.x >> 1)) { __builtin_amdgcn_s_sleep(56); }
  for (int k = 0;; ++k) {
    const int t = ((blockIdx.x & 7) + 8 * k) * nslot + (blockIdx.x >> 3);
    if (t >= total) break;
    const int band = t / (8 * NT), rem = t - band * 8 * NT;
    const int nt = rem >> 3, mt = band * 8 + (rem & 7);
    const int m0 = mt * 128, n0 = nt * 128;
    const bf16_t* Ag = A + (size_t)(m0 + lr) * lda + lc;
    const bf16_t* Bg = Bt + (size_t)(n0 + lr) * ldb + lc;
    uint4 xa0, xa1, xa2, xa3, xb0, xb1, xb2, xb3;
    uint4 ya0, ya1, ya2, ya3, yb0, yb1, yb2, yb3;
#define GLOADS(S, KOFS) \
    S##a0 = *(const uint4*)(Ag + (KOFS)); S##a1 = *(const uint4*)(Ag + (size_t)32 * lda + (KOFS)); \
    S##a2 = *(const uint4*)(Ag + (size_t)64 * lda + (KOFS)); S##a3 = *(const uint4*)(Ag + (size_t)96 * lda + (KOFS)); \
    S##b0 = *(const uint4*)(Bg + (KOFS)); S##b1 = *(const uint4*)(Bg + (size_t)32 * ldb + (KOFS)); \
    S##b2 = *(const uint4*)(Bg + (size_t)64 * ldb + (KOFS)); S##b3 = *(const uint4*)(Bg + (size_t)96 * ldb + (KOFS));
#define LSTORES(S, ST) \
    *(uint4*)(As + (ST) * 128 * GLD + (lr) * GLD + lc) = S##a0; *(uint4*)(As + (ST) * 128 * GLD + (lr + 32) * GLD + lc) = S##a1; \
    *(uint4*)(As + (ST) * 128 * GLD + (lr + 64) * GLD + lc) = S##a2; *(uint4*)(As + (ST) * 128 * GLD + (lr + 96) * GLD + lc) = S##a3; \
    *(uint4*)(Bs + (ST) * 128 * GLD + (lr) * GLD + lc) = S##b0; *(uint4*)(Bs + (ST) * 128 * GLD + (lr + 32) * GLD + lc) = S##b1; \
    *(uint4*)(Bs + (ST) * 128 * GLD + (lr + 64) * GLD + lc) = S##b2; *(uint4*)(Bs + (ST) * 128 * GLD + (lr + 96) * GLD + lc) = S##b3;
    bf16x8 fa0[4], fa1[4], fb0[4], fb1[4];
#define FRAGS(ST) { \
      const bf16_t* as = As + (ST) * 128 * GLD + (wm * 64 + r) * GLD + h * 8; \
      const bf16_t* bs = Bs + (ST) * 128 * GLD + (wn * 64 + r) * GLD + h * 8; \
      _Pragma("unroll") for (int s = 0; s < 4; ++s) { \
        fa0[s] = *(const bf16x8*)(as + s * 16); \
        fb0[s] = *(const bf16x8*)(bs + s * 16); \
        fa1[s] = *(const bf16x8*)(as + 32 * GLD + s * 16); \
        fb1[s] = *(const bf16x8*)(bs + 32 * GLD + s * 16); \
      } \
      __builtin_amdgcn_sched_barrier(0); }
#define MFMAS() { \
      _Pragma("unroll") for (int s = 0; s < 4; ++s) { \
        acc00 = mfma(fa0[s], fb0[s], acc00); acc01 = mfma(fa0[s], fb1[s], acc01); \
        acc10 = mfma(fa1[s], fb0[s], acc10); acc11 = mfma(fa1[s], fb1[s], acc11); \
      } \
      _Pragma("unroll") for (int g = 0; g < 8; ++g) { \
        __builtin_amdgcn_sched_group_barrier(0x008, 2, 0); \
        __builtin_amdgcn_sched_group_barrier(0x200, 1, 0); \
        __builtin_amdgcn_sched_group_barrier(0x020, 1, 0); \
      } }
    GLOADS(x, 0)
    LSTORES(x, 0)
    GLOADS(x, 64)
    GLOADS(y, 128)
    __syncthreads();
    f32x16 acc00 = zero16(), acc01 = zero16(), acc10 = zero16(), acc11 = zero16();
#pragma unroll
    for (int kt = 0; kt < KT; kt += 2) {
      FRAGS(0)
      LSTORES(x, 1)
      if (kt + 3 < KT) { GLOADS(x, (kt + 3) * 64) }
      MFMAS()
      __syncthreads();
      __builtin_amdgcn_sched_barrier(0);
      FRAGS(1)
      if (kt + 2 < KT) { LSTORES(y, 0) }
      if (kt + 4 < KT) { GLOADS(y, (kt + 4) * 64) }
      MFMAS()
      __syncthreads();
      __builtin_amdgcn_sched_barrier(0);
    }
#undef FRAGS
#undef MFMAS
#undef GLOADS
#undef LSTORES
    {
      float* Cs = (float*)smem;
      const int er = tid >> 4, ec = (tid & 15) * 8;
      const int jm = (m0 < NTOK_P) ? 0 : 1 + ((m0 - NTOK_P) >> 12);
      float4 px[8][2];
      uint4 pz[8][2];
      if (EPI == EPI_RES) {
        const float* xsrc;
        if (l == 0) xsrc = (m0 < NTOK_P) ? p.in[I_XP] : p.in[I_XS] - (size_t)NTOK_P * DM;
        else xsrc = p.out;
#pragma unroll
        for (int ps = 0; ps < 8; ++ps) {
          const float* xp_ = xsrc + (size_t)(m0 + ps * 16 + er) * DM + n0 + ec;
          px[ps][0] = *(const float4*)xp_; px[ps][1] = *(const float4*)(xp_ + 4);
        }
      } else if (EPI == EPI_GLU) {
        const bf16_t* Pz = (const bf16_t*)(p.ws + OFF_P);
        const bf16_t* Z5z = (const bf16_t*)(p.ws + OFF_Z5);
#pragma unroll
        for (int ps = 0; ps < 8; ++ps) {
          const size_t gr = (size_t)(m0 + ps * 16 + er);
          pz[ps][0] = *(const uint4*)(Z5z + gr * 512 + n0 + ec);
          pz[ps][1] = *(const uint4*)(Pz + gr * LDP_E + PE_ZS + n0 + ec);
        }
      }
#pragma unroll
      for (int q = 0; q < 16; ++q) {
        const int rr = wm * 64 + crow(q, h), cc = wn * 64 + r;
        Cs[rr * 132 + cc] = acc00[q];
        Cs[rr * 132 + cc + 32] = acc01[q];
        Cs[(rr + 32) * 132 + cc] = acc10[q];
        Cs[(rr + 32) * 132 + cc + 32] = acc11[q];
      }
      __syncthreads();
#pragma unroll
      for (int ps = 0; ps < 8; ++ps) {
        const int row = ps * 16 + er;
        const float4 c0 = *(const float4*)(Cs + row * 132 + ec);
        const float4 c1 = *(const float4*)(Cs + row * 132 + ec + 4);
        const size_t grow = (size_t)(m0 + row);
        const int gcol = n0 + ec;
        if (EPI == EPI_P) {
          bf16_t* P = (bf16_t*)(p.ws + OFF_P);
          *(uint4*)(P + grow * ldp + gcol) = make_uint4(pack2(c0.x, c0.y), pack2(c0.z, c0.w), pack2(c1.x, c1.y), pack2(c1.z, c1.w));
        } else if (EPI == EPI_RES) {
          const float* gate = MOD + (l * 5 + jm) * 3072 + 2048 + gcol;
          const float4 g0 = *(const float4*)gate, g1 = *(const float4*)(gate + 4);
          const float4 x0 = px[ps][0], x1 = px[ps][1];
          float4 o0, o1;
          o0.x = x0.x + g0.x * c0.x; o0.y = x0.y + g0.y * c0.y; o0.z = x0.z + g0.z * c0.z; o0.w = x0.w + g0.w * c0.w;
          o1.x = x1.x + g1.x * c1.x; o1.y = x1.y + g1.y * c1.y; o1.z = x1.z + g1.z * c1.z; o1.w = x1.w + g1.w * c1.w;
          *(float4*)(p.out + grow * DM + gcol) = o0;
          *(float4*)(p.out + grow * DM + gcol + 4) = o1;
        } else {
          const bf16_t* P = (const bf16_t*)(p.ws + OFF_P);
          const bf16_t* Z5 = (const bf16_t*)(p.ws + OFF_Z5);
          bf16_t* Y = (bf16_t*)(p.ws + OFF_HY);
          const float* bglu = p.in[I_BGLU] + (l >> 1) * 512 + gcol;
          const float4 b0 = *(const float4*)bglu, b1 = *(const float4*)(bglu + 4);
          const uint4 zv = pz[ps][0];
          const uint4 zs = pz[ps][1];
#define GLU1(ZW, SW, CA, CB, BA, BB) pack2(__uint_as_float((ZW) << 16) * sigmf((CA) + (BA)) * siluf(__uint_as_float((SW) << 16)), \
                                           __uint_as_float((ZW) & 0xffff0000u) * sigmf((CB) + (BB)) * siluf(__uint_as_float((SW) & 0xffff0000u)))
          uint4 o;
          o.x = GLU1(zv.x, zs.x, c0.x, c0.y, b0.x, b0.y);
          o.y = GLU1(zv.y, zs.y, c0.z, c0.w, b0.z, b0.w);
          o.z = GLU1(zv.z, zs.z, c1.x, c1.y, b1.x, b1.y);
          o.w = GLU1(zv.w, zs.w, c1.z, c1.w, b1.z, b1.w);
#undef GLU1
          *(uint4*)(Y + grow * DM + 512 + gcol) = o;
        }
      }
      __syncthreads();
    }
  }
}

#define GL 72
struct GlaSmem {
  bf16_t Qd[64 * GL];
  bf16_t Kn[64 * GL];
  bf16_t KdT[64 * GL];
  bf16_t Att[64 * GL];
  bf16_t VT[128 * GL];
  bf16_t ST[128 * GL];
  float lfS[64 * 16];
  float qtot[4 * 64];
  float Dl[64];
  float Gtot[64];
};
#define OLD 132
static_assert(sizeof(GlaSmem) <= SMEM_BYTES, "GLA smem");

template <bool FULL>
DI void gla_sweep(const Params& p, int e, int hd, int dir, int tok0, f32x16 (&sacc)[2], GlaSmem& S) {
  const int tid = otid(), lane = tid & 63, w = tid >> 6;
  const int r = lane & 31, h = lane >> 5;
  const bf16_t* P = (const bf16_t*)(p.ws + OFF_P);
  bf16_t* Y = (bf16_t*)(p.ws + OFF_HY);
  const int tq = tid >> 6;
  if (tid < 64) S.Gtot[tid] = 0.f;
  unsigned w2p[8];
  float bias;
  {
    const int d0 = tid & 63;
#pragma unroll
    for (int i = 0; i < 8; ++i)
      w2p[i] = pack2(p.in[I_GW2][((size_t)(e * 2 + dir) * 16 + 2 * i) * 256 + hd * 64 + d0],
                     p.in[I_GW2][((size_t)(e * 2 + dir) * 16 + 2 * i + 1) * 256 + hd * 64 + d0]);
    bias = p.in[I_GB2][(e * 2 + dir) * 256 + hd * 64 + d0];
  }
  __syncthreads();
  if (FULL) {
#pragma unroll
    for (int ni = 0; ni < 2; ++ni)
#pragma unroll
      for (int q = 0; q < 16; ++q) S.ST[(w * 32 + crow(q, h)) * GL + ni * 32 + r] = f2bf(sacc[ni][q]);
  }
  uint4 pq0, pq1, pk0, pk1;
  bf16_t plf[4];
  pq0 = pq1 = pk0 = pk1 = make_uint4(0, 0, 0, 0);
  plf[0] = plf[1] = plf[2] = plf[3] = 0;
#pragma unroll 1
  for (int cc = 0; cc < 4; ++cc) {
    const int c = dir ? 3 - cc : cc;
    const int ct0 = tok0 + c * 64;
    const int tv = tid & 63, cgp = tid >> 6;
    uint4 v0, v1, v2, v3;
    {
      const bf16_t* vsrc = P + (size_t)(ct0 + tv) * LDP_E + PE_V + hd * 128 + cgp * 32;
      v0 = *(const uint4*)(vsrc); v1 = *(const uint4*)(vsrc + 8); v2 = *(const uint4*)(vsrc + 16); v3 = *(const uint4*)(vsrc + 24);
    }
    {
      const int row = tid >> 2, c8 = (tid & 3) * 16;
      if (cc == 0) {
        const bf16_t* src = P + (size_t)(ct0 + row) * LDP_E + hd * 64 + c8;
        pk0 = *(const uint4*)(src + PE_K); pk1 = *(const uint4*)(src + PE_K + 8);
        if (FULL) { pq0 = *(const uint4*)(src + PE_Q); pq1 = *(const uint4*)(src + PE_Q + 8); }
#pragma unroll
        for (int i = 0; i < 4; ++i) {
          int idx = tid + 256 * i; int t = idx >> 4, rr = idx & 15;
          plf[i] = P[(size_t)(ct0 + t) * LDP_E + PE_LF + dir * 16 + rr];
        }
      }
#pragma unroll
      for (int i = 0; i < 4; ++i) S.lfS[tid + 256 * i] = bf2f(plf[i]);
      *(uint4*)(S.Kn + row * GL + c8) = pk0; *(uint4*)(S.Kn + row * GL + c8 + 8) = pk1;
      if (FULL) { *(uint4*)(S.Qd + row * GL + c8) = pq0; *(uint4*)(S.Qd + row * GL + c8 + 8) = pq1; }
      if (cc < 3) {
        const int cn = dir ? 2 - cc : cc + 1;
        const int cn0 = tok0 + cn * 64;
        const bf16_t* src = P + (size_t)(cn0 + row) * LDP_E + hd * 64 + c8;
        pk0 = *(const uint4*)(src + PE_K); pk1 = *(const uint4*)(src + PE_K + 8);
        if (FULL) { pq0 = *(const uint4*)(src + PE_Q); pq1 = *(const uint4*)(src + PE_Q + 8); }
#pragma unroll
        for (int i = 0; i < 4; ++i) {
          int idx = tid + 256 * i; int t = idx >> 4, rr = idx & 15;
          plf[i] = P[(size_t)(cn0 + t) * LDP_E + PE_LF + dir * 16 + rr];
        }
      }
    }
    __syncthreads();
    const int d = tid & 63;
    float w2r[16];
#pragma unroll
    for (int i = 0; i < 8; ++i) { w2r[2 * i] = __uint_as_float(w2p[i] << 16); w2r[2 * i + 1] = __uint_as_float(w2p[i] & 0xffff0000u); }
    float g[16];
    float run = 0.f;
#pragma unroll
    for (int i = 0; i < 16; ++i) {
      int t = tq * 16 + i;
      float x = bias;
#pragma unroll
      for (int rr = 0; rr < 16; ++rr) x += S.lfS[t * 16 + rr] * w2r[rr];
      float ls = fminf(x, 0.f) - __logf(1.f + __expf(-fabsf(x)));
      g[i] = ls * (1.f / 16.f);
      run += g[i];
    }
    S.qtot[tq * 64 + d] = run;
    __syncthreads();
    float q0 = S.qtot[d], q1 = S.qtot[64 + d], q2 = S.qtot[128 + d], q3 = S.qtot[192 + d];
    const float total = q0 + q1 + q2 + q3;
    float off;
    if (dir == 0) off = (tq > 0 ? q0 : 0.f) + (tq > 1 ? q1 : 0.f) + (tq > 2 ? q2 : 0.f);
    else off = (tq < 1 ? q1 : 0.f) + (tq < 2 ? q2 : 0.f) + (tq < 3 ? q3 : 0.f);
    float b[16];
    if (dir == 0) {
      float a = off;
#pragma unroll
      for (int i = 0; i < 16; ++i) { a += g[i]; b[i] = a; }
    } else {
      float a = off;
#pragma unroll
      for (int i = 15; i >= 0; --i) { a += g[i]; b[i] = a; }
    }
    if (tq == 0) { S.Dl[d] = __expf(total); S.Gtot[d] += total; }
    {
      unsigned kd[8];
      float kprev = 0.f;
#pragma unroll
      for (int i = 0; i < 16; ++i) {
        int t = tq * 16 + i;
        float kv = bf2f(S.Kn[t * GL + d]);
        if (FULL) {
          float qv = bf2f(S.Qd[t * GL + d]);
          S.Qd[t * GL + d] = f2bf(qv * 0.125f * __expf(b[i]));
          S.Kn[t * GL + d] = f2bf(kv * __expf(-b[i]));
        }
        float kdv = kv * __expf(total - b[i]);
        if (i & 1) kd[i >> 1] = pack2(kprev, kdv); else kprev = kdv;
      }
      uint4* dst = (uint4*)(S.KdT + d * GL + tq * 16);
      dst[0] = make_uint4(kd[0], kd[1], kd[2], kd[3]);
      dst[1] = make_uint4(kd[4], kd[5], kd[6], kd[7]);
    }
    {
      bf16_t* vd = S.VT + (cgp * 32) * GL + tv;
#define VTW(VV, B) vd[((B) + 0) * GL] = (bf16_t)(VV.x & 0xffffu); vd[((B) + 1) * GL] = (bf16_t)(VV.x >> 16); \
                   vd[((B) + 2) * GL] = (bf16_t)(VV.y & 0xffffu); vd[((B) + 3) * GL] = (bf16_t)(VV.y >> 16); \
                   vd[((B) + 4) * GL] = (bf16_t)(VV.z & 0xffffu); vd[((B) + 5) * GL] = (bf16_t)(VV.z >> 16); \
                   vd[((B) + 6) * GL] = (bf16_t)(VV.w & 0xffffu); vd[((B) + 7) * GL] = (bf16_t)(VV.w >> 16);
      VTW(v0, 0) VTW(v1, 8) VTW(v2, 16) VTW(v3, 24)
#undef VTW
    }
    __syncthreads();
    const int mi = w >> 1;
    f32x16 oacc[2];
    bf16_t* orec = Y + (size_t)(ct0 + mi * 32 + h * 16 + (r >> 1)) * DM + hd * 128 + (w & 1) * 64 + (r & 1) * 16;
    uint4 of0 = make_uint4(0, 0, 0, 0), of1 = of0, of2 = of0, of3 = of0, zg0 = of0, zg1 = of0, zg2 = of0, zg3 = of0;
    if (FULL && dir) {
      of0 = *(const uint4*)(orec); of1 = *(const uint4*)(orec + 8);
      of2 = *(const uint4*)(orec + 32); of3 = *(const uint4*)(orec + 40);
      const bf16_t* zg = P + (size_t)(ct0 + (tid >> 2)) * LDP_E + PE_ZG + hd * 128 + (tid & 3) * 32;
      zg0 = *(const uint4*)(zg); zg1 = *(const uint4*)(zg + 8); zg2 = *(const uint4*)(zg + 16); zg3 = *(const uint4*)(zg + 24);
    }
    if (FULL) {
      const int ni = w & 1;
      const bool skip = dir ? (ni < mi) : (ni > mi);
      f32x16 a = zero16();
      if (!skip) mma_tile<64>(a, S.Qd + mi * 32 * GL, GL, S.Kn + ni * 32 * GL, GL, lane);
#pragma unroll
      for (int q = 0; q < 16; ++q) {
        int i = mi * 32 + crow(q, h), j = ni * 32 + r;
        bool keep = dir ? (j >= i) : (j <= i);
        S.Att[i * GL + j] = f2bf(keep ? a[q] : 0.f);
      }
#pragma unroll
      for (int jj = 0; jj < 2; ++jj) {
        int nj = (w & 1) * 2 + jj;
        oacc[jj] = zero16();
        mma_tile<64>(oacc[jj], S.Qd + mi * 32 * GL, GL, S.ST + nj * 32 * GL, GL, lane);
      }
      __syncthreads();
#pragma unroll
      for (int jj = 0; jj < 2; ++jj) {
        int nj = (w & 1) * 2 + jj;
        mma_tile<64>(oacc[jj], S.Att + mi * 32 * GL, GL, S.VT + nj * 32 * GL, GL, lane);
      }
    }
#pragma unroll
    for (int ni = 0; ni < 2; ++ni) {
      float dec = S.Dl[ni * 32 + r];
#pragma unroll
      for (int q = 0; q < 16; ++q) sacc[ni][q] *= dec;
      mma_tile<64>(sacc[ni], S.VT + w * 32 * GL, GL, S.KdT + ni * 32 * GL, GL, lane);
    }
    __syncthreads();
    if (FULL) {
#pragma unroll
      for (int ni = 0; ni < 2; ++ni)
#pragma unroll
        for (int q = 0; q < 16; ++q) S.ST[(w * 32 + crow(q, h)) * GL + ni * 32 + r] = f2bf(sacc[ni][q]);
      if (dir == 0) {
#pragma unroll
        for (int jj = 0; jj < 2; ++jj) {
          *(uint4*)(orec + jj * 32) = make_uint4(pack2(oacc[jj][0], oacc[jj][1]), pack2(oacc[jj][2], oacc[jj][3]), pack2(oacc[jj][4], oacc[jj][5]), pack2(oacc[jj][6], oacc[jj][7]));
          *(uint4*)(orec + jj * 32 + 8) = make_uint4(pack2(oacc[jj][8], oacc[jj][9]), pack2(oacc[jj][10], oacc[jj][11]), pack2(oacc[jj][12], oacc[jj][13]), pack2(oacc[jj][14], oacc[jj][15]));
        }
      } else {
        float* Ob = (float*)S.Qd;
        {
          const unsigned ofw[16] = {of0.x, of0.y, of0.z, of0.w, of1.x, of1.y, of1.z, of1.w, of2.x, of2.y, of2.z, of2.w, of3.x, of3.y, of3.z, of3.w};
#pragma unroll
          for (int jj = 0; jj < 2; ++jj) {
            int cl = ((w & 1) * 2 + jj) * 32 + r;
#pragma unroll
            for (int q = 0; q < 16; ++q) {
              int tl = mi * 32 + crow(q, h);
              const unsigned wv = ofw[jj * 8 + (q >> 1)];
              float prev = (q & 1) ? __uint_as_float(wv & 0xffff0000u) : __uint_as_float(wv << 16);
              Ob[tl * OLD + cl] = oacc[jj][q] + prev;
            }
          }
        }
        __syncthreads();
        {
          const int tl = tid >> 2, qtr = tid & 3;
          float ss = 0.f;
#pragma unroll
          for (int i = 0; i < 32; ++i) { float v = Ob[tl * OLD + qtr * 32 + i]; ss += v * v; }
          ss += __shfl_xor(ss, 1);
          ss += __shfl_xor(ss, 2);
          const float rstd = rsqrtf(ss * (1.f / 128.f) + EPSF);
          const float* onw = p.in[I_GON] + e * 128 + qtr * 32;
          bf16_t* yo = Y + (size_t)(ct0 + tl) * DM + hd * 128 + qtr * 32;
          const unsigned zgw[16] = {zg0.x, zg0.y, zg0.z, zg0.w, zg1.x, zg1.y, zg1.z, zg1.w, zg2.x, zg2.y, zg2.z, zg2.w, zg3.x, zg3.y, zg3.z, zg3.w};
#pragma unroll
          for (int i = 0; i < 32; i += 2) {
            unsigned zz = zgw[i >> 1];
            float y0 = Ob[tl * OLD + qtr * 32 + i] * rstd * onw[i] * siluf(__uint_as_float(zz << 16));
            float y1 = Ob[tl * OLD + qtr * 32 + i + 1] * rstd * onw[i + 1] * siluf(__uint_as_float(zz & 0xffff0000u));
            *(unsigned*)(yo + i) = pack2(y0, y1);
          }
        }
        __syncthreads();
      }
    }
  }
}

DI void gla_pass1_unit(const Params& p, int e, int u, char* smem) {
  GlaSmem& S = *(GlaSmem*)smem;
  const int tid = otid(), lane = tid & 63, w = tid >> 6;
  const int r = lane & 31, h = lane >> 5;
  const int seg = u >> 3, hd = (u >> 1) & 3, dir = u & 1;
  const int tok0 = NTOK_P + seg * 256;
  f32x16 sacc[2];
  sacc[0] = zero16(); sacc[1] = zero16();
  __syncthreads();
  gla_sweep<false>(p, e, hd, dir, tok0, sacc, S);
  float* L = (float*)(p.ws + OFF_GLAL) + (size_t)((seg * 4 + hd) * 2 + dir) * 8192;
#pragma unroll
  for (int ni = 0; ni < 2; ++ni)
#pragma unroll
    for (int q = 0; q < 16; ++q) L[(w * 32 + crow(q, h)) * 64 + ni * 32 + r] = sacc[ni][q];
  if (tid < 64) {
    float* D = (float*)(p.ws + OFF_GLAD) + ((seg * 4 + hd) * 2 + dir) * 64;
    D[tid] = expf(S.Gtot[tid]);
  }
  __syncthreads();
}

DI void gla_pass3_unit(const Params& p, int e, int u, char* smem) {
  GlaSmem& S = *(GlaSmem*)smem;
  const int tid = otid(), lane = tid & 63, w = tid >> 6;
  const int r = lane & 31, h = lane >> 5;
  const int seg = ((u >> 2) + 32) % 96, hd = u & 3;
  const int tok0 = seg * 256;
  const bool samp = seg >= 32;
  const int sb = samp ? (seg - 32) >> 4 : 0, sl = samp ? (seg - 32) & 15 : 0;
  const float* Lb = (const float*)(p.ws + OFF_GLAL);
  const float* Db = (const float*)(p.ws + OFF_GLAD);
  for (int dir = 0; dir < 2; ++dir) {
    f32x16 sacc[2];
    sacc[0] = zero16(); sacc[1] = zero16();
    if (samp) {
      const float* s0 = p.in[I_SGLA] + (size_t)(((sb * 2 + e) * 2 + dir) * 4 + hd) * 8192;
#pragma unroll
      for (int ni = 0; ni < 2; ++ni)
#pragma unroll
        for (int q = 0; q < 16; ++q) sacc[ni][q] = s0[(ni * 32 + r) * 128 + w * 32 + crow(q, h)];
      const int nst = dir ? 15 - sl : sl;
      float Lc[32], dc[2];
      {
        const int sp0 = dir ? 15 : 0;
        const int sidx0 = ((sb * 16 + sp0) * 4 + hd) * 2 + dir;
        const float* L0 = Lb + (size_t)sidx0 * 8192;
        const float* D0 = Db + sidx0 * 64;
#pragma unroll
        for (int ni = 0; ni < 2; ++ni) {
          dc[ni] = D0[ni * 32 + r];
#pragma unroll
          for (int q = 0; q < 16; ++q) Lc[ni * 16 + q] = L0[(w * 32 + crow(q, h)) * 64 + ni * 32 + r];
        }
      }
#pragma unroll 1
      for (int k = 0; k < nst; ++k) {
        float Ln[32], dn[2];
        const int kn = (k + 1 < nst) ? k + 1 : k;
        const int sp = dir ? 15 - kn : kn;
        const int sidx = ((sb * 16 + sp) * 4 + hd) * 2 + dir;
        const float* L = Lb + (size_t)sidx * 8192;
        const float* D = Db + sidx * 64;
#pragma unroll
        for (int ni = 0; ni < 2; ++ni) {
          dn[ni] = D[ni * 32 + r];
#pragma unroll
          for (int q = 0; q < 16; ++q) Ln[ni * 16 + q] = L[(w * 32 + crow(q, h)) * 64 + ni * 32 + r];
        }
#pragma unroll
        for (int ni = 0; ni < 2; ++ni)
#pragma unroll
          for (int q = 0; q < 16; ++q) sacc[ni][q] = sacc[ni][q] * dc[ni] + Lc[ni * 16 + q];
#pragma unroll
        for (int i = 0; i < 32; ++i) Lc[i] = Ln[i];
        dc[0] = dn[0]; dc[1] = dn[1];
      }
    }
    __syncthreads();
    gla_sweep<true>(p, e, hd, dir, tok0, sacc, S);
    if (!samp) {
      float* o = p.out + OUT_GLA + (size_t)(((seg * 2 + e) * 2 + dir) * 4 + hd) * 8192;
#pragma unroll
      for (int ni = 0; ni < 2; ++ni)
#pragma unroll
        for (int q = 0; q < 16; ++q) o[(ni * 32 + r) * 128 + w * 32 + crow(q, h)] = sacc[ni][q];
    }
    __syncthreads();
  }
}

#define XLD 136
#define WSYNC() do { __builtin_amdgcn_fence(__ATOMIC_RELEASE, "wavefront"); __builtin_amdgcn_wave_barrier(); __builtin_amdgcn_fence(__ATOMIC_ACQUIRE, "wavefront"); } while (0)
DI void s5_sweep(const Params& p, int e, int g, int dir, int mode, int tok0, float& hr, float& hi, bf16_t* X) {
  const int lane = otid() & 63;
  const int r = lane & 31, h = lane >> 5;
  const bf16_t* P = (const bf16_t*)(p.ws + OFF_P);
  bf16_t* Z5 = (bf16_t*)(p.ws + OFF_Z5);
  bf16_t* Yb = (bf16_t*)(p.ws + OFF_HY);
  const float* LB = (const float*)(p.ws + OFF_LB) + (size_t)(((e * 2 + dir) * 32 + g) * 64 + lane) * 2;
  const float lbr = LB[0], lbi = LB[1];
  const bf16_t* BBT = (const bf16_t*)(p.ws + OFF_BBT) + (size_t)((e * 2 + dir) * 32 + g) * 128 * 16;
  const bf16_t* CM = (const bf16_t*)(p.ws + OFF_CM) + (size_t)(e * 32 + g) * 32 * 128;
  bf16x8 bfr[4];
#pragma unroll
  for (int j = 0; j < 4; ++j) bfr[j] = *(const bf16x8*)(BBT + (32 * j + r) * 16 + 8 * h);
  bf16x8 cfr[8];
#pragma unroll
  for (int s = 0; s < 8; ++s) cfr[s] = *(const bf16x8*)(CM + r * 128 + s * 16 + h * 8);
  bf16x8 dfr;
  {
    const short dv = (r < 16) ? (short)f2bf(p.in[I_S5D][e * 512 + g * 16 + r]) : (short)0;
#pragma unroll
    for (int j = 0; j < 8; ++j) dfr[j] = (8 * h + j == r) ? dv : (short)0;
  }
  const bf16_t* Ub = P + (size_t)(tok0 + r) * LDP_E + PE_U + g * 16 + 8 * h;
  bf16x8 a_cur = *(const bf16x8*)(Ub + (size_t)((dir ? 7 : 0) * 32) * LDP_E);
#pragma unroll 1
  for (int ss = 0; ss < 8; ++ss) {
    const int sc = dir ? 7 - ss : ss;
    const int t0 = tok0 + sc * 32;
    bf16x8 a_nxt = a_cur;
    if (ss < 7) a_nxt = *(const bf16x8*)(Ub + (size_t)((dir ? 6 - ss : ss + 1) * 32) * LDP_E);
    bf16_t* prec = Yb + (size_t)(t0 + 16 * h + (r & 15)) * DM + 512 + g * 16;
    uint4 pp0 = make_uint4(0, 0, 0, 0), pp1 = make_uint4(0, 0, 0, 0);
    if (mode == 2 && r < 16) { pp0 = *(const uint4*)prec; pp1 = *(const uint4*)(prec + 8); }
#pragma unroll
    for (int jp = 0; jp < 2; ++jp) {
      f32x16 are = mfma(a_cur, bfr[2 * jp], zero16());
      f32x16 aim = mfma(a_cur, bfr[2 * jp + 1], zero16());
#pragma unroll
      for (int q = 0; q < 16; ++q) *(unsigned*)(X + crow(q, h) * XLD + 2 * (32 * jp + r)) = pack2(are[q], aim[q]);
    }
    WSYNC();
#define S5STEP(T) { float br = __uint_as_float(wv[T] << 16), bi = __uint_as_float(wv[T] & 0xffff0000u); \
        float nr = lbr * hr - lbi * hi + br; float ni = lbr * hi + lbi * hr + bi; hr = nr; hi = ni; wv[T] = pack2(nr, ni); }
#pragma unroll
    for (int hf = 0; hf < 2; ++hf) {
      bf16_t* Xh = X + ((dir ? 1 - hf : hf) * 16) * XLD + 2 * lane;
      unsigned wv[16];
#pragma unroll
      for (int tt = 0; tt < 16; ++tt) wv[tt] = *(const unsigned*)(Xh + tt * XLD);
      if (dir == 0) {
#pragma unroll
        for (int tt = 0; tt < 16; ++tt) S5STEP(tt)
      } else {
#pragma unroll
        for (int tt = 15; tt >= 0; --tt) S5STEP(tt)
      }
#pragma unroll
      for (int tt = 0; tt < 16; ++tt) *(unsigned*)(Xh + tt * XLD) = wv[tt];
    }
#undef S5STEP
    WSYNC();
    if (mode >= 1) {
      f32x16 acc = zero16();
#pragma unroll
      for (int s = 0; s < 8; ++s) {
        bf16x8 xa = *(const bf16x8*)(X + r * XLD + s * 16 + h * 8);
        acc = mfma(xa, cfr[s], acc);
      }
      if (mode == 2) acc = mfma(a_cur, dfr, acc);
      if (r < 16) {
        if (mode == 1) {
          *(uint4*)prec = make_uint4(pack2(acc[0], acc[1]), pack2(acc[2], acc[3]), pack2(acc[4], acc[5]), pack2(acc[6], acc[7]));
          *(uint4*)(prec + 8) = make_uint4(pack2(acc[8], acc[9]), pack2(acc[10], acc[11]), pack2(acc[12], acc[13]), pack2(acc[14], acc[15]));
        } else {
          const unsigned pw[8] = {pp0.x, pp0.y, pp0.z, pp0.w, pp1.x, pp1.y, pp1.z, pp1.w};
          const int col = g * 16 + r;
#pragma unroll
          for (int q = 0; q < 16; ++q) {
            const float prev = (q & 1) ? __uint_as_float(pw[q >> 1] & 0xffff0000u) : __uint_as_float(pw[q >> 1] << 16);
            const float y = acc[q] + prev;
            const float t3 = 1.5957691216057308f * (y + 0.044715f * y * y * y);
            Z5[(size_t)(t0 + crow(q, h)) * 512 + col] = f2bf(y * sigmf(t3));
          }
        }
      }
    }
    WSYNC();
    a_cur = a_nxt;
  }
}

DI void s5_pass1_unit(const Params& p, int e, int u, char* smem) {
  const int tid = otid(), lane = tid & 63, w = tid >> 6;
  const int seg = u >> 3, g = (u & 7) * 4 + w;
  bf16_t* X = (bf16_t*)smem + w * 32 * XLD;
  float* ES = (float*)(p.ws + OFF_S5ES);
  for (int dir = 0; dir < 2; ++dir) {
    float hr = 0.f, hi = 0.f;
    s5_sweep(p, e, g, dir, 0, NTOK_P + seg * 256, hr, hi, X);
    size_t o = ((size_t)((seg * 32 + g) * 2 + dir) * 64 + lane) * 2;
    ES[o] = hr; ES[o + 1] = hi;
  }
}

DI void s5_pass3_unit(const Params& p, int e, int u, char* smem) {
  const int tid = otid(), lane = tid & 63, w = tid >> 6;
  const int seg = u >> 3, g = (u & 7) * 4 + w;
  bf16_t* X = (bf16_t*)smem + w * 32 * XLD;
  const bool samp = seg >= 32;
  const int sb = samp ? (seg - 32) >> 4 : 0, sl = samp ? (seg - 32) & 15 : 0;
  const float* ES = (const float*)(p.ws + OFF_S5ES);
  for (int dir = 0; dir < 2; ++dir) {
    float hr = 0.f, hi = 0.f;
    if (samp) {
      const size_t si = (size_t)(((sb * 2 + e) * 2 + dir) * 32 + g) * 64 + lane;
      hr = p.in[I_S5R][si]; hi = p.in[I_S5I][si];
      const float* L2 = (const float*)(p.ws + OFF_LB256) + (size_t)(((e * 2 + dir) * 32 + g) * 64 + lane) * 2;
      const float ar = L2[0], ai = L2[1];
      const int nst = dir ? 15 - sl : sl;
      float er[15], ei[15];
#pragma unroll
      for (int k = 0; k < 15; ++k) {
        const int kk = k < nst ? k : 0;
        const int sp = dir ? 15 - kk : kk;
        size_t o = ((size_t)(((sb * 16 + sp) * 32 + g) * 2 + dir) * 64 + lane) * 2;
        float2 ev = *(const float2*)(ES + o);
        er[k] = ev.x; ei[k] = ev.y;
      }
#pragma unroll
      for (int k = 0; k < 15; ++k) {
        if (k < nst) {
          float nr = ar * hr - ai * hi + er[k];
          float ni = ar * hi + ai * hr + ei[k];
          hr = nr; hi = ni;
        }
      }
    }
    s5_sweep(p, e, g, dir, dir + 1, seg * 256, hr, hi, X);
    if (!samp) {
      const size_t so = (size_t)(((seg * 2 + e) * 2 + dir) * 32 + g) * 64 + lane;
      p.out[OUT_S5R + so] = hr;
      p.out[OUT_S5I + so] = hi;
    }
  }
}

#define AL 72
template <int W>
DI void qk_prep(const bf16_t* src, const float* nw, bool rope, int pos, float mult, int sub, const float* RT,
                bf16_t* dst, float* fdst) {
  float x[4][W];
#pragma unroll
  for (int c = 0; c < 4; ++c) {
    if (W == 4) {
      uint2 v = *(const uint2*)(src + 16 * c + 4 * sub);
      x[c][0] = __uint_as_float(v.x << 16); x[c][1] = __uint_as_float(v.x & 0xffff0000u);
      x[c][2] = __uint_as_float(v.y << 16); x[c][3] = __uint_as_float(v.y & 0xffff0000u);
    } else {
      uint4 v = *(const uint4*)(src + 16 * c + 8 * sub);
      x[c][0] = __uint_as_float(v.x << 16); x[c][1] = __uint_as_float(v.x & 0xffff0000u);
      x[c][2] = __uint_as_float(v.y << 16); x[c][3] = __uint_as_float(v.y & 0xffff0000u);
      x[c][4 % W] = __uint_as_float(v.z << 16); x[c][5 % W] = __uint_as_float(v.z & 0xffff0000u);
      x[c][6 % W] = __uint_as_float(v.w << 16); x[c][7 % W] = __uint_as_float(v.w & 0xffff0000u);
    }
  }
  float ss = 0.f;
#pragma unroll
  for (int c = 0; c < 4; ++c)
#pragma unroll
    for (int i = 0; i < W; ++i) ss += x[c][i] * x[c][i];
  ss += __shfl_xor(ss, 1);
  if (W == 4) ss += __shfl_xor(ss, 2);
  const float rstd = rsqrtf(ss * (1.f / 64.f) + EPSF);
#pragma unroll
  for (int c = 0; c < 4; ++c)
#pragma unroll
    for (int i = 0; i < W; ++i) x[c][i] *= rstd * nw[16 * c + W * sub + i];
  if (rope) {
    const int row = pos >> 6, col = pos & 63;
#pragma unroll
    for (int i = 0; i < W; ++i) {
      const int f = W * sub + i;
      float cs = RT[(row * 16 + f) * 2], sn = RT[(row * 16 + f) * 2 + 1];
      float x1 = x[0][i], x2 = x[1][i];
      x[0][i] = x1 * cs - x2 * sn; x[1][i] = x2 * cs + x1 * sn;
      cs = RT[(col * 16 + f) * 2]; sn = RT[(col * 16 + f) * 2 + 1];
      x1 = x[2][i]; x2 = x[3][i];
      x[2][i] = x1 * cs - x2 * sn; x[3][i] = x2 * cs + x1 * sn;
    }
  }
#pragma unroll
  for (int c = 0; c < 4; ++c)
#pragma unroll
    for (int i = 0; i < W; ++i) {
      dst[16 * c + W * sub + i] = f2bf(x[c][i] * mult);
      if (fdst) fdst[16 * c + W * sub + i] = x[c][i];
    }
}

DI void attn_unit(const Params& p, int e, int u, char* smem) {
  const int tid = otid(), lane = tid & 63, w = tid >> 6;
  const int r = lane & 31, h = lane >> 5;
  bf16_t* Ks = (bf16_t*)smem;
  bf16_t* Vt = Ks + 64 * AL;
  bf16_t* Qs = Vt + 64 * AL;
  const bf16_t* P = (const bf16_t*)(p.ws + OFF_P);
  bf16_t* Y = (bf16_t*)(p.ws + OFF_HY);
  const float* RT = (const float*)(p.ws + OFF_ROPE);
  const bool lat = u >= 512;
  int b, kvh, qb;
  if (!lat) { b = u >> 4; kvh = (u >> 3) & 1; qb = u & 7; }
  else { int v = u - 512; b = v >> 8; kvh = (v >> 7) & 1; qb = v & 127; }
  const int tokbase = lat ? NTOK_P + b * 4096 : b * 256;
  const int q0 = qb * 32;
  const int hq = kvh * 4 + w;
  __syncthreads();
  {
    const int qi = lane >> 1, sub = lane & 1;
    const bf16_t* src = P + (size_t)(tokbase + q0 + qi) * LDP_O + PO_Q + hq * 64;
    qk_prep<8>(src, p.in[I_QNW] + e * 64, lat, q0 + qi, 0.125f, sub, RT, Qs + (w * 32 + qi) * AL, nullptr);
  }
  __syncthreads();
  bf16x8 qf[4];
#pragma unroll
  for (int ks = 0; ks < 4; ++ks) qf[ks] = *(const bf16x8*)(Qs + (w * 32 + r) * AL + ks * 16 + h * 8);
  float m_run = p.in[I_SINK][e * 8 + hq];
  float l_run = 1.f;
  f32x16 o[2];
  o[0] = zero16(); o[1] = zero16();
  const int kbase = lat ? (((q0 - 128) >> 6) << 6) : 0;
  const int ntile = lat ? 9 : 4;
  bf16_t* Ks1 = Qs + 4 * 32 * AL;
  bf16_t* Vt1 = Ks1 + 64 * AL;
  const int keyk = tid >> 2, s4 = tid & 3;
  const int keyv = tid & 63, cq = tid >> 6;
  const bool wr = (!lat) && (qb == 0);
  float knw[16];
#pragma unroll
  for (int c = 0; c < 4; ++c)
#pragma unroll
    for (int i = 0; i < 4; ++i) knw[c * 4 + i] = p.in[I_KNW][e * 64 + 16 * c + 4 * s4 + i];
  float ccs[4], csn[4];
#pragma unroll
  for (int i = 0; i < 4; ++i) { ccs[i] = RT[(keyk * 16 + 4 * s4 + i) * 2]; csn[i] = RT[(keyk * 16 + 4 * s4 + i) * 2 + 1]; }
  uint4 rk0, rk1, rk2, rk3, rv0, rv1, rv2, rv3;
  float rrc[4] = {1.f, 1.f, 1.f, 1.f}, rrs[4] = {0.f, 0.f, 0.f, 0.f};
  rk0 = rk1 = rk2 = rk3 = rv0 = rv1 = rv2 = rv3 = make_uint4(0, 0, 0, 0);
  int tlo = 0, thi = ntile - 1;
  if (lat) {
    tlo = kbase < 0 ? (-kbase) >> 6 : 0;
    thi = 4;
    while (kbase + thi * 64 >= 4096) --thi;
  }
#define TILE_NEXT(ti) (lat ? ((ti) < thi ? (ti) + 1 : ((ti) < 5 ? 5 : (ti) + 1)) : (ti) + 1)
#define TILE_LOAD(ti) { \
    const bool fc_ = lat && (ti) >= 5; \
    const int kt0_ = fc_ ? ((ti) - 5) * 64 : kbase + (ti) * 64; \
    if (fc_) { \
      const float* ck = p.in[I_CK] + ((size_t)((b * 2 + e) * 2 + kvh) * 256 + kt0_ + keyk) * 64 + 4 * s4; \
      const float* cv = p.in[I_CV] + ((size_t)((b * 2 + e) * 2 + kvh) * 256 + kt0_ + keyv) * 64 + cq * 16; \
      rk0 = *(const uint4*)(ck); rk1 = *(const uint4*)(ck + 16); rk2 = *(const uint4*)(ck + 32); rk3 = *(const uint4*)(ck + 48); \
      rv0 = *(const uint4*)(cv); rv1 = *(const uint4*)(cv + 4); rv2 = *(const uint4*)(cv + 8); rv3 = *(const uint4*)(cv + 12); \
    } else { \
      const bf16_t* ksrc = P + (size_t)(tokbase + kt0_ + keyk) * LDP_O + PO_K + kvh * 64 + 4 * s4; \
      const bf16_t* vsrc = P + (size_t)(tokbase + kt0_ + keyv) * LDP_O + PO_V + kvh * 64 + cq * 16; \
      uint2 t0_ = *(const uint2*)(ksrc), t1_ = *(const uint2*)(ksrc + 16), t2_ = *(const uint2*)(ksrc + 32), t3_ = *(const uint2*)(ksrc + 48); \
      rk0.x = t0_.x; rk0.y = t0_.y; rk1.x = t1_.x; rk1.y = t1_.y; rk2.x = t2_.x; rk2.y = t2_.y; rk3.x = t3_.x; rk3.y = t3_.y; \
      rv0 = *(const uint4*)(vsrc); rv1 = *(const uint4*)(vsrc + 8); \
      if (lat) { \
        const int row_ = kt0_ >> 6; \
        _Pragma("unroll") for (int i = 0; i < 4; ++i) { rrc[i] = RT[(row_ * 16 + 4 * s4 + i) * 2]; rrs[i] = RT[(row_ * 16 + 4 * s4 + i) * 2 + 1]; } \
      } \
    } }
#define VT4(VD, W0, W1) { (VD)[0] = (bf16_t)((W0) & 0xffffu); (VD)[AL] = (bf16_t)((W0) >> 16); (VD)[2 * AL] = (bf16_t)((W1) & 0xffffu); (VD)[3 * AL] = (bf16_t)((W1) >> 16); }
#define TILE_STORE(ti, KB, VB) { \
    const bool fc_ = lat && (ti) >= 5; \
    const int kt0_ = fc_ ? ((ti) - 5) * 64 : kbase + (ti) * 64; \
    if (fc_) { \
      bf16_t* kd = (KB) + keyk * AL + 4 * s4; \
      *(uint2*)(kd) = make_uint2(pack2(__uint_as_float(rk0.x), __uint_as_float(rk0.y)), pack2(__uint_as_float(rk0.z), __uint_as_float(rk0.w))); \
      *(uint2*)(kd + 16) = make_uint2(pack2(__uint_as_float(rk1.x), __uint_as_float(rk1.y)), pack2(__uint_as_float(rk1.z), __uint_as_float(rk1.w))); \
      *(uint2*)(kd + 32) = make_uint2(pack2(__uint_as_float(rk2.x), __uint_as_float(rk2.y)), pack2(__uint_as_float(rk2.z), __uint_as_float(rk2.w))); \
      *(uint2*)(kd + 48) = make_uint2(pack2(__uint_as_float(rk3.x), __uint_as_float(rk3.y)), pack2(__uint_as_float(rk3.z), __uint_as_float(rk3.w))); \
      bf16_t* vd = (VB) + (cq * 16) * AL + keyv; \
      VT4(vd, pack2(__uint_as_float(rv0.x), __uint_as_float(rv0.y)), pack2(__uint_as_float(rv0.z), __uint_as_float(rv0.w))) \
      VT4(vd + 4 * AL, pack2(__uint_as_float(rv1.x), __uint_as_float(rv1.y)), pack2(__uint_as_float(rv1.z), __uint_as_float(rv1.w))) \
      VT4(vd + 8 * AL, pack2(__uint_as_float(rv2.x), __uint_as_float(rv2.y)), pack2(__uint_as_float(rv2.z), __uint_as_float(rv2.w))) \
      VT4(vd + 12 * AL, pack2(__uint_as_float(rv3.x), __uint_as_float(rv3.y)), pack2(__uint_as_float(rv3.z), __uint_as_float(rv3.w))) \
    } else { \
      float x[4][4]; \
      const unsigned kw[8] = {rk0.x, rk0.y, rk1.x, rk1.y, rk2.x, rk2.y, rk3.x, rk3.y}; \
      _Pragma("unroll") for (int c = 0; c < 4; ++c) { \
        x[c][0] = __uint_as_float(kw[2 * c] << 16); x[c][1] = __uint_as_float(kw[2 * c] & 0xffff0000u); \
        x[c][2] = __uint_as_float(kw[2 * c + 1] << 16); x[c][3] = __uint_as_float(kw[2 * c + 1] & 0xffff0000u); } \
      float ss = 0.f; \
      _Pragma("unroll") for (int c = 0; c < 4; ++c) _Pragma("unroll") for (int i = 0; i < 4; ++i) ss += x[c][i] * x[c][i]; \
      ss += __shfl_xor(ss, 1); ss += __shfl_xor(ss, 2); \
      const float rstd = rsqrtf(ss * (1.f / 64.f) + EPSF); \
      _Pragma("unroll") for (int c = 0; c < 4; ++c) _Pragma("unroll") for (int i = 0; i < 4; ++i) x[c][i] *= rstd * knw[c * 4 + i]; \
      if (lat) { \
        _Pragma("unroll") for (int i = 0; i < 4; ++i) { \
          float x1 = x[0][i], x2 = x[1][i]; x[0][i] = x1 * rrc[i] - x2 * rrs[i]; x[1][i] = x2 * rrc[i] + x1 * rrs[i]; \
          x1 = x[2][i]; x2 = x[3][i]; x[2][i] = x1 * ccs[i] - x2 * csn[i]; x[3][i] = x2 * ccs[i] + x1 * csn[i]; } \
      } \
      bf16_t* kd = (KB) + keyk * AL + 4 * s4; \
      _Pragma("unroll") for (int c = 0; c < 4; ++c) *(uint2*)(kd + 16 * c) = make_uint2(pack2(x[c][0], x[c][1]), pack2(x[c][2], x[c][3])); \
      if (wr) { \
        float* fd = p.out + OUT_CK + ((size_t)((b * 2 + e) * 2 + kvh) * 256 + kt0_ + keyk) * 64 + 4 * s4; \
        _Pragma("unroll") for (int c = 0; c < 4; ++c) *(float4*)(fd + 16 * c) = make_float4(x[c][0], x[c][1], x[c][2], x[c][3]); \
        float* fv = p.out + OUT_CV + ((size_t)((b * 2 + e) * 2 + kvh) * 256 + kt0_ + keyv) * 64 + cq * 16; \
        *(float4*)(fv) = make_float4(__uint_as_float(rv0.x << 16), __uint_as_float(rv0.x & 0xffff0000u), __uint_as_float(rv0.y << 16), __uint_as_float(rv0.y & 0xffff0000u)); \
        *(float4*)(fv + 4) = make_float4(__uint_as_float(rv0.z << 16), __uint_as_float(rv0.z & 0xffff0000u), __uint_as_float(rv0.w << 16), __uint_as_float(rv0.w & 0xffff0000u)); \
        *(float4*)(fv + 8) = make_float4(__uint_as_float(rv1.x << 16), __uint_as_float(rv1.x & 0xffff0000u), __uint_as_float(rv1.y << 16), __uint_as_float(rv1.y & 0xffff0000u)); \
        *(float4*)(fv + 12) = make_float4(__uint_as_float(rv1.z << 16), __uint_as_float(rv1.z & 0xffff0000u), __uint_as_float(rv1.w << 16), __uint_as_float(rv1.w & 0xffff0000u)); \
      } \
      bf16_t* vd = (VB) + (cq * 16) * AL + keyv; \
      VT4(vd, rv0.x, rv0.y) VT4(vd + 4 * AL, rv0.z, rv0.w) VT4(vd + 8 * AL, rv1.x, rv1.y) VT4(vd + 12 * AL, rv1.z, rv1.w) \
    } }
  int cur = 0;
  {
    TILE_LOAD(tlo)
    TILE_STORE(tlo, Ks, Vt)
  }
  __syncthreads();
  for (int ti = tlo; ti < ntile;) {
    const bool fromcache = lat && ti >= 5;
    const int kt0 = fromcache ? (ti - 5) * 64 : kbase + ti * 64;
    const int tn = TILE_NEXT(ti);
    if (tn < ntile) { TILE_LOAD(tn) }
    const bf16_t* Kc = cur ? Ks1 : Ks;
    const bf16_t* Vc = cur ? Vt1 : Vt;
    f32x16 s[2];
#pragma unroll
    for (int mt = 0; mt < 2; ++mt) {
      s[mt] = zero16();
#pragma unroll
      for (int ks = 0; ks < 4; ++ks) {
        bf16x8 a = *(const bf16x8*)(Kc + (mt * 32 + r) * AL + ks * 16 + h * 8);
        s[mt] = mfma(a, qf[ks], s[mt]);
      }
    }
    if (lat && !fromcache) {
      const int qpos = q0 + r;
#pragma unroll
      for (int mt = 0; mt < 2; ++mt)
#pragma unroll
        for (int q = 0; q < 16; ++q) {
          int kpos = kt0 + mt * 32 + crow(q, h);
          int dd = kpos - qpos;
          if (dd > 128 || dd < -128) s[mt][q] = -1e30f;
        }
    }
    float mx = -3e38f;
#pragma unroll
    for (int mt = 0; mt < 2; ++mt)
#pragma unroll
      for (int q = 0; q < 16; ++q) mx = fmaxf(mx, s[mt][q]);
    mx = fmaxf(mx, __shfl_xor(mx, 32));
    const float m_new = fmaxf(m_run, mx);
    const float alpha = __expf(m_run - m_new);
    float rs = 0.f;
#pragma unroll
    for (int mt = 0; mt < 2; ++mt)
#pragma unroll
      for (int q = 0; q < 16; ++q) { float pv = __expf(s[mt][q] - m_new); s[mt][q] = pv; rs += pv; }
    rs += __shfl_xor(rs, 32);
    l_run = l_run * alpha + rs;
    m_run = m_new;
#pragma unroll
    for (int q = 0; q < 16; ++q) { o[0][q] *= alpha; o[1][q] *= alpha; }
#pragma unroll
    for (int mt = 0; mt < 2; ++mt)
#pragma unroll
      for (int sx = 0; sx < 2; ++sx) {
        bf16x8 pf;
#pragma unroll
        for (int j = 0; j < 8; ++j) pf[j] = (short)f2bf(s[mt][8 * sx + j]);
#pragma unroll
        for (int dvt = 0; dvt < 2; ++dvt) {
          const bf16_t* vp = Vc + (dvt * 32 + r) * AL + mt * 32 + 16 * sx + 4 * h;
          s16x4 lo = *(const s16x4*)vp;
          s16x4 hi4 = *(const s16x4*)(vp + 8);
          bf16x8 a = __builtin_shufflevector(lo, hi4, 0, 1, 2, 3, 4, 5, 6, 7);
          o[dvt] = mfma(a, pf, o[dvt]);
        }
      }
      if (tn < ntile) {
      if (cur) { TILE_STORE(tn, Ks, Vt) } else { TILE_STORE(tn, Ks1, Vt1) }
    }
    __syncthreads();
    ti = tn;
    cur ^= 1;
  }
#undef TILE_NEXT
#undef TILE_LOAD
#undef TILE_STORE
#undef VT4
  const float inv = 1.f / l_run;
  const int tok = tokbase + q0 + r;
#pragma unroll
  for (int dvt = 0; dvt < 2; ++dvt)
#pragma unroll
    for (int g4 = 0; g4 < 4; ++g4) {
      const int dv = dvt * 32 + 8 * g4 + 4 * h;
      uint2 zz = *(const uint2*)(P + (size_t)tok * LDP_O + PO_ZA + hq * 64 + dv);
      float z0 = __uint_as_float(zz.x << 16), z1 = __uint_as_float(zz.x & 0xffff0000u);
      float z2 = __uint_as_float(zz.y << 16), z3 = __uint_as_float(zz.y & 0xffff0000u);
      float y0 = o[dvt][4 * g4 + 0] * inv * siluf(z0);
      float y1 = o[dvt][4 * g4 + 1] * inv * siluf(z1);
      float y2 = o[dvt][4 * g4 + 2] * inv * siluf(z2);
      float y3 = o[dvt][4 * g4 + 3] * inv * siluf(z3);
      *(uint2*)(Y + (size_t)tok * DM + hq * 64 + dv) = make_uint2(pack2(y0, y1), pack2(y2, y3));
    }
}

DI void conv_unit(const Params& p, int e, int u) {
  const int tid = otid();
  const bf16_t* P = (const bf16_t*)(p.ws + OFF_P);
  bf16_t* Y = (bf16_t*)(p.ws + OFF_HY);
  const int t0 = u * 16;
  const int c = tid * 2;
  int seg0, seg1;
  if (t0 < NTOK_P) { seg0 = t0 & ~255; seg1 = seg0 + 256; }
  else { seg0 = NTOK_P + ((t0 - NTOK_P) & ~4095); seg1 = seg0 + 4096; }
  const float* cw = p.in[I_CONVW] + (size_t)e * 3 * 512;
  const float w00 = cw[c], w01 = cw[c + 1], w10 = cw[512 + c], w11 = cw[512 + c + 1], w20 = cw[1024 + c], w21 = cw[1024 + c + 1];
  const float b0 = p.in[I_CONVB][e * 512 + c], b1 = p.in[I_CONVB][e * 512 + c + 1];
  auto prod = [&](int t, float& a, float& b) {
    if (t < seg0 || t >= seg1) { a = 0.f; b = 0.f; return; }
    unsigned xc = *(const unsigned*)(P + (size_t)t * LDP_O + PO_XC + c);
    unsigned cg_ = *(const unsigned*)(P + (size_t)t * LDP_O + PO_CG + c);
    a = __uint_as_float(xc << 16) * __uint_as_float(cg_ << 16);
    b = __uint_as_float(xc & 0xffff0000u) * __uint_as_float(cg_ & 0xffff0000u);
  };
  float pa0, pa1, pb0, pb1, pc0, pc1;
  prod(t0 - 1, pa0, pa1);
  prod(t0, pb0, pb1);
#pragma unroll
  for (int i = 0; i < 16; ++i) {
    const int t = t0 + i;
    prod(t + 1, pc0, pc1);
    unsigned bg = *(const unsigned*)(P + (size_t)t * LDP_O + PO_BG + c);
    unsigned zc = *(const unsigned*)(P + (size_t)t * LDP_O + PO_ZC + c);
    float y0 = __uint_as_float(bg << 16) * (w00 * pa0 + w10 * pb0 + w20 * pc0 + b0) * siluf(__uint_as_float(zc << 16));
    float y1 = __uint_as_float(bg & 0xffff0000u) * (w01 * pa1 + w11 * pb1 + w21 * pc1 + b1) * siluf(__uint_as_float(zc & 0xffff0000u));
    *(unsigned*)(Y + (size_t)t * DM + 512 + c) = pack2(y0, y1);
    pa0 = pb0; pa1 = pb1; pb0 = pc0; pb1 = pc1;
  }
}


#define QCTR(l, ph) ((unsigned*)(p.ws + OFF_BAR) + 3584 + 16 * ((l) * 4 + (ph)))
DI int next_unit(unsigned* ctr, volatile int* sh) {
  __syncthreads();
  if (threadIdx.x == 0) *sh = (int)atomicAdd(ctr, 1u);
  __syncthreads();
  return *sh;
}
#ifndef REP_A
#define REP_A 1
#endif
#ifndef REP_INPROJ
#define REP_INPROJ 1
#endif
#ifndef REP_EVEN
#define REP_EVEN 1
#endif
#ifndef REP_ODD
#define REP_ODD 1
#endif
#define REP_G1 1
#define REP_S1 1
#define REP_G3 1
#define REP_S3 1
#ifndef REP_SYNC
#define REP_SYNC 1
#endif
#define GSYNC() do { _Pragma("unroll 1") for (int rs_ = 0; rs_ < REP_SYNC; ++rs_) xcd_barrier(xb); } while (0)
__global__ void __launch_bounds__(256, 2) fwd_megakernel(Params p) {
  cg::grid_group grid = cg::this_grid();
  __shared__ __attribute__((aligned(16))) char smem[SMEM_BYTES];
  __shared__ uint4 xb_words;
  __shared__ int qsh;
  if (threadIdx.x == 0) xb_words = make_uint4(0u, 0u, 0u, 0u);
  __syncthreads();
  XcdBarrier xb = xcd_barrier_post((unsigned*)(p.ws + OFF_BAR), (volatile LAS unsigned*)&xb_words);
  if (p.ws == nullptr) grid.sync();
  phase0(p, smem);
  GSYNC();
#pragma unroll 1
  for (int l = 0; l < 4; ++l) {
    const int e = l >> 1;
#pragma unroll 1
    for (int rep = 0; rep < REP_A; ++rep) {
      phaseA(p, l);
      GSYNC();
    }
    const int odd = l & 1;
#pragma unroll 1
    for (int rep = 0; rep < REP_INPROJ; ++rep) {
      gemm_phase<EPI_P, 16>(p, l, (const bf16_t*)(p.ws + OFF_HY), DM, (const bf16_t*)(p.ws + OFF_WIN), DM, odd ? LDP_O / 128 : LDP_E / 128, odd ? LDP_O : LDP_E, smem);
      GSYNC();
    }
    if (!odd) {
#pragma unroll 1
      for (int rep = 0; rep < REP_EVEN; ++rep) {
        for (int u = next_unit(QCTR(l, 0), &qsh); u < 512 + 512; u = next_unit(QCTR(l, 0), &qsh)) {
          if (u < 512) { _Pragma("unroll 1") for (int r2 = 0; r2 < REP_G1; ++r2) gla_pass1_unit(p, e, u, smem); }
          else { _Pragma("unroll 1") for (int r2 = 0; r2 < REP_S1; ++r2) s5_pass1_unit(p, e, u - 512, smem); }
        }
        GSYNC();
        for (int u = next_unit(QCTR(l, 1), &qsh); u < 384 + 768; u = next_unit(QCTR(l, 1), &qsh)) {
          if (u < 384) { _Pragma("unroll 1") for (int r2 = 0; r2 < REP_G3; ++r2) gla_pass3_unit(p, e, u, smem); }
          else { _Pragma("unroll 1") for (int r2 = 0; r2 < REP_S3; ++r2) s5_pass3_unit(p, e, u - 384, smem); }
        }
        GSYNC();
        gemm_phase<EPI_GLU, 8>(p, l, (const bf16_t*)(p.ws + OFF_Z5), 512, (const bf16_t*)(p.ws + OFF_WGLU), 512, 4, 0, smem);
        GSYNC();
      }
    } else {
#pragma unroll 1
      for (int rep = 0; rep < REP_ODD; ++rep) {
        for (int u = next_unit(QCTR(l, 2), &qsh); u < 1536 + 1536; u = next_unit(QCTR(l, 2), &qsh)) {
          if (u < 1024) attn_unit(p, e, u + 512, smem);
          else if (u < 1536) attn_unit(p, e, u - 1024, smem);
          else conv_unit(p, e, u - 1536);
        }
        GSYNC();
      }
    }
    gemm_phase<EPI_RES, 16>(p, l, (const bf16_t*)(p.ws + OFF_HY), DM, (const bf16_t*)(p.ws + OFF_WOUT), DM, 8, 0, smem);
    if (l < 3) GSYNC();
  }
}

extern "C" void kernel_launch(void* const* d_in, const int* in_sizes, int n_in, void* d_out, int out_size,
                              void* d_ws, size_t ws_size, hipStream_t stream) {
  static int grid_blocks = 0;
  if (!grid_blocks) {
    int dev = 0, cus = 0, per_cu = 0;
    hipGetDevice(&dev);
    hipDeviceGetAttribute(&cus, hipDeviceAttributeMultiprocessorCount, dev);
    hipOccupancyMaxActiveBlocksPerMultiprocessor(&per_cu, fwd_megakernel, 256, 0);
    if (per_cu > 2) per_cu = 2;
    if (per_cu < 1) per_cu = 1;
    grid_blocks = cus * per_cu;
  }
  if (ws_size < WS_NEED || n_in < 34) { fprintf(stderr, "workspace too small\n"); return; }
  Params p{};
  for (int i = 0; i < 34; ++i) p.in[i] = (const float*)d_in[i];
  p.out = (float*)d_out;
  p.ws = (char*)d_ws;
  (void)hipMemsetAsync((char*)d_ws + OFF_BAR, 0, 16384, stream);
  void* args[] = {&p};
  hipError_t err = hipLaunchCooperativeKernel((void*)fwd_megakernel, dim3(grid_blocks), dim3(256), args, 0, stream);
  if (err != hipSuccess) fprintf(stderr, "cooperative launch failed: %s (grid %d)\n", hipGetErrorString(err), grid_blocks);
}
```

```cpp
#include <hip/hip_runtime.h>
#include <hip/hip_cooperative_groups.h>
#include <cstdio>
namespace cg = cooperative_groups;

typedef unsigned short bf16_t;
using bf16x8 = __attribute__((ext_vector_type(8))) short;
using s16x4  = __attribute__((ext_vector_type(4))) short;
using f32x16 = __attribute__((ext_vector_type(16))) float;
#define DI __device__ __forceinline__

#define NTOK    24576
#define NTOK_P  8192
#define DM      1024
#define LDP_E   2688
#define LDP_O   3328
#define EPSF    1e-6f

#define PE_Q   0
#define PE_K   256
#define PE_V   512
#define PE_ZG  1024
#define PE_U   1536
#define PE_ZS  2048
#define PE_LF  2560
#define PO_Q   0
#define PO_K   512
#define PO_V   640
#define PO_ZA  768
#define PO_XC  1280
#define PO_BG  1792
#define PO_CG  2304
#define PO_ZC  2816

#define OUT_GLA  25165824
#define OUT_S5R  29360128
#define OUT_S5I  29622272
#define OUT_CK   29884416
#define OUT_CV   31981568

#define OFF_WIN   0ull
#define OFF_WOUT  6815744ull
#define OFF_WGLU  8912896ull
#define OFF_MOD   9437184ull
#define OFF_LB    9682944ull
#define OFF_LB256 (OFF_LB + 65536ull)
#define OFF_BBT   (OFF_LB256 + 65536ull)
#define OFF_CM    (OFF_BBT + 524288ull)
#define OFF_ROPE  (OFF_CM + 524288ull)
#define OFF_S5ES  (OFF_ROPE + 8192ull)
#define OFF_GLAL  (OFF_S5ES + 2097152ull)
#define OFF_GLAD  (OFF_GLAL + 16777216ull)
#define OFF_HY    (OFF_GLAD + 131072ull)
#define OFF_P     (OFF_HY + 50331648ull)
#define OFF_Z5    (OFF_P + 132120576ull)
#define OFF_BAR   (OFF_P + 163577856ull)
#define WS_NEED   (OFF_BAR + 16384ull)

#define SMEM_BYTES 80896

struct Params {
  const float* in[34];
  float* out;
  char* ws;
};

enum { I_XP = 0, I_XS, I_C, I_SGLA, I_S5R, I_S5I, I_CK, I_CV, I_CCTX, I_NORMW, I_WADA, I_BADA, I_WINE, I_WOUTE,
       I_GW2, I_GB2, I_GON, I_LAMR, I_LAMI, I_LOGDT, I_BRE, I_BIM, I_CRE, I_CIM, I_S5D, I_WGLU, I_BGLU,
       I_WINO, I_WOUTO, I_QNW, I_KNW, I_SINK, I_CONVW, I_CONVB };

DI int otid() { int t = threadIdx.x; asm volatile("" : "+v"(t)); return t; }
typedef __bf16 hbf16x2 __attribute__((ext_vector_type(2)));
typedef float hf32x2 __attribute__((ext_vector_type(2)));
DI unsigned pack2(float a, float b) { hf32x2 v = {a, b}; return __builtin_bit_cast(unsigned, __builtin_convertvector(v, hbf16x2)); }
DI bf16_t f2bf(float x) { return (bf16_t)(pack2(x, x) & 0xffffu); }
DI float bf2f(bf16_t b) { return __uint_as_float(((unsigned)b) << 16); }
DI float siluf(float x) { return x * __builtin_amdgcn_rcpf(1.f + __expf(-x)); }
DI float sigmf(float x) { return __builtin_amdgcn_rcpf(1.f + __expf(-x)); }
DI int crow(int q, int h) { return (q & 3) + 8 * (q >> 2) + 4 * h; }
DI f32x16 mfma(bf16x8 a, bf16x8 b, f32x16 c) { return __builtin_amdgcn_mfma_f32_32x32x16_bf16(a, b, c, 0, 0, 0); }
DI f32x16 zero16() { f32x16 z; for (int i = 0; i < 16; ++i) z[i] = 0.f; return z; }

template <int K>
DI void mma_tile(f32x16& acc, const bf16_t* A, int lda, const bf16_t* Bt, int ldb, int lane) {
  const int r = lane & 31, h = lane >> 5;
#pragma unroll
  for (int s = 0; s < K / 16; ++s) {
    bf16x8 a = *(const bf16x8*)(A + r * lda + s * 16 + h * 8);
    bf16x8 b = *(const bf16x8*)(Bt + r * ldb + s * 16 + h * 8);
    acc = mfma(a, b, acc);
  }
}

#define XB_TMO      128
#define XB_XCNT(j)  (256  + 64 * (j))
#define XB_XSUB(j)  (1280 + 64 * (j))
#define XB_XGEN(j)  (2304 + 64 * (j))
#define XB_TOP      3328
#define XB_TOPGEN   3392
#define XCD_BAR_WORDS 3456
#define XB_SPIN_CAP (1u << 18)
#define LAS __attribute__((address_space(3)))

__device__ __forceinline__ unsigned xb_ld(unsigned* p)              { return __hip_atomic_load(p, __ATOMIC_RELAXED, __HIP_MEMORY_SCOPE_AGENT); }
__device__ __forceinline__ unsigned xb_add(unsigned* p, unsigned v) { return __hip_atomic_fetch_add(p, v, __ATOMIC_RELAXED, __HIP_MEMORY_SCOPE_AGENT); }
__device__ __forceinline__ unsigned xb_xcc_id() { return (unsigned)__builtin_amdgcn_s_getreg((3 << 11) | 20) & 0xFu; }
#define XB_SPIN(cond, bar) do { unsigned _sp = 0; while (cond) { __builtin_amdgcn_s_sleep(1); \
    if ((++_sp & 255u) == 0u) { if (xb_ld(&(bar)[XB_TMO])) break; if (_sp > XB_SPIN_CAP) { atomicAdd(&(bar)[XB_TMO], 1u); break; } } } } while (0)

struct XcdBarrier {
    unsigned* bar; unsigned x;
    volatile LAS unsigned* st;
};

__device__ __forceinline__ XcdBarrier xcd_barrier_post(unsigned* bar, volatile LAS unsigned* st) {
    XcdBarrier b; b.bar = bar; b.x = xb_xcc_id(); b.st = st;
    if (threadIdx.x == 0) (void)xb_add(&bar[XB_XCNT(b.x)], 1u);
    return b;
}
__device__ __forceinline__ void xcd_barrier_complete(unsigned* bar, unsigned x, unsigned& nloc, unsigned& nx) {
    const unsigned G = gridDim.x * gridDim.y * gridDim.z;
    unsigned sum, cnt, mine, sp = 0u;
    for (;;) {
        sum = 0u; cnt = 0u; mine = 0u;
#pragma unroll
        for (unsigned j = 0; j < 16; ++j) { const unsigned c = xb_ld(&bar[XB_XCNT(j)]); sum += c; cnt += (c > 0u) ? 1u : 0u; mine = (j == x) ? c : mine; }
        if (sum == G) break;
        __builtin_amdgcn_s_sleep(1);
        if ((++sp & 255u) == 0u) { if (xb_ld(&bar[XB_TMO])) break; if (sp > XB_SPIN_CAP) { atomicAdd(&bar[XB_TMO], 1u); break; } }
    }
    nloc = mine > 0u ? mine : 1u; nx = cnt > 0u ? cnt : 1u;
}

__device__ __forceinline__ void xcd_barrier(const XcdBarrier& b) {
    asm volatile("s_waitcnt vmcnt(0)" ::: "memory");
    __syncthreads();
    if (threadIdx.x == 0) {
        unsigned* bar = b.bar;
        __builtin_amdgcn_s_waitcnt(0);
        unsigned nloc = b.st[0], nx = b.st[1];
        if (nloc == 0u) { xcd_barrier_complete(bar, b.x, nloc, nx); b.st[0] = nloc; b.st[1] = nx; }
        const unsigned old = xb_add(&bar[XB_XSUB(b.x)], 1u);
        const unsigned gen = old / nloc;
        if (old + 1u == (gen + 1u) * nloc) {
            __builtin_amdgcn_fence(__ATOMIC_RELEASE, "agent");
            asm volatile("s_waitcnt vmcnt(0)" ::: "memory");
            const unsigned og = xb_add(&bar[XB_TOP], 1u);
            const unsigned tg = og / nx;
            if (og + 1u == (tg + 1u) * nx) xb_add(&bar[XB_TOPGEN], 1u);
            else XB_SPIN(xb_ld(&bar[XB_TOPGEN]) == tg, bar);
            __builtin_amdgcn_fence(__ATOMIC_ACQUIRE, "agent");
            xb_add(&bar[XB_XGEN(b.x)], 1u);
            asm volatile("s_waitcnt vmcnt(0)" ::: "memory");
        } else {
            XB_SPIN(xb_ld(&bar[XB_XGEN(b.x)]) == gen, bar);
            __builtin_amdgcn_fence(__ATOMIC_ACQUIRE, "agent");
            asm volatile("s_waitcnt vmcnt(0)" ::: "memory");
        }
    }
    __syncthreads();
}


DI void phase0(const Params& p, char* smem) {
  const int tid = otid();
  float* sc = (float*)smem;
  float* red = sc + 5 * 1024;
  float* MOD = (float*)(p.ws + OFF_MOD);
  const int NU = 384 + 128 + 1;
  for (int u = blockIdx.x; u < NU; u += gridDim.x) {
    if (u < 384) {
      const int l = u / 96, nc = u % 96;
      __syncthreads();
      for (int i = tid; i < 5 * 1024; i += 256) {
        int j = i >> 10, k = i & 1023;
        float v = (j == 0) ? p.in[I_CCTX][k] : p.in[I_C][(j - 1) * 1024 + k];
        sc[i] = v / (1.f + expf(-v));
      }
      __syncthreads();
      const int col = tid & 31, kg = tid >> 5;
      const float* w = p.in[I_WADA] + (size_t)l * 1024 * 3072 + nc * 32 + col;
      float a0 = 0, a1 = 0, a2 = 0, a3 = 0, a4 = 0;
#pragma unroll 16
      for (int k = kg; k < 1024; k += 8) {
        float wv = w[(size_t)k * 3072];
        a0 += sc[k] * wv; a1 += sc[1024 + k] * wv; a2 += sc[2048 + k] * wv; a3 += sc[3072 + k] * wv; a4 += sc[4096 + k] * wv;
      }
      red[(kg * 5 + 0) * 32 + col] = a0; red[(kg * 5 + 1) * 32 + col] = a1; red[(kg * 5 + 2) * 32 + col] = a2;
      red[(kg * 5 + 3) * 32 + col] = a3; red[(kg * 5 + 4) * 32 + col] = a4;
      __syncthreads();
      if (tid < 160) {
        int j = tid >> 5, c2 = tid & 31;
        float s = 0;
        for (int g = 0; g < 8; ++g) s += red[(g * 5 + j) * 32 + c2];
        int n = nc * 32 + c2;
        MOD[(l * 5 + j) * 3072 + n] = s + p.in[I_BADA][l * 3072 + n];
      }
    } else if (u < 384 + 128) {
      const int v = u - 384;
      const int e = v >> 6, dir = (v >> 5) & 1, g = v & 31;
      if (tid < 64) {
        const int pp = tid;
        const int idx = ((e * 2 + dir) * 32 + g) * 64 + pp;
        double dt = exp((double)p.in[I_LOGDT][(e * 2 + dir) * 32 + g]);
        double lr = (double)p.in[I_LAMR][idx], li = (double)p.in[I_LAMI][idx];
        double mag = exp(lr * dt);
        double ang = li * dt;
        double tw = 6.283185307179586476925286766559;
        double kq = rint(ang / tw);
        double ra = ang - kq * tw;
        double lbr = mag * cos(ra), lbi = mag * sin(ra);
        double den = lr * lr + li * li;
        double nr = lbr - 1.0, ni = lbi;
        double cr = (nr * lr + ni * li) / den, ci = (ni * lr - nr * li) / den;
        float* LB = (float*)(p.ws + OFF_LB);
        float* LB256 = (float*)(p.ws + OFF_LB256);
        LB[idx * 2] = (float)lbr; LB[idx * 2 + 1] = (float)lbi;
        double pr = lbr, pi = lbi;
        for (int i = 0; i < 8; ++i) { double t = pr * pr - pi * pi; pi = 2.0 * pr * pi; pr = t; }
        LB256[idx * 2] = (float)pr; LB256[idx * 2 + 1] = (float)pi;
        bf16_t* BBT = (bf16_t*)(p.ws + OFF_BBT) + (size_t)((e * 2 + dir) * 32 + g) * 128 * 16;
        const float* bre = p.in[I_BRE] + ((size_t)(e * 32 + g) * 64 + pp) * 16;
        const float* bim = p.in[I_BIM] + ((size_t)(e * 32 + g) * 64 + pp) * 16;
        for (int hh = 0; hh < 16; ++hh) {
          double br = bre[hh], bi = bim[hh];
          const int nre = (pp >> 5) * 64 + (pp & 31);
          BBT[nre * 16 + hh] = f2bf((float)(cr * br - ci * bi));
          BBT[(nre + 32) * 16 + hh] = f2bf((float)(cr * bi + ci * br));
        }
        if (dir == 0) {
          bf16_t* CM = (bf16_t*)(p.ws + OFF_CM) + (size_t)(e * 32 + g) * 32 * 128;
          for (int hh = 0; hh < 32; ++hh) {
            float cre = 0.f, cim = 0.f;
            if (hh < 16) {
              cre = p.in[I_CRE][((size_t)(e * 32 + g) * 16 + hh) * 64 + pp];
              cim = p.in[I_CIM][((size_t)(e * 32 + g) * 16 + hh) * 64 + pp];
            }
            CM[hh * 128 + 2 * pp] = f2bf(cre);
            CM[hh * 128 + 2 * pp + 1] = f2bf(-cim);
          }
        }
      }
    } else {
      float* RT = (float*)(p.ws + OFF_ROPE);
      for (int i = tid; i < 64 * 16; i += 256) {
        int pos = i >> 4, f = i & 15;
        double fr = exp(-(double)f / 16.0 * 9.2103403719761827360719658187375);
        double ang = (double)pos * fr;
        double tw = 6.283185307179586476925286766559;
        double ra = ang - rint(ang / tw) * tw;
        RT[i * 2] = (float)cos(ra); RT[i * 2 + 1] = (float)sin(ra);
      }
    }
  }
}

DI void convert_tile(const float* src, int nsrc, bf16_t* dst, int K, int n0, int k0, int mapmode, int tid) {
  const int n = n0 + (tid & 63), kq = tid >> 6;
  int sc = n;
  if (mapmode == 1) {
    if (n < 1024) sc = n;
    else if (n < 2560) sc = n + 32;
    else if (n < 2592) sc = n - 1536;
    else sc = -1;
  }
  unsigned w[8];
#pragma unroll
  for (int i = 0; i < 8; ++i) {
    int k = k0 + kq * 16 + 2 * i;
    float a = 0.f, b = 0.f;
    if (sc >= 0) { a = src[(size_t)k * nsrc + sc]; b = src[(size_t)(k + 1) * nsrc + sc]; }
    w[i] = pack2(a, b);
  }
  uint4* d = (uint4*)(dst + (size_t)n * K + k0 + kq * 16);
  d[0] = make_uint4(w[0], w[1], w[2], w[3]);
  d[1] = make_uint4(w[4], w[5], w[6], w[7]);
}

DI void phaseA(const Params& p, int l) {
  const int tid = otid();
  const int odd = l & 1, e = l >> 1;
  const int n_in = (odd ? 52 : 42) * 16;
  const int n_out = 256;
  const int n_glu = odd ? 0 : 64;
  const int n_norm = NTOK / 16;
  const int total = n_in + n_out + n_glu + n_norm;
  bf16_t* WIN = (bf16_t*)(p.ws + OFF_WIN);
  bf16_t* WOUT = (bf16_t*)(p.ws + OFF_WOUT);
  bf16_t* WGLU = (bf16_t*)(p.ws + OFF_WGLU);
  bf16_t* H = (bf16_t*)(p.ws + OFF_HY);
  const float* MOD = (const float*)(p.ws + OFF_MOD);
  for (int u = blockIdx.x; u < total; u += gridDim.x) {
    if (u < n_in) {
      int nt = u >> 4, kt = u & 15;
      if (odd) convert_tile(p.in[I_WINO] + (size_t)e * 1024 * 3328, 3328, WIN, 1024, nt * 64, kt * 64, 0, tid);
      else convert_tile(p.in[I_WINE] + (size_t)e * 1024 * 2592, 2592, WIN, 1024, nt * 64, kt * 64, 1, tid);
    } else if (u < n_in + n_out) {
      int v = u - n_in; int nt = v >> 4, kt = v & 15;
      const float* src = (odd ? p.in[I_WOUTO] : p.in[I_WOUTE]) + (size_t)e * 1024 * 1024;
      convert_tile(src, 1024, WOUT, 1024, nt * 64, kt * 64, 0, tid);
    } else if (u < n_in + n_out + n_glu) {
      int v = u - n_in - n_out; int nt = v >> 3, kt = v & 7;
      convert_tile(p.in[I_WGLU] + (size_t)e * 512 * 512, 512, WGLU, 512, nt * 64, kt * 64, 0, tid);
    } else {
      int v = u - n_in - n_out - n_glu;
      const int tok0 = v * 16 + (tid >> 6) * 4;
      const int lane = tid & 63;
      const float* x;
      if (l == 0) x = (tok0 < NTOK_P) ? p.in[I_XP] + (size_t)tok0 * DM : p.in[I_XS] + (size_t)(tok0 - NTOK_P) * DM;
      else x = p.out + (size_t)tok0 * DM;
      const int j = (tok0 < NTOK_P) ? 0 : 1 + ((tok0 - NTOK_P) >> 12);
      const float* mod = MOD + (l * 5 + j) * 3072;
      const float* nw = p.in[I_NORMW] + l * 1024;
      float4 xv[4][4];
#pragma unroll
      for (int rr = 0; rr < 4; ++rr)
#pragma unroll
        for (int i = 0; i < 4; ++i) xv[rr][i] = *(const float4*)(x + (size_t)rr * DM + lane * 4 + 256 * i);
      float rstd[4];
#pragma unroll
      for (int rr = 0; rr < 4; ++rr) {
        float ss = 0.f;
#pragma unroll
        for (int i = 0; i < 4; ++i) ss += xv[rr][i].x * xv[rr][i].x + xv[rr][i].y * xv[rr][i].y + xv[rr][i].z * xv[rr][i].z + xv[rr][i].w * xv[rr][i].w;
#pragma unroll
        for (int o = 32; o >= 1; o >>= 1) ss += __shfl_xor(ss, o);
        rstd[rr] = rsqrtf(ss * (1.f / 1024.f) + EPSF);
      }
#pragma unroll
      for (int i = 0; i < 4; ++i) {
        const int k = lane * 4 + 256 * i;
        float4 w4 = *(const float4*)(nw + k);
        float4 sh = *(const float4*)(mod + k);
        float4 scl = *(const float4*)(mod + 1024 + k);
        const float c0 = w4.x * (1.f + scl.x), c1 = w4.y * (1.f + scl.y), c2 = w4.z * (1.f + scl.z), c3 = w4.w * (1.f + scl.w);
#pragma unroll
        for (int rr = 0; rr < 4; ++rr) {
          float h0 = xv[rr][i].x * rstd[rr] * c0 + sh.x;
          float h1 = xv[rr][i].y * rstd[rr] * c1 + sh.y;
          float h2 = xv[rr][i].z * rstd[rr] * c2 + sh.z;
          float h3 = xv[rr][i].w * rstd[rr] * c3 + sh.w;
          *(uint2*)(H + (size_t)(tok0 + rr) * DM + k) = make_uint2(pack2(h0, h1), pack2(h2, h3));
        }
      }
    }
  }
}

#define GLD 72
enum { EPI_P = 0, EPI_RES = 1, EPI_GLU = 2 };

template <int EPI, int KT>
DI void gemm_phase(const Params& p, int l, const bf16_t* A, int lda, const bf16_t* Bt, int ldb,
                           int NT, int ldp, char* smem) {
  const int tid = otid(), lane = tid & 63, w = tid >> 6;
  const int r = lane & 31, h = lane >> 5;
  const int wm = w >> 1, wn = w & 1;
  bf16_t* As = (bf16_t*)smem;
  bf16_t* Bs = As + 2 * 128 * GLD;
  const int lr = tid >> 3, lc = (tid & 7) * 8;
  const int MT = NTOK / 128;
  const int total = MT * NT;
  const float* MOD = (const float*)(p.ws + OFF_MOD);
  const int nslot = gridDim.x >> 3;
  if (blockIdx.x >= (gridDim.x >> 1)) { __builtin_amdgcn_s_sleep(56); }
  for (int k = 0;; ++k) {
    const int t = ((blockIdx.x & 7) + 8 * k) * nslot + (blockIdx.x >> 3);
    if (t >= total) break;
    const int band = t / (8 * NT), rem = t - band * 8 * NT;
    const int nt = rem >> 3, mt = band * 8 + (rem & 7);
    const int m0 = mt * 128, n0 = nt * 128;
    const bf16_t* Ag = A + (size_t)(m0 + lr) * lda + lc;
    const bf16_t* Bg = Bt + (size_t)(n0 + lr) * ldb + lc;
    uint4 xa0, xa1, xa2, xa3, xb0, xb1, xb2, xb3;
    uint4 ya0, ya1, ya2, ya3, yb0, yb1, yb2, yb3;
#define GLOADS(S, KOFS) \
    S##a0 = *(const uint4*)(Ag + (KOFS)); S##a1 = *(const uint4*)(Ag + (size_t)32 * lda + (KOFS)); \
    S##a2 = *(const uint4*)(Ag + (size_t)64 * lda + (KOFS)); S##a3 = *(const uint4*)(Ag + (size_t)96 * lda + (KOFS)); \
    S##b0 = *(const uint4*)(Bg + (KOFS)); S##b1 = *(const uint4*)(Bg + (size_t)32 * ldb + (KOFS)); \
    S##b2 = *(const uint4*)(Bg + (size_t)64 * ldb + (KOFS)); S##b3 = *(const uint4*)(Bg + (size_t)96 * ldb + (KOFS));
#define LSTORES(S, ST) \
    *(uint4*)(As + (ST) * 128 * GLD + (lr) * GLD + lc) = S##a0; *(uint4*)(As + (ST) * 128 * GLD + (lr + 32) * GLD + lc) = S##a1; \
    *(uint4*)(As + (ST) * 128 * GLD + (lr + 64) * GLD + lc) = S##a2; *(uint4*)(As + (ST) * 128 * GLD + (lr + 96) * GLD + lc) = S##a3; \
    *(uint4*)(Bs + (ST) * 128 * GLD + (lr) * GLD + lc) = S##b0; *(uint4*)(Bs + (ST) * 128 * GLD + (lr + 32) * GLD + lc) = S##b1; \
    *(uint4*)(Bs + (ST) * 128 * GLD + (lr + 64) * GLD + lc) = S##b2; *(uint4*)(Bs + (ST) * 128 * GLD + (lr + 96) * GLD + lc) = S##b3;
    bf16x8 fa0[4], fa1[4], fb0[4], fb1[4];
#define FRAGS(ST) { \
      const bf16_t* as = As + (ST) * 128 * GLD + (wm * 64 + r) * GLD + h * 8; \
      const bf16_t* bs = Bs + (ST) * 128 * GLD + (wn * 64 + r) * GLD + h * 8; \
      _Pragma("unroll") for (int s = 0; s < 4; ++s) { \
        fa0[s] = *(const bf16x8*)(as + s * 16); \
        fb0[s] = *(const bf16x8*)(bs + s * 16); \
        fa1[s] = *(const bf16x8*)(as + 32 * GLD + s * 16); \
        fb1[s] = *(const bf16x8*)(bs + 32 * GLD + s * 16); \
      } \
      __builtin_amdgcn_sched_barrier(0); }
#define MFMAS() { \
      _Pragma("unroll") for (int s = 0; s < 4; ++s) { \
        acc00 = mfma(fa0[s], fb0[s], acc00); acc01 = mfma(fa0[s], fb1[s], acc01); \
        acc10 = mfma(fa1[s], fb0[s], acc10); acc11 = mfma(fa1[s], fb1[s], acc11); \
      } \
      _Pragma("unroll") for (int g = 0; g < 8; ++g) { \
        __builtin_amdgcn_sched_group_barrier(0x008, 2, 0); \
        __builtin_amdgcn_sched_group_barrier(0x200, 1, 0); \
        __builtin_amdgcn_sched_group_barrier(0x020, 1, 0); \
      } }
    GLOADS(x, 0)
    LSTORES(x, 0)
    GLOADS(x, 64)
    GLOADS(y, 128)
    __syncthreads();
    f32x16 acc00 = zero16(), acc01 = zero16(), acc10 = zero16(), acc11 = zero16();
#pragma unroll
    for (int kt = 0; kt < KT; kt += 2) {
      FRAGS(0)
      LSTORES(x, 1)
      if (kt + 3 < KT) { GLOADS(x, (kt + 3) * 64) }
      MFMAS()
      __syncthreads();
      __builtin_amdgcn_sched_barrier(0);
      FRAGS(1)
      if (kt + 2 < KT) { LSTORES(y, 0) }
      if (kt + 4 < KT) { GLOADS(y, (kt + 4) * 64) }
      MFMAS()
      __syncthreads();
      __builtin_amdgcn_sched_barrier(0);
    }
#undef FRAGS
#undef MFMAS
#undef GLOADS
#undef LSTORES
    {
      float* Cs = (float*)smem;
      const int er = tid >> 4, ec = (tid & 15) * 8;
      const int jm = (m0 < NTOK_P) ? 0 : 1 + ((m0 - NTOK_P) >> 12);
      float4 px[8][2];
      uint4 pz[8][2];
      if (EPI == EPI_RES) {
        const float* xsrc;
        if (l == 0) xsrc = (m0 < NTOK_P) ? p.in[I_XP] : p.in[I_XS] - (size_t)NTOK_P * DM;
        else xsrc = p.out;
#pragma unroll
        for (int ps = 0; ps < 8; ++ps) {
          const float* xp_ = xsrc + (size_t)(m0 + ps * 16 + er) * DM + n0 + ec;
          px[ps][0] = *(const float4*)xp_; px[ps][1] = *(const float4*)(xp_ + 4);
        }
      } else if (EPI == EPI_GLU) {
        const bf16_t* Pz = (const bf16_t*)(p.ws + OFF_P);
        const bf16_t* Z5z = (const bf16_t*)(p.ws + OFF_Z5);
#pragma unroll
        for (int ps = 0; ps < 8; ++ps) {
          const size_t gr = (size_t)(m0 + ps * 16 + er);
          pz[ps][0] = *(const uint4*)(Z5z + gr * 512 + n0 + ec);
          pz[ps][1] = *(const uint4*)(Pz + gr * LDP_E + PE_ZS + n0 + ec);
        }
      }
#pragma unroll
      for (int q = 0; q < 16; ++q) {
        const int rr = wm * 64 + crow(q, h), cc = wn * 64 + r;
        Cs[rr * 132 + cc] = acc00[q];
        Cs[rr * 132 + cc + 32] = acc01[q];
        Cs[(rr + 32) * 132 + cc] = acc10[q];
        Cs[(rr + 32) * 132 + cc + 32] = acc11[q];
      }
      __syncthreads();
#pragma unroll
      for (int ps = 0; ps < 8; ++ps) {
        const int row = ps * 16 + er;
        const float4 c0 = *(const float4*)(Cs + row * 132 + ec);
        const float4 c1 = *(const float4*)(Cs + row * 132 + ec + 4);
        const size_t grow = (size_t)(m0 + row);
        const int gcol = n0 + ec;
        if (EPI == EPI_P) {
          bf16_t* P = (bf16_t*)(p.ws + OFF_P);
          *(uint4*)(P + grow * ldp + gcol) = make_uint4(pack2(c0.x, c0.y), pack2(c0.z, c0.w), pack2(c1.x, c1.y), pack2(c1.z, c1.w));
        } else if (EPI == EPI_RES) {
          const float* gate = MOD + (l * 5 + jm) * 3072 + 2048 + gcol;
          const float4 g0 = *(const float4*)gate, g1 = *(const float4*)(gate + 4);
          const float4 x0 = px[ps][0], x1 = px[ps][1];
          float4 o0, o1;
          o0.x = x0.x + g0.x * c0.x; o0.y = x0.y + g0.y * c0.y; o0.z = x0.z + g0.z * c0.z; o0.w = x0.w + g0.w * c0.w;
          o1.x = x1.x + g1.x * c1.x; o1.y = x1.y + g1.y * c1.y; o1.z = x1.z + g1.z * c1.z; o1.w = x1.w + g1.w * c1.w;
          *(float4*)(p.out + grow * DM + gcol) = o0;
          *(float4*)(p.out + grow * DM + gcol + 4) = o1;
        } else {
          const bf16_t* P = (const bf16_t*)(p.ws + OFF_P);
          const bf16_t* Z5 = (const bf16_t*)(p.ws + OFF_Z5);
          bf16_t* Y = (bf16_t*)(p.ws + OFF_HY);
          const float* bglu = p.in[I_BGLU] + (l >> 1) * 512 + gcol;
          const float4 b0 = *(const float4*)bglu, b1 = *(const float4*)(bglu + 4);
          const uint4 zv = pz[ps][0];
          const uint4 zs = pz[ps][1];
#define GLU1(ZW, SW, CA, CB, BA, BB) pack2(__uint_as_float((ZW) << 16) * sigmf((CA) + (BA)) * siluf(__uint_as_float((SW) << 16)), \
                                           __uint_as_float((ZW) & 0xffff0000u) * sigmf((CB) + (BB)) * siluf(__uint_as_float((SW) & 0xffff0000u)))
          uint4 o;
          o.x = GLU1(zv.x, zs.x, c0.x, c0.y, b0.x, b0.y);
          o.y = GLU1(zv.y, zs.y, c0.z, c0.w, b0.z, b0.w);
          o.z = GLU1(zv.z, zs.z, c1.x, c1.y, b1.x, b1.y);
          o.w = GLU1(zv.w, zs.w, c1.z, c1.w, b1.z, b1.w);
#undef GLU1
          *(uint4*)(Y + grow * DM + 512 + gcol) = o;
        }
      }
      __syncthreads();
    }
  }
}

#define GL 72
struct GlaSmem {
  bf16_t Qd[64 * GL];
  bf16_t Kn[64 * GL];
  bf16_t KdT[64 * GL];
  bf16_t Att[64 * GL];
  bf16_t VT[128 * GL];
  bf16_t ST[128 * GL];
  float lfS[64 * 16];
  float qtot[4 * 64];
  float Dl[64];
  float Gtot[64];
};
#define OLD 132
static_assert(sizeof(GlaSmem) <= SMEM_BYTES, "GLA smem");

template <bool FULL>
DI void gla_sweep(const Params& p, int e, int hd, int dir, int tok0, f32x16 (&sacc)[2], GlaSmem& S) {
  const int tid = otid(), lane = tid & 63, w = tid >> 6;
  const int r = lane & 31, h = lane >> 5;
  const bf16_t* P = (const bf16_t*)(p.ws + OFF_P);
  bf16_t* Y = (bf16_t*)(p.ws + OFF_HY);
  const int tq = tid >> 6;
  if (tid < 64) S.Gtot[tid] = 0.f;
  unsigned w2p[8];
  float bias;
  {
    const int d0 = tid & 63;
#pragma unroll
    for (int i = 0; i < 8; ++i)
      w2p[i] = pack2(p.in[I_GW2][((size_t)(e * 2 + dir) * 16 + 2 * i) * 256 + hd * 64 + d0],
                     p.in[I_GW2][((size_t)(e * 2 + dir) * 16 + 2 * i + 1) * 256 + hd * 64 + d0]);
    bias = p.in[I_GB2][(e * 2 + dir) * 256 + hd * 64 + d0];
  }
  __syncthreads();
  if (FULL) {
#pragma unroll
    for (int ni = 0; ni < 2; ++ni)
#pragma unroll
      for (int q = 0; q < 16; ++q) S.ST[(w * 32 + crow(q, h)) * GL + ni * 32 + r] = f2bf(sacc[ni][q]);
  }
  uint4 pq0, pq1, pk0, pk1;
  bf16_t plf[4];
  pq0 = pq1 = pk0 = pk1 = make_uint4(0, 0, 0, 0);
  plf[0] = plf[1] = plf[2] = plf[3] = 0;
#pragma unroll 1
  for (int cc = 0; cc < 4; ++cc) {
    const int c = dir ? 3 - cc : cc;
    const int ct0 = tok0 + c * 64;
    const int tv = tid & 63, cgp = tid >> 6;
    uint4 v0, v1, v2, v3;
    {
      const bf16_t* vsrc = P + (size_t)(ct0 + tv) * LDP_E + PE_V + hd * 128 + cgp * 32;
      v0 = *(const uint4*)(vsrc); v1 = *(const uint4*)(vsrc + 8); v2 = *(const uint4*)(vsrc + 16); v3 = *(const uint4*)(vsrc + 24);
    }
    {
      const int row = tid >> 2, c8 = (tid & 3) * 16;
      if (cc == 0) {
        const bf16_t* src = P + (size_t)(ct0 + row) * LDP_E + hd * 64 + c8;
        pk0 = *(const uint4*)(src + PE_K); pk1 = *(const uint4*)(src + PE_K + 8);
        if (FULL) { pq0 = *(const uint4*)(src + PE_Q); pq1 = *(const uint4*)(src + PE_Q + 8); }
#pragma unroll
        for (int i = 0; i < 4; ++i) {
          int idx = tid + 256 * i; int t = idx >> 4, rr = idx & 15;
          plf[i] = P[(size_t)(ct0 + t) * LDP_E + PE_LF + dir * 16 + rr];
        }
      }
#pragma unroll
      for (int i = 0; i < 4; ++i) S.lfS[tid + 256 * i] = bf2f(plf[i]);
      *(uint4*)(S.Kn + row * GL + c8) = pk0; *(uint4*)(S.Kn + row * GL + c8 + 8) = pk1;
      if (FULL) { *(uint4*)(S.Qd + row * GL + c8) = pq0; *(uint4*)(S.Qd + row * GL + c8 + 8) = pq1; }
      if (cc < 3) {
        const int cn = dir ? 2 - cc : cc + 1;
        const int cn0 = tok0 + cn * 64;
        const bf16_t* src = P + (size_t)(cn0 + row) * LDP_E + hd * 64 + c8;
        pk0 = *(const uint4*)(src + PE_K); pk1 = *(const uint4*)(src + PE_K + 8);
        if (FULL) { pq0 = *(const uint4*)(src + PE_Q); pq1 = *(const uint4*)(src + PE_Q + 8); }
#pragma unroll
        for (int i = 0; i < 4; ++i) {
          int idx = tid + 256 * i; int t = idx >> 4, rr = idx & 15;
          plf[i] = P[(size_t)(cn0 + t) * LDP_E + PE_LF + dir * 16 + rr];
        }
      }
    }
    __syncthreads();
    const int d = tid & 63;
    float w2r[16];
#pragma unroll
    for (int i = 0; i < 8; ++i) { w2r[2 * i] = __uint_as_float(w2p[i] << 16); w2r[2 * i + 1] = __uint_as_float(w2p[i] & 0xffff0000u); }
    float g[16];
    float run = 0.f;
#pragma unroll
    for (int i = 0; i < 16; ++i) {
      int t = tq * 16 + i;
      float x = bias;
#pragma unroll
      for (int rr = 0; rr < 16; ++rr) x += S.lfS[t * 16 + rr] * w2r[rr];
      float ls = fminf(x, 0.f) - __logf(1.f + __expf(-fabsf(x)));
      g[i] = ls * (1.f / 16.f);
      run += g[i];
    }
    S.qtot[tq * 64 + d] = run;
    __syncthreads();
    float q0 = S.qtot[d], q1 = S.qtot[64 + d], q2 = S.qtot[128 + d], q3 = S.qtot[192 + d];
    const float total = q0 + q1 + q2 + q3;
    float off;
    if (dir == 0) off = (tq > 0 ? q0 : 0.f) + (tq > 1 ? q1 : 0.f) + (tq > 2 ? q2 : 0.f);
    else off = (tq < 1 ? q1 : 0.f) + (tq < 2 ? q2 : 0.f) + (tq < 3 ? q3 : 0.f);
    float b[16];
    if (dir == 0) {
      float a = off;
#pragma unroll
      for (int i = 0; i < 16; ++i) { a += g[i]; b[i] = a; }
    } else {
      float a = off;
#pragma unroll
      for (int i = 15; i >= 0; --i) { a += g[i]; b[i] = a; }
    }
    if (tq == 0) { S.Dl[d] = __expf(total); S.Gtot[d] += total; }
    {
      unsigned kd[8];
      float kprev = 0.f;
#pragma unroll
      for (int i = 0; i < 16; ++i) {
        int t = tq * 16 + i;
        float kv = bf2f(S.Kn[t * GL + d]);
        if (FULL) {
          float qv = bf2f(S.Qd[t * GL + d]);
          S.Qd[t * GL + d] = f2bf(qv * 0.125f * __expf(b[i]));
          S.Kn[t * GL + d] = f2bf(kv * __expf(-b[i]));
        }
        float kdv = kv * __expf(total - b[i]);
        if (i & 1) kd[i >> 1] = pack2(kprev, kdv); else kprev = kdv;
      }
      uint4* dst = (uint4*)(S.KdT + d * GL + tq * 16);
      dst[0] = make_uint4(kd[0], kd[1], kd[2], kd[3]);
      dst[1] = make_uint4(kd[4], kd[5], kd[6], kd[7]);
    }
    {
      bf16_t* vd = S.VT + (cgp * 32) * GL + tv;
#define VTW(VV, B) vd[((B) + 0) * GL] = (bf16_t)(VV.x & 0xffffu); vd[((B) + 1) * GL] = (bf16_t)(VV.x >> 16); \
                   vd[((B) + 2) * GL] = (bf16_t)(VV.y & 0xffffu); vd[((B) + 3) * GL] = (bf16_t)(VV.y >> 16); \
                   vd[((B) + 4) * GL] = (bf16_t)(VV.z & 0xffffu); vd[((B) + 5) * GL] = (bf16_t)(VV.z >> 16); \
                   vd[((B) + 6) * GL] = (bf16_t)(VV.w & 0xffffu); vd[((B) + 7) * GL] = (bf16_t)(VV.w >> 16);
      VTW(v0, 0) VTW(v1, 8) VTW(v2, 16) VTW(v3, 24)
#undef VTW
    }
    __syncthreads();
    const int mi = w >> 1;
    f32x16 oacc[2];
    bf16_t* orec = Y + (size_t)(ct0 + mi * 32 + h * 16 + (r >> 1)) * DM + hd * 128 + (w & 1) * 64 + (r & 1) * 16;
    uint4 of0 = make_uint4(0, 0, 0, 0), of1 = of0, of2 = of0, of3 = of0, zg0 = of0, zg1 = of0, zg2 = of0, zg3 = of0;
    if (FULL && dir) {
      of0 = *(const uint4*)(orec); of1 = *(const uint4*)(orec + 8);
      of2 = *(const uint4*)(orec + 32); of3 = *(const uint4*)(orec + 40);
      const bf16_t* zg = P + (size_t)(ct0 + (tid >> 2)) * LDP_E + PE_ZG + hd * 128 + (tid & 3) * 32;
      zg0 = *(const uint4*)(zg); zg1 = *(const uint4*)(zg + 8); zg2 = *(const uint4*)(zg + 16); zg3 = *(const uint4*)(zg + 24);
    }
    if (FULL) {
      const int ni = w & 1;
      const bool skip = dir ? (ni < mi) : (ni > mi);
      f32x16 a = zero16();
      if (!skip) mma_tile<64>(a, S.Qd + mi * 32 * GL, GL, S.Kn + ni * 32 * GL, GL, lane);
#pragma unroll
      for (int q = 0; q < 16; ++q) {
        int i = mi * 32 + crow(q, h), j = ni * 32 + r;
        bool keep = dir ? (j >= i) : (j <= i);
        S.Att[i * GL + j] = f2bf(keep ? a[q] : 0.f);
      }
#pragma unroll
      for (int jj = 0; jj < 2; ++jj) {
        int nj = (w & 1) * 2 + jj;
        oacc[jj] = zero16();
        mma_tile<64>(oacc[jj], S.Qd + mi * 32 * GL, GL, S.ST + nj * 32 * GL, GL, lane);
      }
      __syncthreads();
#pragma unroll
      for (int jj = 0; jj < 2; ++jj) {
        int nj = (w & 1) * 2 + jj;
        mma_tile<64>(oacc[jj], S.Att + mi * 32 * GL, GL, S.VT + nj * 32 * GL, GL, lane);
      }
    }
#pragma unroll
    for (int ni = 0; ni < 2; ++ni) {
      float dec = S.Dl[ni * 32 + r];
#pragma unroll
      for (int q = 0; q < 16; ++q) sacc[ni][q] *= dec;
      mma_tile<64>(sacc[ni], S.VT + w * 32 * GL, GL, S.KdT + ni * 32 * GL, GL, lane);
    }
    __syncthreads();
    if (FULL) {
#pragma unroll
      for (int ni = 0; ni < 2; ++ni)
#pragma unroll
        for (int q = 0; q < 16; ++q) S.ST[(w * 32 + crow(q, h)) * GL + ni * 32 + r] = f2bf(sacc[ni][q]);
      if (dir == 0) {
#pragma unroll
        for (int jj = 0; jj < 2; ++jj) {
          *(uint4*)(orec + jj * 32) = make_uint4(pack2(oacc[jj][0], oacc[jj][1]), pack2(oacc[jj][2], oacc[jj][3]), pack2(oacc[jj][4], oacc[jj][5]), pack2(oacc[jj][6], oacc[jj][7]));
          *(uint4*)(orec + jj * 32 + 8) = make_uint4(pack2(oacc[jj][8], oacc[jj][9]), pack2(oacc[jj][10], oacc[jj][11]), pack2(oacc[jj][12], oacc[jj][13]), pack2(oacc[jj][14], oacc[jj][15]));
        }
      } else {
        float* Ob = (float*)S.Qd;
        {
          const unsigned ofw[16] = {of0.x, of0.y, of0.z, of0.w, of1.x, of1.y, of1.z, of1.w, of2.x, of2.y, of2.z, of2.w, of3.x, of3.y, of3.z, of3.w};
#pragma unroll
          for (int jj = 0; jj < 2; ++jj) {
            int cl = ((w & 1) * 2 + jj) * 32 + r;
#pragma unroll
            for (int q = 0; q < 16; ++q) {
              int tl = mi * 32 + crow(q, h);
              const unsigned wv = ofw[jj * 8 + (q >> 1)];
              float prev = (q & 1) ? __uint_as_float(wv & 0xffff0000u) : __uint_as_float(wv << 16);
              Ob[tl * OLD + cl] = oacc[jj][q] + prev;
            }
          }
        }
        __syncthreads();
        {
          const int tl = tid >> 2, qtr = tid & 3;
          float ss = 0.f;
#pragma unroll
          for (int i = 0; i < 32; ++i) { float v = Ob[tl * OLD + qtr * 32 + i]; ss += v * v; }
          ss += __shfl_xor(ss, 1);
          ss += __shfl_xor(ss, 2);
          const float rstd = rsqrtf(ss * (1.f / 128.f) + EPSF);
          const float* onw = p.in[I_GON] + e * 128 + qtr * 32;
          bf16_t* yo = Y + (size_t)(ct0 + tl) * DM + hd * 128 + qtr * 32;
          const unsigned zgw[16] = {zg0.x, zg0.y, zg0.z, zg0.w, zg1.x, zg1.y, zg1.z, zg1.w, zg2.x, zg2.y, zg2.z, zg2.w, zg3.x, zg3.y, zg3.z, zg3.w};
#pragma unroll
          for (int i = 0; i < 32; i += 2) {
            unsigned zz = zgw[i >> 1];
            float y0 = Ob[tl * OLD + qtr * 32 + i] * rstd * onw[i] * siluf(__uint_as_float(zz << 16));
            float y1 = Ob[tl * OLD + qtr * 32 + i + 1] * rstd * onw[i + 1] * siluf(__uint_as_float(zz & 0xffff0000u));
            *(unsigned*)(yo + i) = pack2(y0, y1);
          }
        }
        __syncthreads();
      }
    }
  }
}

DI void gla_pass1_unit(const Params& p, int e, int u, char* smem) {
  GlaSmem& S = *(GlaSmem*)smem;
  const int tid = otid(), lane = tid & 63, w = tid >> 6;
  const int r = lane & 31, h = lane >> 5;
  const int seg = u >> 3, hd = (u >> 1) & 3, dir = u & 1;
  const int tok0 = NTOK_P + seg * 256;
  f32x16 sacc[2];
  sacc[0] = zero16(); sacc[1] = zero16();
  __syncthreads();
  gla_sweep<false>(p, e, hd, dir, tok0, sacc, S);
  float* L = (float*)(p.ws + OFF_GLAL) + (size_t)((seg * 4 + hd) * 2 + dir) * 8192;
#pragma unroll
  for (int ni = 0; ni < 2; ++ni)
#pragma unroll
    for (int q = 0; q < 16; ++q) L[(w * 32 + crow(q, h)) * 64 + ni * 32 + r] = sacc[ni][q];
  if (tid < 64) {
    float* D = (float*)(p.ws + OFF_GLAD) + ((seg * 4 + hd) * 2 + dir) * 64;
    D[tid] = expf(S.Gtot[tid]);
  }
  __syncthreads();
}

DI void gla_pass3_unit(const Params& p, int e, int u, char* smem) {
  GlaSmem& S = *(GlaSmem*)smem;
  const int tid = otid(), lane = tid & 63, w = tid >> 6;
  const int r = lane & 31, h = lane >> 5;
  const int seg = ((u >> 2) + 32) % 96, hd = u & 3;
  const int tok0 = seg * 256;
  const bool samp = seg >= 32;
  const int sb = samp ? (seg - 32) >> 4 : 0, sl = samp ? (seg - 32) & 15 : 0;
  const float* Lb = (const float*)(p.ws + OFF_GLAL);
  const float* Db = (const float*)(p.ws + OFF_GLAD);
  for (int dir = 0; dir < 2; ++dir) {
    f32x16 sacc[2];
    sacc[0] = zero16(); sacc[1] = zero16();
    if (samp) {
      const float* s0 = p.in[I_SGLA] + (size_t)(((sb * 2 + e) * 2 + dir) * 4 + hd) * 8192;
#pragma unroll
      for (int ni = 0; ni < 2; ++ni)
#pragma unroll
        for (int q = 0; q < 16; ++q) sacc[ni][q] = s0[(ni * 32 + r) * 128 + w * 32 + crow(q, h)];
      const int nst = dir ? 15 - sl : sl;
      float Lc[32], dc[2];
      {
        const int sp0 = dir ? 15 : 0;
        const int sidx0 = ((sb * 16 + sp0) * 4 + hd) * 2 + dir;
        const float* L0 = Lb + (size_t)sidx0 * 8192;
        const float* D0 = Db + sidx0 * 64;
#pragma unroll
        for (int ni = 0; ni < 2; ++ni) {
          dc[ni] = D0[ni * 32 + r];
#pragma unroll
          for (int q = 0; q < 16; ++q) Lc[ni * 16 + q] = L0[(w * 32 + crow(q, h)) * 64 + ni * 32 + r];
        }
      }
#pragma unroll 1
      for (int k = 0; k < nst; ++k) {
        float Ln[32], dn[2];
        const int kn = (k + 1 < nst) ? k + 1 : k;
        const int sp = dir ? 15 - kn : kn;
        const int sidx = ((sb * 16 + sp) * 4 + hd) * 2 + dir;
        const float* L = Lb + (size_t)sidx * 8192;
        const float* D = Db + sidx * 64;
#pragma unroll
        for (int ni = 0; ni < 2; ++ni) {
          dn[ni] = D[ni * 32 + r];
#pragma unroll
          for (int q = 0; q < 16; ++q) Ln[ni * 16 + q] = L[(w * 32 + crow(q, h)) * 64 + ni * 32 + r];
        }
#pragma unroll
        for (int ni = 0; ni < 2; ++ni)
#pragma unroll
          for (int q = 0; q < 16; ++q) sacc[ni][q] = sacc[ni][q] * dc[ni] + Lc[ni * 16 + q];
#pragma unroll
        for (int i = 0; i < 32; ++i) Lc[i] = Ln[i];
        dc[0] = dn[0]; dc[1] = dn[1];
      }
    }
    __syncthreads();
    gla_sweep<true>(p, e, hd, dir, tok0, sacc, S);
    if (!samp) {
      float* o = p.out + OUT_GLA + (size_t)(((seg * 2 + e) * 2 + dir) * 4 + hd) * 8192;
#pragma unroll
      for (int ni = 0; ni < 2; ++ni)
#pragma unroll
        for (int q = 0; q < 16; ++q) o[(ni * 32 + r) * 128 + w * 32 + crow(q, h)] = sacc[ni][q];
    }
    __syncthreads();
  }
}

#define XLD 136
#define WSYNC() do { __builtin_amdgcn_fence(__ATOMIC_RELEASE, "wavefront"); __builtin_amdgcn_wave_barrier(); __builtin_amdgcn_fence(__ATOMIC_ACQUIRE, "wavefront"); } while (0)
DI void s5_sweep(const Params& p, int e, int g, int dir, int mode, int tok0, float& hr, float& hi, bf16_t* X) {
  const int lane = otid() & 63;
  const int r = lane & 31, h = lane >> 5;
  const bf16_t* P = (const bf16_t*)(p.ws + OFF_P);
  bf16_t* Z5 = (bf16_t*)(p.ws + OFF_Z5);
  bf16_t* Yb = (bf16_t*)(p.ws + OFF_HY);
  const float* LB = (const float*)(p.ws + OFF_LB) + (size_t)(((e * 2 + dir) * 32 + g) * 64 + lane) * 2;
  const float lbr = LB[0], lbi = LB[1];
  const bf16_t* BBT = (const bf16_t*)(p.ws + OFF_BBT) + (size_t)((e * 2 + dir) * 32 + g) * 128 * 16;
  const bf16_t* CM = (const bf16_t*)(p.ws + OFF_CM) + (size_t)(e * 32 + g) * 32 * 128;
  bf16x8 bfr[4];
#pragma unroll
  for (int j = 0; j < 4; ++j) bfr[j] = *(const bf16x8*)(BBT + (32 * j + r) * 16 + 8 * h);
  bf16x8 cfr[8];
#pragma unroll
  for (int s = 0; s < 8; ++s) cfr[s] = *(const bf16x8*)(CM + r * 128 + s * 16 + h * 8);
  bf16x8 dfr;
  {
    const short dv = (r < 16) ? (short)f2bf(p.in[I_S5D][e * 512 + g * 16 + r]) : (short)0;
#pragma unroll
    for (int j = 0; j < 8; ++j) dfr[j] = (8 * h + j == r) ? dv : (short)0;
  }
  const bf16_t* Ub = P + (size_t)(tok0 + r) * LDP_E + PE_U + g * 16 + 8 * h;
  bf16x8 a_cur = *(const bf16x8*)(Ub + (size_t)((dir ? 7 : 0) * 32) * LDP_E);
#pragma unroll 1
  for (int ss = 0; ss < 8; ++ss) {
    const int sc = dir ? 7 - ss : ss;
    const int t0 = tok0 + sc * 32;
    bf16x8 a_nxt = a_cur;
    if (ss < 7) a_nxt = *(const bf16x8*)(Ub + (size_t)((dir ? 6 - ss : ss + 1) * 32) * LDP_E);
    bf16_t* prec = Yb + (size_t)(t0 + 16 * h + (r & 15)) * DM + 512 + g * 16;
    uint4 pp0 = make_uint4(0, 0, 0, 0), pp1 = make_uint4(0, 0, 0, 0);
    if (mode == 2 && r < 16) { pp0 = *(const uint4*)prec; pp1 = *(const uint4*)(prec + 8); }
#pragma unroll
    for (int jp = 0; jp < 2; ++jp) {
      f32x16 are = mfma(a_cur, bfr[2 * jp], zero16());
      f32x16 aim = mfma(a_cur, bfr[2 * jp + 1], zero16());
#pragma unroll
      for (int q = 0; q < 16; ++q) *(unsigned*)(X + crow(q, h) * XLD + 2 * (32 * jp + r)) = pack2(are[q], aim[q]);
    }
    WSYNC();
#define S5STEP(T) { float br = __uint_as_float(wv[T] << 16), bi = __uint_as_float(wv[T] & 0xffff0000u); \
        float nr = lbr * hr - lbi * hi + br; float ni = lbr * hi + lbi * hr + bi; hr = nr; hi = ni; wv[T] = pack2(nr, ni); }
#pragma unroll
    for (int hf = 0; hf < 2; ++hf) {
      bf16_t* Xh = X + ((dir ? 1 - hf : hf) * 16) * XLD + 2 * lane;
      unsigned wv[16];
#pragma unroll
      for (int tt = 0; tt < 16; ++tt) wv[tt] = *(const unsigned*)(Xh + tt * XLD);
      if (dir == 0) {
#pragma unroll
        for (int tt = 0; tt < 16; ++tt) S5STEP(tt)
      } else {
#pragma unroll
        for (int tt = 15; tt >= 0; --tt) S5STEP(tt)
      }
#pragma unroll
      for (int tt = 0; tt < 16; ++tt) *(unsigned*)(Xh + tt * XLD) = wv[tt];
    }
#undef S5STEP
    WSYNC();
    if (mode >= 1) {
      f32x16 acc = zero16();
#pragma unroll
      for (int s = 0; s < 8; ++s) {
        bf16x8 xa = *(const bf16x8*)(X + r * XLD + s * 16 + h * 8);
        acc = mfma(xa, cfr[s], acc);
      }
      if (mode == 2) acc = mfma(a_cur, dfr, acc);
      if (r < 16) {
        if (mode == 1) {
          *(uint4*)prec = make_uint4(pack2(acc[0], acc[1]), pack2(acc[2], acc[3]), pack2(acc[4], acc[5]), pack2(acc[6], acc[7]));
          *(uint4*)(prec + 8) = make_uint4(pack2(acc[8], acc[9]), pack2(acc[10], acc[11]), pack2(acc[12], acc[13]), pack2(acc[14], acc[15]));
        } else {
          const unsigned pw[8] = {pp0.x, pp0.y, pp0.z, pp0.w, pp1.x, pp1.y, pp1.z, pp1.w};
          const int col = g * 16 + r;
#pragma unroll
          for (int q = 0; q < 16; ++q) {
            const float prev = (q & 1) ? __uint_as_float(pw[q >> 1] & 0xffff0000u) : __uint_as_float(pw[q >> 1] << 16);
            const float y = acc[q] + prev;
            const float t3 = 1.5957691216057308f * (y + 0.044715f * y * y * y);
            Z5[(size_t)(t0 + crow(q, h)) * 512 + col] = f2bf(y * sigmf(t3));
          }
        }
      }
    }
    WSYNC();
    a_cur = a_nxt;
  }
}

DI void s5_pass1_unit(const Params& p, int e, int u, char* smem) {
  const int tid = otid(), lane = tid & 63, w = tid >> 6;
  const int seg = u >> 3, g = (u & 7) * 4 + w;
  bf16_t* X = (bf16_t*)smem + w * 32 * XLD;
  float* ES = (float*)(p.ws + OFF_S5ES);
  for (int dir = 0; dir < 2; ++dir) {
    float hr = 0.f, hi = 0.f;
    s5_sweep(p, e, g, dir, 0, NTOK_P + seg * 256, hr, hi, X);
    size_t o = ((size_t)((seg * 32 + g) * 2 + dir) * 64 + lane) * 2;
    ES[o] = hr; ES[o + 1] = hi;
  }
}

DI void s5_pass3_unit(const Params& p, int e, int u, char* smem) {
  const int tid = otid(), lane = tid & 63, w = tid >> 6;
  const int seg = u >> 3, g = (u & 7) * 4 + w;
  bf16_t* X = (bf16_t*)smem + w * 32 * XLD;
  const bool samp = seg >= 32;
  const int sb = samp ? (seg - 32) >> 4 : 0, sl = samp ? (seg - 32) & 15 : 0;
  const float* ES = (const float*)(p.ws + OFF_S5ES);
  for (int dir = 0; dir < 2; ++dir) {
    float hr = 0.f, hi = 0.f;
    if (samp) {
      const size_t si = (size_t)(((sb * 2 + e) * 2 + dir) * 32 + g) * 64 + lane;
      hr = p.in[I_S5R][si]; hi = p.in[I_S5I][si];
      const float* L2 = (const float*)(p.ws + OFF_LB256) + (size_t)(((e * 2 + dir) * 32 + g) * 64 + lane) * 2;
      const float ar = L2[0], ai = L2[1];
      const int nst = dir ? 15 - sl : sl;
      float er[15], ei[15];
#pragma unroll
      for (int k = 0; k < 15; ++k) {
        const int kk = k < nst ? k : 0;
        const int sp = dir ? 15 - kk : kk;
        size_t o = ((size_t)(((sb * 16 + sp) * 32 + g) * 2 + dir) * 64 + lane) * 2;
        float2 ev = *(const float2*)(ES + o);
        er[k] = ev.x; ei[k] = ev.y;
      }
#pragma unroll
      for (int k = 0; k < 15; ++k) {
        if (k < nst) {
          float nr = ar * hr - ai * hi + er[k];
          float ni = ar * hi + ai * hr + ei[k];
          hr = nr; hi = ni;
        }
      }
    }
    s5_sweep(p, e, g, dir, dir + 1, seg * 256, hr, hi, X);
    if (!samp) {
      const size_t so = (size_t)(((seg * 2 + e) * 2 + dir) * 32 + g) * 64 + lane;
      p.out[OUT_S5R + so] = hr;
      p.out[OUT_S5I + so] = hi;
    }
  }
}

#define AL 72
template <int W>
DI void qk_prep(const bf16_t* src, const float* nw, bool rope, int pos, float mult, int sub, const float* RT,
                bf16_t* dst, float* fdst) {
  float x[4][W];
#pragma unroll
  for (int c = 0; c < 4; ++c) {
    if (W == 4) {
      uint2 v = *(const uint2*)(src + 16 * c + 4 * sub);
      x[c][0] = __uint_as_float(v.x << 16); x[c][1] = __uint_as_float(v.x & 0xffff0000u);
      x[c][2] = __uint_as_float(v.y << 16); x[c][3] = __uint_as_float(v.y & 0xffff0000u);
    } else {
      uint4 v = *(const uint4*)(src + 16 * c + 8 * sub);
      x[c][0] = __uint_as_float(v.x << 16); x[c][1] = __uint_as_float(v.x & 0xffff0000u);
      x[c][2] = __uint_as_float(v.y << 16); x[c][3] = __uint_as_float(v.y & 0xffff0000u);
      x[c][4 % W] = __uint_as_float(v.z << 16); x[c][5 % W] = __uint_as_float(v.z & 0xffff0000u);
      x[c][6 % W] = __uint_as_float(v.w << 16); x[c][7 % W] = __uint_as_float(v.w & 0xffff0000u);
    }
  }
  float ss = 0.f;
#pragma unroll
  for (int c = 0; c < 4; ++c)
#pragma unroll
    for (int i = 0; i < W; ++i) ss += x[c][i] * x[c][i];
  ss += __shfl_xor(ss, 1);
  if (W == 4) ss += __shfl_xor(ss, 2);
  const float rstd = rsqrtf(ss * (1.f / 64.f) + EPSF);
#pragma unroll
  for (int c = 0; c < 4; ++c)
#pragma unroll
    for (int i = 0; i < W; ++i) x[c][i] *= rstd * nw[16 * c + W * sub + i];
  if (rope) {
    const int row = pos >> 6, col = pos & 63;
#pragma unroll
    for (int i = 0; i < W; ++i) {
      const int f = W * sub + i;
      float cs = RT[(row * 16 + f) * 2], sn = RT[(row * 16 + f) * 2 + 1];
      float x1 = x[0][i], x2 = x[1][i];
      x[0][i] = x1 * cs - x2 * sn; x[1][i] = x2 * cs + x1 * sn;
      cs = RT[(col * 16 + f) * 2]; sn = RT[(col * 16 + f) * 2 + 1];
      x1 = x[2][i]; x2 = x[3][i];
      x[2][i] = x1 * cs - x2 * sn; x[3][i] = x2 * cs + x1 * sn;
    }
  }
#pragma unroll
  for (int c = 0; c < 4; ++c)
#pragma unroll
    for (int i = 0; i < W; ++i) {
      dst[16 * c + W * sub + i] = f2bf(x[c][i] * mult);
      if (fdst) fdst[16 * c + W * sub + i] = x[c][i];
    }
}

DI void attn_unit(const Params& p, int e, int u, char* smem) {
  const int tid = otid(), lane = tid & 63, w = tid >> 6;
  const int r = lane & 31, h = lane >> 5;
  bf16_t* Ks = (bf16_t*)smem;
  bf16_t* Vt = Ks + 64 * AL;
  bf16_t* Qs = Vt + 64 * AL;
  const bf16_t* P = (const bf16_t*)(p.ws + OFF_P);
  bf16_t* Y = (bf16_t*)(p.ws + OFF_HY);
  const float* RT = (const float*)(p.ws + OFF_ROPE);
  const bool lat = u >= 512;
  int b, kvh, qb;
  if (!lat) { b = u >> 4; kvh = (u >> 3) & 1; qb = u & 7; }
  else { int v = u - 512; b = v >> 8; kvh = (v >> 7) & 1; qb = v & 127; }
  const int tokbase = lat ? NTOK_P + b * 4096 : b * 256;
  const int q0 = qb * 32;
  const int hq = kvh * 4 + w;
  __syncthreads();
  const int kbase = lat ? (((q0 - 128) >> 6) << 6) : 0;
  const int ntile = lat ? 9 : 4;
  bf16_t* Ks1 = Qs + 4 * 32 * AL;
  bf16_t* Vt1 = Ks1 + 64 * AL;
  const int keyk = tid >> 2, s4 = tid & 3;
  const int keyv = tid & 63, cq = tid >> 6;
  const bool wr = (!lat) && (qb == 0);
  float knw[16];
#pragma unroll
  for (int c = 0; c < 4; ++c)
#pragma unroll
    for (int i = 0; i < 4; ++i) knw[c * 4 + i] = p.in[I_KNW][e * 64 + 16 * c + 4 * s4 + i];
  float ccs[4], csn[4];
#pragma unroll
  for (int i = 0; i < 4; ++i) { ccs[i] = RT[(keyk * 16 + 4 * s4 + i) * 2]; csn[i] = RT[(keyk * 16 + 4 * s4 + i) * 2 + 1]; }
  uint4 rk0, rk1, rk2, rk3, rv0, rv1, rv2, rv3;
  float rrc[4] = {1.f, 1.f, 1.f, 1.f}, rrs[4] = {0.f, 0.f, 0.f, 0.f};
  rk0 = rk1 = rk2 = rk3 = rv0 = rv1 = rv2 = rv3 = make_uint4(0, 0, 0, 0);
  int tlo = 0, thi = ntile - 1;
  if (lat) {
    tlo = kbase < 0 ? (-kbase) >> 6 : 0;
    thi = 4;
    while (kbase + thi * 64 >= 4096) --thi;
  }
#define TILE_NEXT(ti) (lat ? ((ti) < thi ? (ti) + 1 : ((ti) < 5 ? 5 : (ti) + 1)) : (ti) + 1)
#define TILE_LOAD(ti) { \
    const bool fc_ = lat && (ti) >= 5; \
    const int kt0_ = fc_ ? ((ti) - 5) * 64 : kbase + (ti) * 64; \
    if (fc_) { \
      const float* ck = p.in[I_CK] + ((size_t)((b * 2 + e) * 2 + kvh) * 256 + kt0_ + keyk) * 64 + 4 * s4; \
      const float* cv = p.in[I_CV] + ((size_t)((b * 2 + e) * 2 + kvh) * 256 + kt0_ + keyv) * 64 + cq * 16; \
      rk0 = *(const uint4*)(ck); rk1 = *(const uint4*)(ck + 16); rk2 = *(const uint4*)(ck + 32); rk3 = *(const uint4*)(ck + 48); \
      rv0 = *(const uint4*)(cv); rv1 = *(const uint4*)(cv + 4); rv2 = *(const uint4*)(cv + 8); rv3 = *(const uint4*)(cv + 12); \
    } else { \
      const bf16_t* ksrc = P + (size_t)(tokbase + kt0_ + keyk) * LDP_O + PO_K + kvh * 64 + 4 * s4; \
      const bf16_t* vsrc = P + (size_t)(tokbase + kt0_ + keyv) * LDP_O + PO_V + kvh * 64 + cq * 16; \
      uint2 t0_ = *(const uint2*)(ksrc), t1_ = *(const uint2*)(ksrc + 16), t2_ = *(const uint2*)(ksrc + 32), t3_ = *(const uint2*)(ksrc + 48); \
      rk0.x = t0_.x; rk0.y = t0_.y; rk1.x = t1_.x; rk1.y = t1_.y; rk2.x = t2_.x; rk2.y = t2_.y; rk3.x = t3_.x; rk3.y = t3_.y; \
      rv0 = *(const uint4*)(vsrc); rv1 = *(const uint4*)(vsrc + 8); \
      if (lat) { \
        const int row_ = kt0_ >> 6; \
        _Pragma("unroll") for (int i = 0; i < 4; ++i) { rrc[i] = RT[(row_ * 16 + 4 * s4 + i) * 2]; rrs[i] = RT[(row_ * 16 + 4 * s4 + i) * 2 + 1]; } \
      } \
    } }
#define VT4(VD, W0, W1) { (VD)[0] = (bf16_t)((W0) & 0xffffu); (VD)[AL] = (bf16_t)((W0) >> 16); (VD)[2 * AL] = (bf16_t)((W1) & 0xffffu); (VD)[3 * AL] = (bf16_t)((W1) >> 16); }
#define TILE_STORE(ti, KB, VB) { \
    const bool fc_ = lat && (ti) >= 5; \
    const int kt0_ = fc_ ? ((ti) - 5) * 64 : kbase + (ti) * 64; \
    if (fc_) { \
      bf16_t* kd = (KB) + keyk * AL + 4 * s4; \
      *(uint2*)(kd) = make_uint2(pack2(__uint_as_float(rk0.x), __uint_as_float(rk0.y)), pack2(__uint_as_float(rk0.z), __uint_as_float(rk0.w))); \
      *(uint2*)(kd + 16) = make_uint2(pack2(__uint_as_float(rk1.x), __uint_as_float(rk1.y)), pack2(__uint_as_float(rk1.z), __uint_as_float(rk1.w))); \
      *(uint2*)(kd + 32) = make_uint2(pack2(__uint_as_float(rk2.x), __uint_as_float(rk2.y)), pack2(__uint_as_float(rk2.z), __uint_as_float(rk2.w))); \
      *(uint2*)(kd + 48) = make_uint2(pack2(__uint_as_float(rk3.x), __uint_as_float(rk3.y)), pack2(__uint_as_float(rk3.z), __uint_as_float(rk3.w))); \
      bf16_t* vd = (VB) + (cq * 16) * AL + keyv; \
      VT4(vd, pack2(__uint_as_float(rv0.x), __uint_as_float(rv0.y)), pack2(__uint_as_float(rv0.z), __uint_as_float(rv0.w))) \
      VT4(vd + 4 * AL, pack2(__uint_as_float(rv1.x), __uint_as_float(rv1.y)), pack2(__uint_as_float(rv1.z), __uint_as_float(rv1.w))) \
      VT4(vd + 8 * AL, pack2(__uint_as_float(rv2.x), __uint_as_float(rv2.y)), pack2(__uint_as_float(rv2.z), __uint_as_float(rv2.w))) \
      VT4(vd + 12 * AL, pack2(__uint_as_float(rv3.x), __uint_as_float(rv3.y)), pack2(__uint_as_float(rv3.z), __uint_as_float(rv3.w))) \
    } else { \
      float x[4][4]; \
      const unsigned kw[8] = {rk0.x, rk0.y, rk1.x, rk1.y, rk2.x, rk2.y, rk3.x, rk3.y}; \
      _Pragma("unroll") for (int c = 0; c < 4; ++c) { \
        x[c][0] = __uint_as_float(kw[2 * c] << 16); x[c][1] = __uint_as_float(kw[2 * c] & 0xffff0000u); \
        x[c][2] = __uint_as_float(kw[2 * c + 1] << 16); x[c][3] = __uint_as_float(kw[2 * c + 1] & 0xffff0000u); } \
      float ss = 0.f; \
      _Pragma("unroll") for (int c = 0; c < 4; ++c) _Pragma("unroll") for (int i = 0; i < 4; ++i) ss += x[c][i] * x[c][i]; \
      ss += __shfl_xor(ss, 1); ss += __shfl_xor(ss, 2); \
      const float rstd = rsqrtf(ss * (1.f / 64.f) + EPSF); \
      _Pragma("unroll") for (int c = 0; c < 4; ++c) _Pragma("unroll") for (int i = 0; i < 4; ++i) x[c][i] *= rstd * knw[c * 4 + i]; \
      if (lat) { \
        _Pragma("unroll") for (int i = 0; i < 4; ++i) { \
          float x1 = x[0][i], x2 = x[1][i]; x[0][i] = x1 * rrc[i] - x2 * rrs[i]; x[1][i] = x2 * rrc[i] + x1 * rrs[i]; \
          x1 = x[2][i]; x2 = x[3][i]; x[2][i] = x1 * ccs[i] - x2 * csn[i]; x[3][i] = x2 * ccs[i] + x1 * csn[i]; } \
      } \
      bf16_t* kd = (KB) + keyk * AL + 4 * s4; \
      _Pragma("unroll") for (int c = 0; c < 4; ++c) *(uint2*)(kd + 16 * c) = make_uint2(pack2(x[c][0], x[c][1]), pack2(x[c][2], x[c][3])); \
      if (wr) { \
        float* fd = p.out + OUT_CK + ((size_t)((b * 2 + e) * 2 + kvh) * 256 + kt0_ + keyk) * 64 + 4 * s4; \
        _Pragma("unroll") for (int c = 0; c < 4; ++c) *(float4*)(fd + 16 * c) = make_float4(x[c][0], x[c][1], x[c][2], x[c][3]); \
        float* fv = p.out + OUT_CV + ((size_t)((b * 2 + e) * 2 + kvh) * 256 + kt0_ + keyv) * 64 + cq * 16; \
        *(float4*)(fv) = make_float4(__uint_as_float(rv0.x << 16), __uint_as_float(rv0.x & 0xffff0000u), __uint_as_float(rv0.y << 16), __uint_as_float(rv0.y & 0xffff0000u)); \
        *(float4*)(fv + 4) = make_float4(__uint_as_float(rv0.z << 16), __uint_as_float(rv0.z & 0xffff0000u), __uint_as_float(rv0.w << 16), __uint_as_float(rv0.w & 0xffff0000u)); \
        *(float4*)(fv + 8) = make_float4(__uint_as_float(rv1.x << 16), __uint_as_float(rv1.x & 0xffff0000u), __uint_as_float(rv1.y << 16), __uint_as_float(rv1.y & 0xffff0000u)); \
        *(float4*)(fv + 12) = make_float4(__uint_as_float(rv1.z << 16), __uint_as_float(rv1.z & 0xffff0000u), __uint_as_float(rv1.w << 16), __uint_as_float(rv1.w & 0xffff0000u)); \
      } \
      bf16_t* vd = (VB) + (cq * 16) * AL + keyv; \
      VT4(vd, rv0.x, rv0.y) VT4(vd + 4 * AL, rv0.z, rv0.w) VT4(vd + 8 * AL, rv1.x, rv1.y) VT4(vd + 12 * AL, rv1.z, rv1.w) \
    } }
  int cur = 0;
  TILE_LOAD(tlo)
  uint2 zq[2][4];
#pragma unroll
  for (int dvt = 0; dvt < 2; ++dvt)
#pragma unroll
    for (int g4 = 0; g4 < 4; ++g4)
      zq[dvt][g4] = *(const uint2*)(P + (size_t)(tokbase + q0 + r) * LDP_O + PO_ZA + hq * 64 + dvt * 32 + 8 * g4 + 4 * h);
  {
    const int qi = lane >> 1, sub = lane & 1;
    const bf16_t* src = P + (size_t)(tokbase + q0 + qi) * LDP_O + PO_Q + hq * 64;
    qk_prep<8>(src, p.in[I_QNW] + e * 64, lat, q0 + qi, 0.125f, sub, RT, Qs + (w * 32 + qi) * AL, nullptr);
  }
  __syncthreads();
  bf16x8 qf[4];
#pragma unroll
  for (int ks = 0; ks < 4; ++ks) qf[ks] = *(const bf16x8*)(Qs + (w * 32 + r) * AL + ks * 16 + h * 8);
  float m_run = p.in[I_SINK][e * 8 + hq];
  float l_run = 1.f;
  f32x16 o[2];
  o[0] = zero16(); o[1] = zero16();
  TILE_STORE(tlo, Ks, Vt)
  __syncthreads();
  for (int ti = tlo; ti < ntile;) {
    const bool fromcache = lat && ti >= 5;
    const int kt0 = fromcache ? (ti - 5) * 64 : kbase + ti * 64;
    const int tn = TILE_NEXT(ti);
    if (tn < ntile) { TILE_LOAD(tn) }
    const bf16_t* Kc = cur ? Ks1 : Ks;
    const bf16_t* Vc = cur ? Vt1 : Vt;
    f32x16 s[2];
#pragma unroll
    for (int mt = 0; mt < 2; ++mt) {
      s[mt] = zero16();
#pragma unroll
      for (int ks = 0; ks < 4; ++ks) {
        bf16x8 a = *(const bf16x8*)(Kc + (mt * 32 + r) * AL + ks * 16 + h * 8);
        s[mt] = mfma(a, qf[ks], s[mt]);
      }
    }
    if (lat && !fromcache) {
      const int qpos = q0 + r;
#pragma unroll
      for (int mt = 0; mt < 2; ++mt)
#pragma unroll
        for (int q = 0; q < 16; ++q) {
          int kpos = kt0 + mt * 32 + crow(q, h);
          int dd = kpos - qpos;
          if (dd > 128 || dd < -128) s[mt][q] = -1e30f;
        }
    }
    float mx = -3e38f;
#pragma unroll
    for (int mt = 0; mt < 2; ++mt)
#pragma unroll
      for (int q = 0; q < 16; ++q) mx = fmaxf(mx, s[mt][q]);
    mx = fmaxf(mx, __shfl_xor(mx, 32));
    const float m_new = fmaxf(m_run, mx);
    const float alpha = __expf(m_run - m_new);
    float rs = 0.f;
#pragma unroll
    for (int mt = 0; mt < 2; ++mt)
#pragma unroll
      for (int q = 0; q < 16; ++q) { float pv = __expf(s[mt][q] - m_new); s[mt][q] = pv; rs += pv; }
    rs += __shfl_xor(rs, 32);
    l_run = l_run * alpha + rs;
    m_run = m_new;
#pragma unroll
    for (int q = 0; q < 16; ++q) { o[0][q] *= alpha; o[1][q] *= alpha; }
#pragma unroll
    for (int mt = 0; mt < 2; ++mt)
#pragma unroll
      for (int sx = 0; sx < 2; ++sx) {
        bf16x8 pf;
#pragma unroll
        for (int j = 0; j < 8; ++j) pf[j] = (short)f2bf(s[mt][8 * sx + j]);
#pragma unroll
        for (int dvt = 0; dvt < 2; ++dvt) {
          const bf16_t* vp = Vc + (dvt * 32 + r) * AL + mt * 32 + 16 * sx + 4 * h;
          s16x4 lo = *(const s16x4*)vp;
          s16x4 hi4 = *(const s16x4*)(vp + 8);
          bf16x8 a = __builtin_shufflevector(lo, hi4, 0, 1, 2, 3, 4, 5, 6, 7);
          o[dvt] = mfma(a, pf, o[dvt]);
        }
      }
      if (tn < ntile) {
      if (cur) { TILE_STORE(tn, Ks, Vt) } else { TILE_STORE(tn, Ks1, Vt1) }
    }
    __syncthreads();
    ti = tn;
    cur ^= 1;
  }
#undef TILE_NEXT
#undef TILE_LOAD
#undef TILE_STORE
#undef VT4
  const float inv = 1.f / l_run;
  const int tok = tokbase + q0 + r;
#pragma unroll
  for (int dvt = 0; dvt < 2; ++dvt)
#pragma unroll
    for (int g4 = 0; g4 < 4; ++g4) {
      const int dv = dvt * 32 + 8 * g4 + 4 * h;
      uint2 zz = zq[dvt][g4];
      float z0 = __uint_as_float(zz.x << 16), z1 = __uint_as_float(zz.x & 0xffff0000u);
      float z2 = __uint_as_float(zz.y << 16), z3 = __uint_as_float(zz.y & 0xffff0000u);
      float y0 = o[dvt][4 * g4 + 0] * inv * siluf(z0);
      float y1 = o[dvt][4 * g4 + 1] * inv * siluf(z1);
      float y2 = o[dvt][4 * g4 + 2] * inv * siluf(z2);
      float y3 = o[dvt][4 * g4 + 3] * inv * siluf(z3);
      *(uint2*)(Y + (size_t)tok * DM + hq * 64 + dv) = make_uint2(pack2(y0, y1), pack2(y2, y3));
    }
}

DI void conv_unit(const Params& p, int e, int u) {
  const int tid = otid();
  const bf16_t* P = (const bf16_t*)(p.ws + OFF_P);
  bf16_t* Y = (bf16_t*)(p.ws + OFF_HY);
  const int t0 = u * 16;
  const int c = tid * 2;
  int seg0, seg1;
  if (t0 < NTOK_P) { seg0 = t0 & ~255; seg1 = seg0 + 256; }
  else { seg0 = NTOK_P + ((t0 - NTOK_P) & ~4095); seg1 = seg0 + 4096; }
  const float* cw = p.in[I_CONVW] + (size_t)e * 3 * 512;
  const float w00 = cw[c], w01 = cw[c + 1], w10 = cw[512 + c], w11 = cw[512 + c + 1], w20 = cw[1024 + c], w21 = cw[1024 + c + 1];
  const float b0 = p.in[I_CONVB][e * 512 + c], b1 = p.in[I_CONVB][e * 512 + c + 1];
  auto prod = [&](int t, float& a, float& b) {
    if (t < seg0 || t >= seg1) { a = 0.f; b = 0.f; return; }
    unsigned xc = *(const unsigned*)(P + (size_t)t * LDP_O + PO_XC + c);
    unsigned cg_ = *(const unsigned*)(P + (size_t)t * LDP_O + PO_CG + c);
    a = __uint_as_float(xc << 16) * __uint_as_float(cg_ << 16);
    b = __uint_as_float(xc & 0xffff0000u) * __uint_as_float(cg_ & 0xffff0000u);
  };
  float pa0, pa1, pb0, pb1, pc0, pc1;
  prod(t0 - 1, pa0, pa1);
  prod(t0, pb0, pb1);
#pragma unroll
  for (int i = 0; i < 16; ++i) {
    const int t = t0 + i;
    prod(t + 1, pc0, pc1);
    unsigned bg = *(const unsigned*)(P + (size_t)t * LDP_O + PO_BG + c);
    unsigned zc = *(const unsigned*)(P + (size_t)t * LDP_O + PO_ZC + c);
    float y0 = __uint_as_float(bg << 16) * (w00 * pa0 + w10 * pb0 + w20 * pc0 + b0) * siluf(__uint_as_float(zc << 16));
    float y1 = __uint_as_float(bg & 0xffff0000u) * (w01 * pa1 + w11 * pb1 + w21 * pc1 + b1) * siluf(__uint_as_float(zc & 0xffff0000u));
    *(unsigned*)(Y + (size_t)t * DM + 512 + c) = pack2(y0, y1);
    pa0 = pb0; pa1 = pb1; pb0 = pc0; pb1 = pc1;
  }
}


#define QCTR(l, ph) ((unsigned*)(p.ws + OFF_BAR) + 3584 + 16 * ((l) * 4 + (ph)))
DI int next_unit(unsigned* ctr, volatile int* sh) {
  __syncthreads();
  if (threadIdx.x == 0) *sh = (int)atomicAdd(ctr, 1u);
  __syncthreads();
  return *sh;
}
#ifndef REP_A
#define REP_A 1
#endif
#ifndef REP_INPROJ
#define REP_INPROJ 1
#endif
#ifndef REP_EVEN
#define REP_EVEN 1
#endif
#ifndef REP_ODD
#define REP_ODD 1
#endif
#define REP_G1 1
#define REP_S1 1
#define REP_G3 1
#define REP_S3 1
#ifndef REP_SYNC
#define REP_SYNC 1
#endif
#define GSYNC() do { _Pragma("unroll 1") for (int rs_ = 0; rs_ < REP_SYNC; ++rs_) xcd_barrier(xb); } while (0)
__global__ void __launch_bounds__(256, 2) fwd_megakernel(Params p) {
  cg::grid_group grid = cg::this_grid();
  __shared__ __attribute__((aligned(16))) char smem[SMEM_BYTES];
  __shared__ uint4 xb_words;
  __shared__ int qsh;
  if (threadIdx.x == 0) xb_words = make_uint4(0u, 0u, 0u, 0u);
  __syncthreads();
  XcdBarrier xb = xcd_barrier_post((unsigned*)(p.ws + OFF_BAR), (volatile LAS unsigned*)&xb_words);
  if (p.ws == nullptr) grid.sync();
  phase0(p, smem);
  GSYNC();
#pragma unroll 1
  for (int l = 0; l < 4; ++l) {
    const int e = l >> 1;
#pragma unroll 1
    for (int rep = 0; rep < REP_A; ++rep) {
      phaseA(p, l);
      GSYNC();
    }
    const int odd = l & 1;
#pragma unroll 1
    for (int rep = 0; rep < REP_INPROJ; ++rep) {
      gemm_phase<EPI_P, 16>(p, l, (const bf16_t*)(p.ws + OFF_HY), DM, (const bf16_t*)(p.ws + OFF_WIN), DM, odd ? LDP_O / 128 : LDP_E / 128, odd ? LDP_O : LDP_E, smem);
      GSYNC();
    }
    if (!odd) {
#pragma unroll 1
      for (int rep = 0; rep < REP_EVEN; ++rep) {
        for (int u = next_unit(QCTR(l, 0), &qsh); u < 512 + 512; u = next_unit(QCTR(l, 0), &qsh)) {
          if (u < 512) { _Pragma("unroll 1") for (int r2 = 0; r2 < REP_G1; ++r2) gla_pass1_unit(p, e, u, smem); }
          else { _Pragma("unroll 1") for (int r2 = 0; r2 < REP_S1; ++r2) s5_pass1_unit(p, e, u - 512, smem); }
        }
        GSYNC();
        for (int u = next_unit(QCTR(l, 1), &qsh); u < 384 + 768; u = next_unit(QCTR(l, 1), &qsh)) {
          if (u < 384) { _Pragma("unroll 1") for (int r2 = 0; r2 < REP_G3; ++r2) gla_pass3_unit(p, e, u, smem); }
          else { _Pragma("unroll 1") for (int r2 = 0; r2 < REP_S3; ++r2) s5_pass3_unit(p, e, u - 384, smem); }
        }
        GSYNC();
        gemm_phase<EPI_GLU, 8>(p, l, (const bf16_t*)(p.ws + OFF_Z5), 512, (const bf16_t*)(p.ws + OFF_WGLU), 512, 4, 0, smem);
        GSYNC();
      }
    } else {
#pragma unroll 1
      for (int rep = 0; rep < REP_ODD; ++rep) {
        for (int u = next_unit(QCTR(l, 2), &qsh); u < 1536 + 1536; u = next_unit(QCTR(l, 2), &qsh)) {
          if (u < 1024) attn_unit(p, e, u + 512, smem);
          else if (u < 1536) attn_unit(p, e, u - 1024, smem);
          else conv_unit(p, e, u - 1536);
        }
        GSYNC();
      }
    }
    gemm_phase<EPI_RES, 16>(p, l, (const bf16_t*)(p.ws + OFF_HY), DM, (const bf16_t*)(p.ws + OFF_WOUT), DM, 8, 0, smem);
    if (l < 3) GSYNC();
  }
}

extern "C" void kernel_launch(void* const* d_in, const int* in_sizes, int n_in, void* d_out, int out_size,
                              void* d_ws, size_t ws_size, hipStream_t stream) {
  static int grid_blocks = 0;
  if (!grid_blocks) {
    int dev = 0, cus = 0, per_cu = 0;
    hipGetDevice(&dev);
    hipDeviceGetAttribute(&cus, hipDeviceAttributeMultiprocessorCount, dev);
    hipOccupancyMaxActiveBlocksPerMultiprocessor(&per_cu, fwd_megakernel, 256, 0);
    if (per_cu > 2) per_cu = 2;
    if (per_cu < 1) per_cu = 1;
    grid_blocks = cus * per_cu;
  }
  if (ws_size < WS_NEED || n_in < 34) { fprintf(stderr, "workspace too small\n"); return; }
  Params p{};
  for (int i = 0; i < 34; ++i) p.in[i] = (const float*)d_in[i];
  p.out = (float*)d_out;
  p.ws = (char*)d_ws;
  (void)hipMemsetAsync((char*)d_ws + OFF_BAR, 0, 16384, stream);
  void* args[] = {&p};
  hipError_t err = hipLaunchCooperativeKernel((void*)fwd_megakernel, dim3(grid_blocks), dim3(256), args, 0, stream);
  if (err != hipSuccess) fprintf(stderr, "cooperative launch failed: %s (grid %d)\n", hipGetErrorString(err), grid_blocks);
}
```

```cpp
#include <hip/hip_runtime.h>
#include <hip/hip_cooperative_groups.h>
#include <cstdio>
namespace cg = cooperative_groups;

typedef unsigned short bf16_t;
using bf16x8 = __attribute__((ext_vector_type(8))) short;
using s16x4  = __attribute__((ext_vector_type(4))) short;
using f32x16 = __attribute__((ext_vector_type(16))) float;
#define DI __device__ __forceinline__

#define NTOK    24576
#define NTOK_P  8192
#define DM      1024
#define LDP_E   2688
#define LDP_O   3328
#define EPSF    1e-6f

#define PE_Q   0
#define PE_K   256
#define PE_V   512
#define PE_ZG  1024
#define PE_U   1536
#define PE_ZS  2048
#define PE_LF  2560
#define PO_Q   0
#define PO_K   512
#define PO_V   640
#define PO_ZA  768
#define PO_XC  1280
#define PO_BG  1792
#define PO_CG  2304
#define PO_ZC  2816

#define OUT_GLA  25165824
#define OUT_S5R  29360128
#define OUT_S5I  29622272
#define OUT_CK   29884416
#define OUT_CV   31981568

#define OFF_WIN   0ull
#define OFF_WOUT  6815744ull
#define OFF_WGLU  8912896ull
#define OFF_MOD   9437184ull
#define OFF_LB    9682944ull
#define OFF_LB256 (OFF_LB + 65536ull)
#define OFF_BBT   (OFF_LB256 + 65536ull)
#define OFF_CM    (OFF_BBT + 524288ull)
#define OFF_ROPE  (OFF_CM + 524288ull)
#define OFF_S5ES  (OFF_ROPE + 8192ull)
#define OFF_GLAL  (OFF_S5ES + 2097152ull)
#define OFF_GLAD  (OFF_GLAL + 16777216ull)
#define OFF_HY    (OFF_GLAD + 131072ull)
#define OFF_P     (OFF_HY + 50331648ull)
#define OFF_Z5    (OFF_P + 132120576ull)
#define OFF_BAR   (OFF_P + 163577856ull)
#define WS_NEED   (OFF_BAR + 16384ull)

#define SMEM_BYTES 80896

struct Params {
  const float* in[34];
  float* out;
  char* ws;
};

enum { I_XP = 0, I_XS, I_C, I_SGLA, I_S5R, I_S5I, I_CK, I_CV, I_CCTX, I_NORMW, I_WADA, I_BADA, I_WINE, I_WOUTE,
       I_GW2, I_GB2, I_GON, I_LAMR, I_LAMI, I_LOGDT, I_BRE, I_BIM, I_CRE, I_CIM, I_S5D, I_WGLU, I_BGLU,
       I_WINO, I_WOUTO, I_QNW, I_KNW, I_SINK, I_CONVW, I_CONVB };

DI int otid() { int t = threadIdx.x; asm volatile("" : "+v"(t)); return t; }
typedef __bf16 hbf16x2 __attribute__((ext_vector_type(2)));
typedef float hf32x2 __attribute__((ext_vector_type(2)));
DI unsigned pack2(float a, float b) { hf32x2 v = {a, b}; return __builtin_bit_cast(unsigned, __builtin_convertvector(v, hbf16x2)); }
DI bf16_t f2bf(float x) { return (bf16_t)(pack2(x, x) & 0xffffu); }
DI float bf2f(bf16_t b) { return __uint_as_float(((unsigned)b) << 16); }
DI float siluf(float x) { return x * __builtin_amdgcn_rcpf(1.f + __expf(-x)); }
DI float sigmf(float x) { return __builtin_amdgcn_rcpf(1.f + __expf(-x)); }
DI int crow(int q, int h) { return (q & 3) + 8 * (q >> 2) + 4 * h; }
DI f32x16 mfma(bf16x8 a, bf16x8 b, f32x16 c) { return __builtin_amdgcn_mfma_f32_32x32x16_bf16(a, b, c, 0, 0, 0); }
DI f32x16 zero16() { f32x16 z; for (int i = 0; i < 16; ++i) z[i] = 0.f; return z; }

template <int K>
DI void mma_tile(f32x16& acc, const bf16_t* A, int lda, const bf16_t* Bt, int ldb, int lane) {
  const int r = lane & 31, h = lane >> 5;
#pragma unroll
  for (int s = 0; s < K / 16; ++s) {
    bf16x8 a = *(const bf16x8*)(A + r * lda + s * 16 + h * 8);
    bf16x8 b = *(const bf16x8*)(Bt + r * ldb + s * 16 + h * 8);
    acc = mfma(a, b, acc);
  }
}

#define XB_TMO      128
#define XB_XCNT(j)  (256  + 64 * (j))
#define XB_XSUB(j)  (1280 + 64 * (j))
#define XB_XGEN(j)  (2304 + 64 * (j))
#define XB_TOP      3328
#define XB_TOPGEN   3392
#define XCD_BAR_WORDS 3456
#define XB_SPIN_CAP (1u << 18)
#define LAS __attribute__((address_space(3)))

__device__ __forceinline__ unsigned xb_ld(unsigned* p)              { return __hip_atomic_load(p, __ATOMIC_RELAXED, __HIP_MEMORY_SCOPE_AGENT); }
__device__ __forceinline__ unsigned xb_add(unsigned* p, unsigned v) { return __hip_atomic_fetch_add(p, v, __ATOMIC_RELAXED, __HIP_MEMORY_SCOPE_AGENT); }
__device__ __forceinline__ unsigned xb_xcc_id() { return (unsigned)__builtin_amdgcn_s_getreg((3 << 11) | 20) & 0xFu; }
#define XB_SPIN(cond, bar) do { unsigned _sp = 0; while (cond) { __builtin_amdgcn_s_sleep(1); \
    if ((++_sp & 255u) == 0u) { if (xb_ld(&(bar)[XB_TMO])) break; if (_sp > XB_SPIN_CAP) { atomicAdd(&(bar)[XB_TMO], 1u); break; } } } } while (0)

struct XcdBarrier {
    unsigned* bar; unsigned x;
    volatile LAS unsigned* st;
};

__device__ __forceinline__ XcdBarrier xcd_barrier_post(unsigned* bar, volatile LAS unsigned* st) {
    XcdBarrier b; b.bar = bar; b.x = xb_xcc_id(); b.st = st;
    if (threadIdx.x == 0) (void)xb_add(&bar[XB_XCNT(b.x)], 1u);
    return b;
}
__device__ __forceinline__ void xcd_barrier_complete(unsigned* bar, unsigned x, unsigned& nloc, unsigned& nx) {
    const unsigned G = gridDim.x * gridDim.y * gridDim.z;
    unsigned sum, cnt, mine, sp = 0u;
    for (;;) {
        sum = 0u; cnt = 0u; mine = 0u;
#pragma unroll
        for (unsigned j = 0; j < 16; ++j) { const unsigned c = xb_ld(&bar[XB_XCNT(j)]); sum += c; cnt += (c > 0u) ? 1u : 0u; mine = (j == x) ? c : mine; }
        if (sum == G) break;
        __builtin_amdgcn_s_sleep(1);
        if ((++sp & 255u) == 0u) { if (xb_ld(&bar[XB_TMO])) break; if (sp > XB_SPIN_CAP) { atomicAdd(&bar[XB_TMO], 1u); break; } }
    }
    nloc = mine > 0u ? mine : 1u; nx = cnt > 0u ? cnt : 1u;
}

__device__ __forceinline__ void xcd_barrier(const XcdBarrier& b) {
    asm volatile("s_waitcnt vmcnt(0)" ::: "memory");
    __syncthreads();
    if (threadIdx.x == 0) {
        unsigned* bar = b.bar;
        __builtin_amdgcn_s_waitcnt(0);
        unsigned nloc = b.st[0], nx = b.st[1];
        if (nloc == 0u) { xcd_barrier_complete(bar, b.x, nloc, nx); b.st[0] = nloc; b.st[1] = nx; }
        const unsigned old = xb_add(&bar[XB_XSUB(b.x)], 1u);
        const unsigned gen = old / nloc;
        if (old + 1u == (gen + 1u) * nloc) {
            __builtin_amdgcn_fence(__ATOMIC_RELEASE, "agent");
            asm volatile("s_waitcnt vmcnt(0)" ::: "memory");
            const unsigned og = xb_add(&bar[XB_TOP], 1u);
            const unsigned tg = og / nx;
            if (og + 1u == (tg + 1u) * nx) xb_add(&bar[XB_TOPGEN], 1u);
            else XB_SPIN(xb_ld(&bar[XB_TOPGEN]) == tg, bar);
            __builtin_amdgcn_fence(__ATOMIC_ACQUIRE, "agent");
            xb_add(&bar[XB_XGEN(b.x)], 1u);
            asm volatile("s_waitcnt vmcnt(0)" ::: "memory");
        } else {
            XB_SPIN(xb_ld(&bar[XB_XGEN(b.x)]) == gen, bar);
            __builtin_amdgcn_fence(__ATOMIC_ACQUIRE, "agent");
            asm volatile("s_waitcnt vmcnt(0)" ::: "memory");
        }
    }
    __syncthreads();
}


DI void phase0(const Params& p, char* smem) {
  const int tid = otid();
  float* sc = (float*)smem;
  float* red = sc + 5 * 1024;
  float* MOD = (float*)(p.ws + OFF_MOD);
  const int NU = 384 + 128 + 1;
  for (int u = blockIdx.x; u < NU; u += gridDim.x) {
    if (u < 384) {
      const int l = u / 96, nc = u % 96;
      __syncthreads();
      for (int i = tid; i < 5 * 1024; i += 256) {
        int j = i >> 10, k = i & 1023;
        float v = (j == 0) ? p.in[I_CCTX][k] : p.in[I_C][(j - 1) * 1024 + k];
        sc[i] = v / (1.f + expf(-v));
      }
      __syncthreads();
      const int col = tid & 31, kg = tid >> 5;
      const float* w = p.in[I_WADA] + (size_t)l * 1024 * 3072 + nc * 32 + col;
      float a0 = 0, a1 = 0, a2 = 0, a3 = 0, a4 = 0;
#pragma unroll 16
      for (int k = kg; k < 1024; k += 8) {
        float wv = w[(size_t)k * 3072];
        a0 += sc[k] * wv; a1 += sc[1024 + k] * wv; a2 += sc[2048 + k] * wv; a3 += sc[3072 + k] * wv; a4 += sc[4096 + k] * wv;
      }
      red[(kg * 5 + 0) * 32 + col] = a0; red[(kg * 5 + 1) * 32 + col] = a1; red[(kg * 5 + 2) * 32 + col] = a2;
      red[(kg * 5 + 3) * 32 + col] = a3; red[(kg * 5 + 4) * 32 + col] = a4;
      __syncthreads();
      if (tid < 160) {
        int j = tid >> 5, c2 = tid & 31;
        float s = 0;
        for (int g = 0; g < 8; ++g) s += red[(g * 5 + j) * 32 + c2];
        int n = nc * 32 + c2;
        MOD[(l * 5 + j) * 3072 + n] = s + p.in[I_BADA][l * 3072 + n];
      }
    } else if (u < 384 + 128) {
      const int v = u - 384;
      const int e = v >> 6, dir = (v >> 5) & 1, g = v & 31;
      if (tid < 64) {
        const int pp = tid;
        const int idx = ((e * 2 + dir) * 32 + g) * 64 + pp;
        double dt = exp((double)p.in[I_LOGDT][(e * 2 + dir) * 32 + g]);
        double lr = (double)p.in[I_LAMR][idx], li = (double)p.in[I_LAMI][idx];
        double mag = exp(lr * dt);
        double ang = li * dt;
        double tw = 6.283185307179586476925286766559;
        double kq = rint(ang / tw);
        double ra = ang - kq * tw;
        double lbr = mag * cos(ra), lbi = mag * sin(ra);
        double den = lr * lr + li * li;
        double nr = lbr - 1.0, ni = lbi;
        double cr = (nr * lr + ni * li) / den, ci = (ni * lr - nr * li) / den;
        float* LB = (float*)(p.ws + OFF_LB);
        float* LB256 = (float*)(p.ws + OFF_LB256);
        LB[idx * 2] = (float)lbr; LB[idx * 2 + 1] = (float)lbi;
        double pr = lbr, pi = lbi;
        for (int i = 0; i < 8; ++i) { double t = pr * pr - pi * pi; pi = 2.0 * pr * pi; pr = t; }
        LB256[idx * 2] = (float)pr; LB256[idx * 2 + 1] = (float)pi;
        bf16_t* BBT = (bf16_t*)(p.ws + OFF_BBT) + (size_t)((e * 2 + dir) * 32 + g) * 128 * 16;
        const float* bre = p.in[I_BRE] + ((size_t)(e * 32 + g) * 64 + pp) * 16;
        const float* bim = p.in[I_BIM] + ((size_t)(e * 32 + g) * 64 + pp) * 16;
        for (int hh = 0; hh < 16; ++hh) {
          double br = bre[hh], bi = bim[hh];
          const int nre = (pp >> 5) * 64 + (pp & 31);
          BBT[nre * 16 + hh] = f2bf((float)(cr * br - ci * bi));
          BBT[(nre + 32) * 16 + hh] = f2bf((float)(cr * bi + ci * br));
        }
        if (dir == 0) {
          bf16_t* CM = (bf16_t*)(p.ws + OFF_CM) + (size_t)(e * 32 + g) * 32 * 128;
          for (int hh = 0; hh < 32; ++hh) {
            float cre = 0.f, cim = 0.f;
            if (hh < 16) {
              cre = p.in[I_CRE][((size_t)(e * 32 + g) * 16 + hh) * 64 + pp];
              cim = p.in[I_CIM][((size_t)(e * 32 + g) * 16 + hh) * 64 + pp];
            }
            CM[hh * 128 + 2 * pp] = f2bf(cre);
            CM[hh * 128 + 2 * pp + 1] = f2bf(-cim);
          }
        }
      }
    } else {
      float* RT = (float*)(p.ws + OFF_ROPE);
      for (int i = tid; i < 64 * 16; i += 256) {
        int pos = i >> 4, f = i & 15;
        double fr = exp(-(double)f / 16.0 * 9.2103403719761827360719658187375);
        double ang = (double)pos * fr;
        double tw = 6.283185307179586476925286766559;
        double ra = ang - rint(ang / tw) * tw;
        RT[i * 2] = (float)cos(ra); RT[i * 2 + 1] = (float)sin(ra);
      }
    }
  }
}

DI void convert_tile(const float* src, int nsrc, bf16_t* dst, int K, int n0, int k0, int mapmode, int tid) {
  const int n = n0 + (tid & 63), kq = tid >> 6;
  int sc = n;
  if (mapmode == 1) {
    if (n < 1024) sc = n;
    else if (n < 2560) sc = n + 32;
    else if (n < 2592) sc = n - 1536;
    else sc = -1;
  }
  unsigned w[8];
#pragma unroll
  for (int i = 0; i < 8; ++i) {
    int k = k0 + kq * 16 + 2 * i;
    float a = 0.f, b = 0.f;
    if (sc >= 0) { a = src[(size_t)k * nsrc + sc]; b = src[(size_t)(k + 1) * nsrc + sc]; }
    w[i] = pack2(a, b);
  }
  uint4* d = (uint4*)(dst + (size_t)n * K + k0 + kq * 16);
  d[0] = make_uint4(w[0], w[1], w[2], w[3]);
  d[1] = make_uint4(w[4], w[5], w[6], w[7]);
}

DI void phaseA(const Params& p, int l) {
  const int tid = otid();
  const int odd = l & 1, e = l >> 1;
  const int n_in = (odd ? 52 : 42) * 16;
  const int n_out = 256;
  const int n_glu = odd ? 0 : 64;
  const int n_norm = NTOK / 16;
  const int total = n_in + n_out + n_glu + n_norm;
  bf16_t* WIN = (bf16_t*)(p.ws + OFF_WIN);
  bf16_t* WOUT = (bf16_t*)(p.ws + OFF_WOUT);
  bf16_t* WGLU = (bf16_t*)(p.ws + OFF_WGLU);
  bf16_t* H = (bf16_t*)(p.ws + OFF_HY);
  const float* MOD = (const float*)(p.ws + OFF_MOD);
  for (int u = blockIdx.x; u < total; u += gridDim.x) {
    if (u < n_in) {
      int nt = u >> 4, kt = u & 15;
      if (odd) convert_tile(p.in[I_WINO] + (size_t)e * 1024 * 3328, 3328, WIN, 1024, nt * 64, kt * 64, 0, tid);
      else convert_tile(p.in[I_WINE] + (size_t)e * 1024 * 2592, 2592, WIN, 1024, nt * 64, kt * 64, 1, tid);
    } else if (u < n_in + n_out) {
      int v = u - n_in; int nt = v >> 4, kt = v & 15;
      const float* src = (odd ? p.in[I_WOUTO] : p.in[I_WOUTE]) + (size_t)e * 1024 * 1024;
      convert_tile(src, 1024, WOUT, 1024, nt * 64, kt * 64, 0, tid);
    } else if (u < n_in + n_out + n_glu) {
      int v = u - n_in - n_out; int nt = v >> 3, kt = v & 7;
      convert_tile(p.in[I_WGLU] + (size_t)e * 512 * 512, 512, WGLU, 512, nt * 64, kt * 64, 0, tid);
    } else {
      int v = u - n_in - n_out - n_glu;
      const int tok0 = v * 16 + (tid >> 6) * 4;
      const int lane = tid & 63;
      const float* x;
      if (l == 0) x = (tok0 < NTOK_P) ? p.in[I_XP] + (size_t)tok0 * DM : p.in[I_XS] + (size_t)(tok0 - NTOK_P) * DM;
      else x = p.out + (size_t)tok0 * DM;
      const int j = (tok0 < NTOK_P) ? 0 : 1 + ((tok0 - NTOK_P) >> 12);
      const float* mod = MOD + (l * 5 + j) * 3072;
      const float* nw = p.in[I_NORMW] + l * 1024;
      float4 xv[4][4];
#pragma unroll
      for (int rr = 0; rr < 4; ++rr)
#pragma unroll
        for (int i = 0; i < 4; ++i) xv[rr][i] = *(const float4*)(x + (size_t)rr * DM + lane * 4 + 256 * i);
      float rstd[4];
#pragma unroll
      for (int rr = 0; rr < 4; ++rr) {
        float ss = 0.f;
#pragma unroll
        for (int i = 0; i < 4; ++i) ss += xv[rr][i].x * xv[rr][i].x + xv[rr][i].y * xv[rr][i].y + xv[rr][i].z * xv[rr][i].z + xv[rr][i].w * xv[rr][i].w;
#pragma unroll
        for (int o = 32; o >= 1; o >>= 1) ss += __shfl_xor(ss, o);
        rstd[rr] = rsqrtf(ss * (1.f / 1024.f) + EPSF);
      }
#pragma unroll
      for (int i = 0; i < 4; ++i) {
        const int k = lane * 4 + 256 * i;
        float4 w4 = *(const float4*)(nw + k);
        float4 sh = *(const float4*)(mod + k);
        float4 scl = *(const float4*)(mod + 1024 + k);
        const float c0 = w4.x * (1.f + scl.x), c1 = w4.y * (1.f + scl.y), c2 = w4.z * (1.f + scl.z), c3 = w4.w * (1.f + scl.w);
#pragma unroll
        for (int rr = 0; rr < 4; ++rr) {
          float h0 = xv[rr][i].x * rstd[rr] * c0 + sh.x;
          float h1 = xv[rr][i].y * rstd[rr] * c1 + sh.y;
          float h2 = xv[rr][i].z * rstd[rr] * c2 + sh.z;
          float h3 = xv[rr][i].w * rstd[rr] * c3 + sh.w;
          *(uint2*)(H + (size_t)(tok0 + rr) * DM + k) = make_uint2(pack2(h0, h1), pack2(h2, h3));
        }
      }
    }
  }
}

#define GLD 72
enum { EPI_P = 0, EPI_RES = 1, EPI_GLU = 2 };

template <int EPI, int KT>
DI void gemm_phase(const Params& p, int l, const bf16_t* A, int lda, const bf16_t* Bt, int ldb,
                           int NT, int ldp, char* smem) {
  const int tid = otid(), lane = tid & 63, w = tid >> 6;
  const int r = lane & 31, h = lane >> 5;
  const int wm = w >> 1, wn = w & 1;
  bf16_t* As = (bf16_t*)smem;
  bf16_t* Bs = As + 2 * 128 * GLD;
  const int lr = tid >> 3, lc = (tid & 7) * 8;
  const int MT = NTOK / 128;
  const int total = MT * NT;
  const float* MOD = (const float*)(p.ws + OFF_MOD);
  const int nslot = gridDim.x >> 3;
  if (blockIdx.x >= (gridDim.x >> 1)) { __builtin_amdgcn_s_sleep(56); }
  for (int k = 0;; ++k) {
    const int t = ((blockIdx.x & 7) + 8 * k) * nslot + (blockIdx.x >> 3);
    if (t >= total) break;
    const int band = t / (8 * NT), rem = t - band * 8 * NT;
    const int nt = rem >> 3, mt = band * 8 + (rem & 7);
    const int m0 = mt * 128, n0 = nt * 128;
    const bf16_t* Ag = A + (size_t)(m0 + lr) * lda + lc;
    const bf16_t* Bg = Bt + (size_t)(n0 + lr) * ldb + lc;
    uint4 xa0, xa1, xa2, xa3, xb0, xb1, xb2, xb3;
    uint4 ya0, ya1, ya2, ya3, yb0, yb1, yb2, yb3;
#define GLOADS(S, KOFS) \
    S##a0 = *(const uint4*)(Ag + (KOFS)); S##a1 = *(const uint4*)(Ag + (size_t)32 * lda + (KOFS)); \
    S##a2 = *(const uint4*)(Ag + (size_t)64 * lda + (KOFS)); S##a3 = *(const uint4*)(Ag + (size_t)96 * lda + (KOFS)); \
    S##b0 = *(const uint4*)(Bg + (KOFS)); S##b1 = *(const uint4*)(Bg + (size_t)32 * ldb + (KOFS)); \
    S##b2 = *(const uint4*)(Bg + (size_t)64 * ldb + (KOFS)); S##b3 = *(const uint4*)(Bg + (size_t)96 * ldb + (KOFS));
#define LSTORES(S, ST) \
    *(uint4*)(As + (ST) * 128 * GLD + (lr) * GLD + lc) = S##a0; *(uint4*)(As + (ST) * 128 * GLD + (lr + 32) * GLD + lc) = S##a1; \
    *(uint4*)(As + (ST) * 128 * GLD + (lr + 64) * GLD + lc) = S##a2; *(uint4*)(As + (ST) * 128 * GLD + (lr + 96) * GLD + lc) = S##a3; \
    *(uint4*)(Bs + (ST) * 128 * GLD + (lr) * GLD + lc) = S##b0; *(uint4*)(Bs + (ST) * 128 * GLD + (lr + 32) * GLD + lc) = S##b1; \
    *(uint4*)(Bs + (ST) * 128 * GLD + (lr + 64) * GLD + lc) = S##b2; *(uint4*)(Bs + (ST) * 128 * GLD + (lr + 96) * GLD + lc) = S##b3;
    bf16x8 fa0[4], fa1[4], fb0[4], fb1[4];
#define FRAGS(ST) { \
      const bf16_t* as = As + (ST) * 128 * GLD + (wm * 64 + r) * GLD + h * 8; \
      const bf16_t* bs = Bs + (ST) * 128 * GLD + (wn * 64 + r) * GLD + h * 8; \
      _Pragma("unroll") for (int s = 0; s < 4; ++s) { \
        fa0[s] = *(const bf16x8*)(as + s * 16); \
        fb0[s] = *(const bf16x8*)(bs + s * 16); \
        fa1[s] = *(const bf16x8*)(as + 32 * GLD + s * 16); \
        fb1[s] = *(const bf16x8*)(bs + 32 * GLD + s * 16); \
      } \
      __builtin_amdgcn_sched_barrier(0); }
#define MFMAS() { \
      _Pragma("unroll") for (int s = 0; s < 4; ++s) { \
        acc00 = mfma(fa0[s], fb0[s], acc00); acc01 = mfma(fa0[s], fb1[s], acc01); \
        acc10 = mfma(fa1[s], fb0[s], acc10); acc11 = mfma(fa1[s], fb1[s], acc11); \
      } \
      _Pragma("unroll") for (int g = 0; g < 8; ++g) { \
        __builtin_amdgcn_sched_group_barrier(0x008, 2, 0); \
        __builtin_amdgcn_sched_group_barrier(0x200, 1, 0); \
        __builtin_amdgcn_sched_group_barrier(0x020, 1, 0); \
      } }
    GLOADS(x, 0)
    LSTORES(x, 0)
    GLOADS(x, 64)
    GLOADS(y, 128)
    __syncthreads();
    f32x16 acc00 = zero16(), acc01 = zero16(), acc10 = zero16(), acc11 = zero16();
#pragma unroll
    for (int kt = 0; kt < KT; kt += 2) {
      FRAGS(0)
      LSTORES(x, 1)
      if (kt + 3 < KT) { GLOADS(x, (kt + 3) * 64) }
      MFMAS()
      __syncthreads();
      __builtin_amdgcn_sched_barrier(0);
      FRAGS(1)
      if (kt + 2 < KT) { LSTORES(y, 0) }
      if (kt + 4 < KT) { GLOADS(y, (kt + 4) * 64) }
      MFMAS()
      __syncthreads();
      __builtin_amdgcn_sched_barrier(0);
    }
#undef FRAGS
#undef MFMAS
#undef GLOADS
#undef LSTORES
    {
      float* Cs = (float*)smem;
      const int er = tid >> 4, ec = (tid & 15) * 8;
      const int jm = (m0 < NTOK_P) ? 0 : 1 + ((m0 - NTOK_P) >> 12);
      float4 px[8][2];
      uint4 pz[8][2];
      if (EPI == EPI_RES) {
        const float* xsrc;
        if (l == 0) xsrc = (m0 < NTOK_P) ? p.in[I_XP] : p.in[I_XS] - (size_t)NTOK_P * DM;
        else xsrc = p.out;
#pragma unroll
        for (int ps = 0; ps < 8; ++ps) {
          const float* xp_ = xsrc + (size_t)(m0 + ps * 16 + er) * DM + n0 + ec;
          px[ps][0] = *(const float4*)xp_; px[ps][1] = *(const float4*)(xp_ + 4);
        }
      } else if (EPI == EPI_GLU) {
        const bf16_t* Pz = (const bf16_t*)(p.ws + OFF_P);
        const bf16_t* Z5z = (const bf16_t*)(p.ws + OFF_Z5);
#pragma unroll
        for (int ps = 0; ps < 8; ++ps) {
          const size_t gr = (size_t)(m0 + ps * 16 + er);
          pz[ps][0] = *(const uint4*)(Z5z + gr * 512 + n0 + ec);
          pz[ps][1] = *(const uint4*)(Pz + gr * LDP_E + PE_ZS + n0 + ec);
        }
      }
#pragma unroll
      for (int q = 0; q < 16; ++q) {
        const int rr = wm * 64 + crow(q, h), cc = wn * 64 + r;
        Cs[rr * 132 + cc] = acc00[q];
        Cs[rr * 132 + cc + 32] = acc01[q];
        Cs[(rr + 32) * 132 + cc] = acc10[q];
        Cs[(rr + 32) * 132 + cc + 32] = acc11[q];
      }
      __syncthreads();
#pragma unroll
      for (int ps = 0; ps < 8; ++ps) {
        const int row = ps * 16 + er;
        const float4 c0 = *(const float4*)(Cs + row * 132 + ec);
        const float4 c1 = *(const float4*)(Cs + row * 132 + ec + 4);
        const size_t grow = (size_t)(m0 + row);
        const int gcol = n0 + ec;
        if (EPI == EPI_P) {
          bf16_t* P = (bf16_t*)(p.ws + OFF_P);
          *(uint4*)(P + grow * ldp + gcol) = make_uint4(pack2(c0.x, c0.y), pack2(c0.z, c0.w), pack2(c1.x, c1.y), pack2(c1.z, c1.w));
        } else if (EPI == EPI_RES) {
          const float* gate = MOD + (l * 5 + jm) * 3072 + 2048 + gcol;
          const float4 g0 = *(const float4*)gate, g1 = *(const float4*)(gate + 4);
          const float4 x0 = px[ps][0], x1 = px[ps][1];
          float4 o0, o1;
          o0.x = x0.x + g0.x * c0.x; o0.y = x0.y + g0.y * c0.y; o0.z = x0.z + g0.z * c0.z; o0.w = x0.w + g0.w * c0.w;
          o1.x = x1.x + g1.x * c1.x; o1.y = x1.y + g1.y * c1.y; o1.z = x1.z + g1.z * c1.z; o1.w = x1.w + g1.w * c1.w;
          *(float4*)(p.out + grow * DM + gcol) = o0;
          *(float4*)(p.out + grow * DM + gcol + 4) = o1;
        } else {
          const bf16_t* P = (const bf16_t*)(p.ws + OFF_P);
          const bf16_t* Z5 = (const bf16_t*)(p.ws + OFF_Z5);
          bf16_t* Y = (bf16_t*)(p.ws + OFF_HY);
          const float* bglu = p.in[I_BGLU] + (l >> 1) * 512 + gcol;
          const float4 b0 = *(const float4*)bglu, b1 = *(const float4*)(bglu + 4);
          const uint4 zv = pz[ps][0];
          const uint4 zs = pz[ps][1];
#define GLU1(ZW, SW, CA, CB, BA, BB) pack2(__uint_as_float((ZW) << 16) * sigmf((CA) + (BA)) * siluf(__uint_as_float((SW) << 16)), \
                                           __uint_as_float((ZW) & 0xffff0000u) * sigmf((CB) + (BB)) * siluf(__uint_as_float((SW) & 0xffff0000u)))
          uint4 o;
          o.x = GLU1(zv.x, zs.x, c0.x, c0.y, b0.x, b0.y);
          o.y = GLU1(zv.y, zs.y, c0.z, c0.w, b0.z, b0.w);
          o.z = GLU1(zv.z, zs.z, c1.x, c1.y, b1.x, b1.y);
          o.w = GLU1(zv.w, zs.w, c1.z, c1.w, b1.z, b1.w);
#undef GLU1
          *(uint4*)(Y + grow * DM + 512 + gcol) = o;
        }
      }
      __syncthreads();
    }
  }
}

#define GL 72
struct GlaSmem {
  bf16_t Qd[64 * GL];
  bf16_t Kn[64 * GL];
  bf16_t KdT[64 * GL];
  bf16_t Att[64 * GL];
  bf16_t VT[128 * GL];
  bf16_t ST[128 * GL];
  float lfS[64 * 16];
  float qtot[4 * 64];
  float Dl[64];
  float Gtot[64];
};
#define OLD 132
static_assert(sizeof(GlaSmem) <= SMEM_BYTES, "GLA smem");

template <bool FULL>
DI void gla_sweep(const Params& p, int e, int hd, int dir, int tok0, f32x16 (&sacc)[2], GlaSmem& S) {
  const int tid = otid(), lane = tid & 63, w = tid >> 6;
  const int r = lane & 31, h = lane >> 5;
  const bf16_t* P = (const bf16_t*)(p.ws + OFF_P);
  bf16_t* Y = (bf16_t*)(p.ws + OFF_HY);
  const int tq = tid >> 6;
  if (tid < 64) S.Gtot[tid] = 0.f;
  unsigned w2p[8];
  float bias;
  {
    const int d0 = tid & 63;
#pragma unroll
    for (int i = 0; i < 8; ++i)
      w2p[i] = pack2(p.in[I_GW2][((size_t)(e * 2 + dir) * 16 + 2 * i) * 256 + hd * 64 + d0],
                     p.in[I_GW2][((size_t)(e * 2 + dir) * 16 + 2 * i + 1) * 256 + hd * 64 + d0]);
    bias = p.in[I_GB2][(e * 2 + dir) * 256 + hd * 64 + d0];
  }
  __syncthreads();
  if (FULL) {
#pragma unroll
    for (int ni = 0; ni < 2; ++ni)
#pragma unroll
      for (int q = 0; q < 16; ++q) S.ST[(w * 32 + crow(q, h)) * GL + ni * 32 + r] = f2bf(sacc[ni][q]);
  }
  uint4 pq0, pq1, pk0, pk1;
  bf16_t plf[4];
  pq0 = pq1 = pk0 = pk1 = make_uint4(0, 0, 0, 0);
  plf[0] = plf[1] = plf[2] = plf[3] = 0;
#pragma unroll 1
  for (int cc = 0; cc < 4; ++cc) {
    const int c = dir ? 3 - cc : cc;
    const int ct0 = tok0 + c * 64;
    const int tv = tid & 63, cgp = tid >> 6;
    uint4 v0, v1, v2, v3;
    {
      const bf16_t* vsrc = P + (size_t)(ct0 + tv) * LDP_E + PE_V + hd * 128 + cgp * 32;
      v0 = *(const uint4*)(vsrc); v1 = *(const uint4*)(vsrc + 8); v2 = *(const uint4*)(vsrc + 16); v3 = *(const uint4*)(vsrc + 24);
    }
    {
      const int row = tid >> 2, c8 = (tid & 3) * 16;
      if (cc == 0) {
        const bf16_t* src = P + (size_t)(ct0 + row) * LDP_E + hd * 64 + c8;
        pk0 = *(const uint4*)(src + PE_K); pk1 = *(const uint4*)(src + PE_K + 8);
        if (FULL) { pq0 = *(const uint4*)(src + PE_Q); pq1 = *(const uint4*)(src + PE_Q + 8); }
#pragma unroll
        for (int i = 0; i < 4; ++i) {
          int idx = tid + 256 * i; int t = idx >> 4, rr = idx & 15;
          plf[i] = P[(size_t)(ct0 + t) * LDP_E + PE_LF + dir * 16 + rr];
        }
      }
#pragma unroll
      for (int i = 0; i < 4; ++i) S.lfS[tid + 256 * i] = bf2f(plf[i]);
      *(uint4*)(S.Kn + row * GL + c8) = pk0; *(uint4*)(S.Kn + row * GL + c8 + 8) = pk1;
      if (FULL) { *(uint4*)(S.Qd + row * GL + c8) = pq0; *(uint4*)(S.Qd + row * GL + c8 + 8) = pq1; }
      if (cc < 3) {
        const int cn = dir ? 2 - cc : cc + 1;
        const int cn0 = tok0 + cn * 64;
        const bf16_t* src = P + (size_t)(cn0 + row) * LDP_E + hd * 64 + c8;
        pk0 = *(const uint4*)(src + PE_K); pk1 = *(const uint4*)(src + PE_K + 8);
        if (FULL) { pq0 = *(const uint4*)(src + PE_Q); pq1 = *(const uint4*)(src + PE_Q + 8); }
#pragma unroll
        for (int i = 0; i < 4; ++i) {
          int idx = tid + 256 * i; int t = idx >> 4, rr = idx & 15;
          plf[i] = P[(size_t)(cn0 + t) * LDP_E + PE_LF + dir * 16 + rr];
        }
      }
    }
    __syncthreads();
    const int d = tid & 63;
    float w2r[16];
#pragma unroll
    for (int i = 0; i < 8; ++i) { w2r[2 * i] = __uint_as_float(w2p[i] << 16); w2r[2 * i + 1] = __uint_as_float(w2p[i] & 0xffff0000u); }
    float g[16];
    float run = 0.f;
#pragma unroll
    for (int i = 0; i < 16; ++i) {
      int t = tq * 16 + i;
      float x = bias;
#pragma unroll
      for (int rr = 0; rr < 16; ++rr) x += S.lfS[t * 16 + rr] * w2r[rr];
      float ls = fminf(x, 0.f) - __logf(1.f + __expf(-fabsf(x)));
      g[i] = ls * (1.f / 16.f);
      run += g[i];
    }
    S.qtot[tq * 64 + d] = run;
    __syncthreads();
    float q0 = S.qtot[d], q1 = S.qtot[64 + d], q2 = S.qtot[128 + d], q3 = S.qtot[192 + d];
    const float total = q0 + q1 + q2 + q3;
    float off;
    if (dir == 0) off = (tq > 0 ? q0 : 0.f) + (tq > 1 ? q1 : 0.f) + (tq > 2 ? q2 : 0.f);
    else off = (tq < 1 ? q1 : 0.f) + (tq < 2 ? q2 : 0.f) + (tq < 3 ? q3 : 0.f);
    float b[16];
    if (dir == 0) {
      float a = off;
#pragma unroll
      for (int i = 0; i < 16; ++i) { a += g[i]; b[i] = a; }
    } else {
      float a = off;
#pragma unroll
      for (int i = 15; i >= 0; --i) { a += g[i]; b[i] = a; }
    }
    if (tq == 0) { S.Dl[d] = __expf(total); S.Gtot[d] += total; }
    {
      unsigned kd[8];
      float kprev = 0.f;
#pragma unroll
      for (int i = 0; i < 16; ++i) {
        int t = tq * 16 + i;
        float kv = bf2f(S.Kn[t * GL + d]);
        if (FULL) {
          float qv = bf2f(S.Qd[t * GL + d]);
          S.Qd[t * GL + d] = f2bf(qv * 0.125f * __expf(b[i]));
          S.Kn[t * GL + d] = f2bf(kv * __expf(-b[i]));
        }
        float kdv = kv * __expf(total - b[i]);
        if (i & 1) kd[i >> 1] = pack2(kprev, kdv); else kprev = kdv;
      }
      uint4* dst = (uint4*)(S.KdT + d * GL + tq * 16);
      dst[0] = make_uint4(kd[0], kd[1], kd[2], kd[3]);
      dst[1] = make_uint4(kd[4], kd[5], kd[6], kd[7]);
    }
    {
      bf16_t* vd = S.VT + (cgp * 32) * GL + tv;
#define VTW(VV, B) vd[((B) + 0) * GL] = (bf16_t)(VV.x & 0xffffu); vd[((B) + 1) * GL] = (bf16_t)(VV.x >> 16); \
                   vd[((B) + 2) * GL] = (bf16_t)(VV.y & 0xffffu); vd[((B) + 3) * GL] = (bf16_t)(VV.y >> 16); \
                   vd[((B) + 4) * GL] = (bf16_t)(VV.z & 0xffffu); vd[((B) + 5) * GL] = (bf16_t)(VV.z >> 16); \
                   vd[((B) + 6) * GL] = (bf16_t)(VV.w & 0xffffu); vd[((B) + 7) * GL] = (bf16_t)(VV.w >> 16);
      VTW(v0, 0) VTW(v1, 8) VTW(v2, 16) VTW(v3, 24)
#undef VTW
    }
    __syncthreads();
    const int mi = w >> 1;
    f32x16 oacc[2];
    bf16_t* orec = Y + (size_t)(ct0 + mi * 32 + h * 16 + (r >> 1)) * DM + hd * 128 + (w & 1) * 64 + (r & 1) * 16;
    uint4 of0 = make_uint4(0, 0, 0, 0), of1 = of0, of2 = of0, of3 = of0, zg0 = of0, zg1 = of0, zg2 = of0, zg3 = of0;
    if (FULL && dir) {
      of0 = *(const uint4*)(orec); of1 = *(const uint4*)(orec + 8);
      of2 = *(const uint4*)(orec + 32); of3 = *(const uint4*)(orec + 40);
      const bf16_t* zg = P + (size_t)(ct0 + (tid >> 2)) * LDP_E + PE_ZG + hd * 128 + (tid & 3) * 32;
      zg0 = *(const uint4*)(zg); zg1 = *(const uint4*)(zg + 8); zg2 = *(const uint4*)(zg + 16); zg3 = *(const uint4*)(zg + 24);
    }
    if (FULL) {
      const int ni = w & 1;
      const bool skip = dir ? (ni < mi) : (ni > mi);
      f32x16 a = zero16();
      if (!skip) mma_tile<64>(a, S.Qd + mi * 32 * GL, GL, S.Kn + ni * 32 * GL, GL, lane);
#pragma unroll
      for (int q = 0; q < 16; ++q) {
        int i = mi * 32 + crow(q, h), j = ni * 32 + r;
        bool keep = dir ? (j >= i) : (j <= i);
        S.Att[i * GL + j] = f2bf(keep ? a[q] : 0.f);
      }
#pragma unroll
      for (int jj = 0; jj < 2; ++jj) {
        int nj = (w & 1) * 2 + jj;
        oacc[jj] = zero16();
        mma_tile<64>(oacc[jj], S.Qd + mi * 32 * GL, GL, S.ST + nj * 32 * GL, GL, lane);
      }
      __syncthreads();
#pragma unroll
      for (int jj = 0; jj < 2; ++jj) {
        int nj = (w & 1) * 2 + jj;
        mma_tile<64>(oacc[jj], S.Att + mi * 32 * GL, GL, S.VT + nj * 32 * GL, GL, lane);
      }
    }
#pragma unroll
    for (int ni = 0; ni < 2; ++ni) {
      float dec = S.Dl[ni * 32 + r];
#pragma unroll
      for (int q = 0; q < 16; ++q) sacc[ni][q] *= dec;
      mma_tile<64>(sacc[ni], S.VT + w * 32 * GL, GL, S.KdT + ni * 32 * GL, GL, lane);
    }
    __syncthreads();
    if (FULL) {
#pragma unroll
      for (int ni = 0; ni < 2; ++ni)
#pragma unroll
        for (int q = 0; q < 16; ++q) S.ST[(w * 32 + crow(q, h)) * GL + ni * 32 + r] = f2bf(sacc[ni][q]);
      if (dir == 0) {
#pragma unroll
        for (int jj = 0; jj < 2; ++jj) {
          *(uint4*)(orec + jj * 32) = make_uint4(pack2(oacc[jj][0], oacc[jj][1]), pack2(oacc[jj][2], oacc[jj][3]), pack2(oacc[jj][4], oacc[jj][5]), pack2(oacc[jj][6], oacc[jj][7]));
          *(uint4*)(orec + jj * 32 + 8) = make_uint4(pack2(oacc[jj][8], oacc[jj][9]), pack2(oacc[jj][10], oacc[jj][11]), pack2(oacc[jj][12], oacc[jj][13]), pack2(oacc[jj][14], oacc[jj][15]));
        }
      } else {
        float* Ob = (float*)S.Qd;
        {
          const unsigned ofw[16] = {of0.x, of0.y, of0.z, of0.w, of1.x, of1.y, of1.z, of1.w, of2.x, of2.y, of2.z, of2.w, of3.x, of3.y, of3.z, of3.w};
#pragma unroll
          for (int jj = 0; jj < 2; ++jj) {
            int cl = ((w & 1) * 2 + jj) * 32 + r;
#pragma unroll
            for (int q = 0; q < 16; ++q) {
              int tl = mi * 32 + crow(q, h);
              const unsigned wv = ofw[jj * 8 + (q >> 1)];
              float prev = (q & 1) ? __uint_as_float(wv & 0xffff0000u) : __uint_as_float(wv << 16);
              Ob[tl * OLD + cl] = oacc[jj][q] + prev;
            }
          }
        }
        __syncthreads();
        {
          const int tl = tid >> 2, qtr = tid & 3;
          float ss = 0.f;
#pragma unroll
          for (int i = 0; i < 32; ++i) { float v = Ob[tl * OLD + qtr * 32 + i]; ss += v * v; }
          ss += __shfl_xor(ss, 1);
          ss += __shfl_xor(ss, 2);
          const float rstd = rsqrtf(ss * (1.f / 128.f) + EPSF);
          const float* onw = p.in[I_GON] + e * 128 + qtr * 32;
          bf16_t* yo = Y + (size_t)(ct0 + tl) * DM + hd * 128 + qtr * 32;
          const unsigned zgw[16] = {zg0.x, zg0.y, zg0.z, zg0.w, zg1.x, zg1.y, zg1.z, zg1.w, zg2.x, zg2.y, zg2.z, zg2.w, zg3.x, zg3.y, zg3.z, zg3.w};
#pragma unroll
          for (int i = 0; i < 32; i += 2) {
            unsigned zz = zgw[i >> 1];
            float y0 = Ob[tl * OLD + qtr * 32 + i] * rstd * onw[i] * siluf(__uint_as_float(zz << 16));
            float y1 = Ob[tl * OLD + qtr * 32 + i + 1] * rstd * onw[i + 1] * siluf(__uint_as_float(zz & 0xffff0000u));
            *(unsigned*)(yo + i) = pack2(y0, y1);
          }
        }
        __syncthreads();
      }
    }
  }
}

DI void gla_pass1_unit(const Params& p, int e, int u, char* smem) {
  GlaSmem& S = *(GlaSmem*)smem;
  const int tid = otid(), lane = tid & 63, w = tid >> 6;
  const int r = lane & 31, h = lane >> 5;
  const int seg = u >> 3, hd = (u >> 1) & 3, dir = u & 1;
  const int tok0 = NTOK_P + seg * 256;
  f32x16 sacc[2];
  sacc[0] = zero16(); sacc[1] = zero16();
  __syncthreads();
  gla_sweep<false>(p, e, hd, dir, tok0, sacc, S);
  float* L = (float*)(p.ws + OFF_GLAL) + (size_t)((seg * 4 + hd) * 2 + dir) * 8192;
#pragma unroll
  for (int ni = 0; ni < 2; ++ni)
#pragma unroll
    for (int q = 0; q < 16; ++q) L[(w * 32 + crow(q, h)) * 64 + ni * 32 + r] = sacc[ni][q];
  if (tid < 64) {
    float* D = (float*)(p.ws + OFF_GLAD) + ((seg * 4 + hd) * 2 + dir) * 64;
    D[tid] = expf(S.Gtot[tid]);
  }
  __syncthreads();
}

DI void gla_pass3_unit(const Params& p, int e, int u, char* smem) {
  GlaSmem& S = *(GlaSmem*)smem;
  const int tid = otid(), lane = tid & 63, w = tid >> 6;
  const int r = lane & 31, h = lane >> 5;
  const int seg = ((u >> 2) + 32) % 96, hd = u & 3;
  const int tok0 = seg * 256;
  const bool samp = seg >= 32;
  const int sb = samp ? (seg - 32) >> 4 : 0, sl = samp ? (seg - 32) & 15 : 0;
  const float* Lb = (const float*)(p.ws + OFF_GLAL);
  const float* Db = (const float*)(p.ws + OFF_GLAD);
  for (int dir = 0; dir < 2; ++dir) {
    f32x16 sacc[2];
    sacc[0] = zero16(); sacc[1] = zero16();
    if (samp) {
      const float* s0 = p.in[I_SGLA] + (size_t)(((sb * 2 + e) * 2 + dir) * 4 + hd) * 8192;
#pragma unroll
      for (int ni = 0; ni < 2; ++ni)
#pragma unroll
        for (int q = 0; q < 16; ++q) sacc[ni][q] = s0[(ni * 32 + r) * 128 + w * 32 + crow(q, h)];
      const int nst = dir ? 15 - sl : sl;
      float Lc[32], dc[2];
      {
        const int sp0 = dir ? 15 : 0;
        const int sidx0 = ((sb * 16 + sp0) * 4 + hd) * 2 + dir;
        const float* L0 = Lb + (size_t)sidx0 * 8192;
        const float* D0 = Db + sidx0 * 64;
#pragma unroll
        for (int ni = 0; ni < 2; ++ni) {
          dc[ni] = D0[ni * 32 + r];
#pragma unroll
          for (int q = 0; q < 16; ++q) Lc[ni * 16 + q] = L0[(w * 32 + crow(q, h)) * 64 + ni * 32 + r];
        }
      }
#pragma unroll 1
      for (int k = 0; k < nst; ++k) {
        float Ln[32], dn[2];
        const int kn = (k + 1 < nst) ? k + 1 : k;
        const int sp = dir ? 15 - kn : kn;
        const int sidx = ((sb * 16 + sp) * 4 + hd) * 2 + dir;
        const float* L = Lb + (size_t)sidx * 8192;
        const float* D = Db + sidx * 64;
#pragma unroll
        for (int ni = 0; ni < 2; ++ni) {
          dn[ni] = D[ni * 32 + r];
#pragma unroll
          for (int q = 0; q < 16; ++q) Ln[ni * 16 + q] = L[(w * 32 + crow(q, h)) * 64 + ni * 32 + r];
        }
#pragma unroll
        for (int ni = 0; ni < 2; ++ni)
#pragma unroll
          for (int q = 0; q < 16; ++q) sacc[ni][q] = sacc[ni][q] * dc[ni] + Lc[ni * 16 + q];
#pragma unroll
        for (int i = 0; i < 32; ++i) Lc[i] = Ln[i];
        dc[0] = dn[0]; dc[1] = dn[1];
      }
    }
    __syncthreads();
    gla_sweep<true>(p, e, hd, dir, tok0, sacc, S);
    if (!samp) {
      float* o = p.out + OUT_GLA + (size_t)(((seg * 2 + e) * 2 + dir) * 4 + hd) * 8192;
#pragma unroll
      for (int ni = 0; ni < 2; ++ni)
#pragma unroll
        for (int q = 0; q < 16; ++q) o[(ni * 32 + r) * 128 + w * 32 + crow(q, h)] = sacc[ni][q];
    }
    __syncthreads();
  }
}

#define XLD 136
#define WSYNC() do { __builtin_amdgcn_fence(__ATOMIC_RELEASE, "wavefront"); __builtin_amdgcn_wave_barrier(); __builtin_amdgcn_fence(__ATOMIC_ACQUIRE, "wavefront"); } while (0)
DI void s5_sweep(const Params& p, int e, int g, int dir, int mode, int tok0, float& hr, float& hi, bf16_t* X) {
  const int lane = otid() & 63;
  const int r = lane & 31, h = lane >> 5;
  const bf16_t* P = (const bf16_t*)(p.ws + OFF_P);
  bf16_t* Z5 = (bf16_t*)(p.ws + OFF_Z5);
  bf16_t* Yb = (bf16_t*)(p.ws + OFF_HY);
  const float* LB = (const float*)(p.ws + OFF_LB) + (size_t)(((e * 2 + dir) * 32 + g) * 64 + lane) * 2;
  const float lbr = LB[0], lbi = LB[1];
  const bf16_t* BBT = (const bf16_t*)(p.ws + OFF_BBT) + (size_t)((e * 2 + dir) * 32 + g) * 128 * 16;
  const bf16_t* CM = (const bf16_t*)(p.ws + OFF_CM) + (size_t)(e * 32 + g) * 32 * 128;
  bf16x8 bfr[4];
#pragma unroll
  for (int j = 0; j < 4; ++j) bfr[j] = *(const bf16x8*)(BBT + (32 * j + r) * 16 + 8 * h);
  bf16x8 cfr[8];
#pragma unroll
  for (int s = 0; s < 8; ++s) cfr[s] = *(const bf16x8*)(CM + r * 128 + s * 16 + h * 8);
  bf16x8 dfr;
  {
    const short dv = (r < 16) ? (short)f2bf(p.in[I_S5D][e * 512 + g * 16 + r]) : (short)0;
#pragma unroll
    for (int j = 0; j < 8; ++j) dfr[j] = (8 * h + j == r) ? dv : (short)0;
  }
  const bf16_t* Ub = P + (size_t)(tok0 + r) * LDP_E + PE_U + g * 16 + 8 * h;
  bf16x8 a_cur = *(const bf16x8*)(Ub + (size_t)((dir ? 7 : 0) * 32) * LDP_E);
#pragma unroll 1
  for (int ss = 0; ss < 8; ++ss) {
    const int sc = dir ? 7 - ss : ss;
    const int t0 = tok0 + sc * 32;
    bf16x8 a_nxt = a_cur;
    if (ss < 7) a_nxt = *(const bf16x8*)(Ub + (size_t)((dir ? 6 - ss : ss + 1) * 32) * LDP_E);
    bf16_t* prec = Yb + (size_t)(t0 + 16 * h + (r & 15)) * DM + 512 + g * 16;
    uint4 pp0 = make_uint4(0, 0, 0, 0), pp1 = make_uint4(0, 0, 0, 0);
    if (mode == 2 && r < 16) { pp0 = *(const uint4*)prec; pp1 = *(const uint4*)(prec + 8); }
#pragma unroll
    for (int jp = 0; jp < 2; ++jp) {
      f32x16 are = mfma(a_cur, bfr[2 * jp], zero16());
      f32x16 aim = mfma(a_cur, bfr[2 * jp + 1], zero16());
#pragma unroll
      for (int q = 0; q < 16; ++q) *(unsigned*)(X + crow(q, h) * XLD + 2 * (32 * jp + r)) = pack2(are[q], aim[q]);
    }
    WSYNC();
#define S5STEP(T) { float br = __uint_as_float(wv[T] << 16), bi = __uint_as_float(wv[T] & 0xffff0000u); \
        float nr = lbr * hr - lbi * hi + br; float ni = lbr * hi + lbi * hr + bi; hr = nr; hi = ni; wv[T] = pack2(nr, ni); }
#pragma unroll
    for (int hf = 0; hf < 2; ++hf) {
      bf16_t* Xh = X + ((dir ? 1 - hf : hf) * 16) * XLD + 2 * lane;
      unsigned wv[16];
#pragma unroll
      for (int tt = 0; tt < 16; ++tt) wv[tt] = *(const unsigned*)(Xh + tt * XLD);
      if (dir == 0) {
#pragma unroll
        for (int tt = 0; tt < 16; ++tt) S5STEP(tt)
      } else {
#pragma unroll
        for (int tt = 15; tt >= 0; --tt) S5STEP(tt)
      }
#pragma unroll
      for (int tt = 0; tt < 16; ++tt) *(unsigned*)(Xh + tt * XLD) = wv[tt];
    }
#undef S5STEP
    WSYNC();
    if (mode >= 1) {
      f32x16 acc = zero16();
#pragma unroll
      for (int s = 0; s < 8; ++s) {
        bf16x8 xa = *(const bf16x8*)(X + r * XLD + s * 16 + h * 8);
        acc = mfma(xa, cfr[s], acc);
      }
      if (mode == 2) acc = mfma(a_cur, dfr, acc);
      if (r < 16) {
        if (mode == 1) {
          *(uint4*)prec = make_uint4(pack2(acc[0], acc[1]), pack2(acc[2], acc[3]), pack2(acc[4], acc[5]), pack2(acc[6], acc[7]));
          *(uint4*)(prec + 8) = make_uint4(pack2(acc[8], acc[9]), pack2(acc[10], acc[11]), pack2(acc[12], acc[13]), pack2(acc[14], acc[15]));
        } else {
          const unsigned pw[8] = {pp0.x, pp0.y, pp0.z, pp0.w, pp1.x, pp1.y, pp1.z, pp1.w};
          const int col = g * 16 + r;
#pragma unroll
          for (int q = 0; q < 16; ++q) {
            const float prev = (q & 1) ? __uint_as_float(pw[q >> 1] & 0xffff0000u) : __uint_as_float(pw[q >> 1] << 16);
            const float y = acc[q] + prev;
            const float t3 = 1.5957691216057308f * (y + 0.044715f * y * y * y);
            Z5[(size_t)(t0 + crow(q, h)) * 512 + col] = f2bf(y * sigmf(t3));
          }
        }
      }
    }
    WSYNC();
    a_cur = a_nxt;
  }
}

DI void s5_pass1_unit(const Params& p, int e, int u, char* smem) {
  const int tid = otid(), lane = tid & 63, w = tid >> 6;
  const int seg = u >> 3, g = (u & 7) * 4 + w;
  bf16_t* X = (bf16_t*)smem + w * 32 * XLD;
  float* ES = (float*)(p.ws + OFF_S5ES);
  for (int dir = 0; dir < 2; ++dir) {
    float hr = 0.f, hi = 0.f;
    s5_sweep(p, e, g, dir, 0, NTOK_P + seg * 256, hr, hi, X);
    size_t o = ((size_t)((seg * 32 + g) * 2 + dir) * 64 + lane) * 2;
    ES[o] = hr; ES[o + 1] = hi;
  }
}

DI void s5_pass3_unit(const Params& p, int e, int u, char* smem) {
  const int tid = otid(), lane = tid & 63, w = tid >> 6;
  const int seg = u >> 3, g = (u & 7) * 4 + w;
  bf16_t* X = (bf16_t*)smem + w * 32 * XLD;
  const bool samp = seg >= 32;
  const int sb = samp ? (seg - 32) >> 4 : 0, sl = samp ? (seg - 32) & 15 : 0;
  const float* ES = (const float*)(p.ws + OFF_S5ES);
  for (int dir = 0; dir < 2; ++dir) {
    float hr = 0.f, hi = 0.f;
    if (samp) {
      const size_t si = (size_t)(((sb * 2 + e) * 2 + dir) * 32 + g) * 64 + lane;
      hr = p.in[I_S5R][si]; hi = p.in[I_S5I][si];
      const float* L2 = (const float*)(p.ws + OFF_LB256) + (size_t)(((e * 2 + dir) * 32 + g) * 64 + lane) * 2;
      const float ar = L2[0], ai = L2[1];
      const int nst = dir ? 15 - sl : sl;
      float er[15], ei[15];
#pragma unroll
      for (int k = 0; k < 15; ++k) {
        const int kk = k < nst ? k : 0;
        const int sp = dir ? 15 - kk : kk;
        size_t o = ((size_t)(((sb * 16 + sp) * 32 + g) * 2 + dir) * 64 + lane) * 2;
        float2 ev = *(const float2*)(ES + o);
        er[k] = ev.x; ei[k] = ev.y;
      }
#pragma unroll
      for (int k = 0; k < 15; ++k) {
        if (k < nst) {
          float nr = ar * hr - ai * hi + er[k];
          float ni = ar * hi + ai * hr + ei[k];
          hr = nr; hi = ni;
        }
      }
    }
    s5_sweep(p, e, g, dir, dir + 1, seg * 256, hr, hi, X);
    if (!samp) {
      const size_t so = (size_t)(((seg * 2 + e) * 2 + dir) * 32 + g) * 64 + lane;
      p.out[OUT_S5R + so] = hr;
      p.out[OUT_S5I + so] = hi;
    }
  }
}

#define AL 72
template <int W>
DI void qk_prep(const bf16_t* src, const float* nw, bool rope, int pos, float mult, int sub, const float* RT,
                bf16_t* dst, float* fdst) {
  float x[4][W];
#pragma unroll
  for (int c = 0; c < 4; ++c) {
    if (W == 4) {
      uint2 v = *(const uint2*)(src + 16 * c + 4 * sub);
      x[c][0] = __uint_as_float(v.x << 16); x[c][1] = __uint_as_float(v.x & 0xffff0000u);
      x[c][2] = __uint_as_float(v.y << 16); x[c][3] = __uint_as_float(v.y & 0xffff0000u);
    } else {
      uint4 v = *(const uint4*)(src + 16 * c + 8 * sub);
      x[c][0] = __uint_as_float(v.x << 16); x[c][1] = __uint_as_float(v.x & 0xffff0000u);
      x[c][2] = __uint_as_float(v.y << 16); x[c][3] = __uint_as_float(v.y & 0xffff0000u);
      x[c][4 % W] = __uint_as_float(v.z << 16); x[c][5 % W] = __uint_as_float(v.z & 0xffff0000u);
      x[c][6 % W] = __uint_as_float(v.w << 16); x[c][7 % W] = __uint_as_float(v.w & 0xffff0000u);
    }
  }
  float ss = 0.f;
#pragma unroll
  for (int c = 0; c < 4; ++c)
#pragma unroll
    for (int i = 0; i < W; ++i) ss += x[c][i] * x[c][i];
  ss += __shfl_xor(ss, 1);
  if (W == 4) ss += __shfl_xor(ss, 2);
  const float rstd = rsqrtf(ss * (1.f / 64.f) + EPSF);
#pragma unroll
  for (int c = 0; c < 4; ++c)
#pragma unroll
    for (int i = 0; i < W; ++i) x[c][i] *= rstd * nw[16 * c + W * sub + i];
  if (rope) {
    const int row = pos >> 6, col = pos & 63;
#pragma unroll
    for (int i = 0; i < W; ++i) {
      const int f = W * sub + i;
      float cs = RT[(row * 16 + f) * 2], sn = RT[(row * 16 + f) * 2 + 1];
      float x1 = x[0][i], x2 = x[1][i];
      x[0][i] = x1 * cs - x2 * sn; x[1][i] = x2 * cs + x1 * sn;
      cs = RT[(col * 16 + f) * 2]; sn = RT[(col * 16 + f) * 2 + 1];
      x1 = x[2][i]; x2 = x[3][i];
      x[2][i] = x1 * cs - x2 * sn; x[3][i] = x2 * cs + x1 * sn;
    }
  }
#pragma unroll
  for (int c = 0; c < 4; ++c)
#pragma unroll
    for (int i = 0; i < W; ++i) {
      dst[16 * c + W * sub + i] = f2bf(x[c][i] * mult);
      if (fdst) fdst[16 * c + W * sub + i] = x[c][i];
    }
}

DI void attn_unit(const Params& p, int e, int u, char* smem) {
  const int tid = otid(), lane = tid & 63, w = tid >> 6;
  const int r = lane & 31, h = lane >> 5;
  bf16_t* Ks = (bf16_t*)smem;
  bf16_t* Vt = Ks + 64 * AL;
  bf16_t* Qs = Vt + 64 * AL;
  const bf16_t* P = (const bf16_t*)(p.ws + OFF_P);
  bf16_t* Y = (bf16_t*)(p.ws + OFF_HY);
  const float* RT = (const float*)(p.ws + OFF_ROPE);
  const bool lat = u >= 512;
  int b, kvh, qb;
  if (!lat) { b = u >> 4; kvh = (u >> 3) & 1; qb = u & 7; }
  else { int v = u - 512; b = v >> 8; kvh = (v >> 7) & 1; qb = v & 127; }
  const int tokbase = lat ? NTOK_P + b * 4096 : b * 256;
  const int q0 = qb * 32;
  const int hq = kvh * 4 + w;
  __syncthreads();
  const int kbase = lat ? (((q0 - 128) >> 6) << 6) : 0;
  const int ntile = lat ? 9 : 4;
  bf16_t* Ks1 = Qs + 4 * 32 * AL;
  bf16_t* Vt1 = Ks1 + 64 * AL;
  const int keyk = tid >> 2, s4 = tid & 3;
  const int keyv = tid & 63, cq = tid >> 6;
  const bool wr = (!lat) && (qb == 0);
  float knw[16];
#pragma unroll
  for (int c = 0; c < 4; ++c)
#pragma unroll
    for (int i = 0; i < 4; ++i) knw[c * 4 + i] = p.in[I_KNW][e * 64 + 16 * c + 4 * s4 + i];
  float ccs[4], csn[4];
#pragma unroll
  for (int i = 0; i < 4; ++i) { ccs[i] = RT[(keyk * 16 + 4 * s4 + i) * 2]; csn[i] = RT[(keyk * 16 + 4 * s4 + i) * 2 + 1]; }
  uint4 rk0, rk1, rk2, rk3, rv0, rv1, rv2, rv3;
  float rrc[4] = {1.f, 1.f, 1.f, 1.f}, rrs[4] = {0.f, 0.f, 0.f, 0.f};
  rk0 = rk1 = rk2 = rk3 = rv0 = rv1 = rv2 = rv3 = make_uint4(0, 0, 0, 0);
  int tlo = 0, thi = ntile - 1;
  if (lat) {
    tlo = kbase < 0 ? (-kbase) >> 6 : 0;
    thi = 4;
    while (kbase + thi * 64 >= 4096) --thi;
  }
#define TILE_NEXT(ti) (lat ? ((ti) < thi ? (ti) + 1 : ((ti) < 5 ? 5 : (ti) + 1)) : (ti) + 1)
#define TILE_LOAD(ti) { \
    const bool fc_ = lat && (ti) >= 5; \
    const int kt0_ = fc_ ? ((ti) - 5) * 64 : kbase + (ti) * 64; \
    if (fc_) { \
      const float* ck = p.in[I_CK] + ((size_t)((b * 2 + e) * 2 + kvh) * 256 + kt0_ + keyk) * 64 + 4 * s4; \
      const float* cv = p.in[I_CV] + ((size_t)((b * 2 + e) * 2 + kvh) * 256 + kt0_ + keyv) * 64 + cq * 16; \
      rk0 = *(const uint4*)(ck); rk1 = *(const uint4*)(ck + 16); rk2 = *(const uint4*)(ck + 32); rk3 = *(const uint4*)(ck + 48); \
      rv0 = *(const uint4*)(cv); rv1 = *(const uint4*)(cv + 4); rv2 = *(const uint4*)(cv + 8); rv3 = *(const uint4*)(cv + 12); \
    } else { \
      const bf16_t* ksrc = P + (size_t)(tokbase + kt0_ + keyk) * LDP_O + PO_K + kvh * 64 + 4 * s4; \
      const bf16_t* vsrc = P + (size_t)(tokbase + kt0_ + keyv) * LDP_O + PO_V + kvh * 64 + cq * 16; \
      uint2 t0_ = *(const uint2*)(ksrc), t1_ = *(const uint2*)(ksrc + 16), t2_ = *(const uint2*)(ksrc + 32), t3_ = *(const uint2*)(ksrc + 48); \
      rk0.x = t0_.x; rk0.y = t0_.y; rk1.x = t1_.x; rk1.y = t1_.y; rk2.x = t2_.x; rk2.y = t2_.y; rk3.x = t3_.x; rk3.y = t3_.y; \
      rv0 = *(const uint4*)(vsrc); rv1 = *(const uint4*)(vsrc + 8); \
      if (lat) { \
        const int row_ = kt0_ >> 6; \
        _Pragma("unroll") for (int i = 0; i < 4; ++i) { rrc[i] = RT[(row_ * 16 + 4 * s4 + i) * 2]; rrs[i] = RT[(row_ * 16 + 4 * s4 + i) * 2 + 1]; } \
      } \
    } }
#define VT4(VD, W0, W1) { (VD)[0] = (bf16_t)((W0) & 0xffffu); (VD)[AL] = (bf16_t)((W0) >> 16); (VD)[2 * AL] = (bf16_t)((W1) & 0xffffu); (VD)[3 * AL] = (bf16_t)((W1) >> 16); }
#define TILE_STORE(ti, KB, VB) { \
    const bool fc_ = lat && (ti) >= 5; \
    const int kt0_ = fc_ ? ((ti) - 5) * 64 : kbase + (ti) * 64; \
    if (fc_) { \
      bf16_t* kd = (KB) + keyk * AL + 4 * s4; \
      *(uint2*)(kd) = make_uint2(pack2(__uint_as_float(rk0.x), __uint_as_float(rk0.y)), pack2(__uint_as_float(rk0.z), __uint_as_float(rk0.w))); \
      *(uint2*)(kd + 16) = make_uint2(pack2(__uint_as_float(rk1.x), __uint_as_float(rk1.y)), pack2(__uint_as_float(rk1.z), __uint_as_float(rk1.w))); \
      *(uint2*)(kd + 32) = make_uint2(pack2(__uint_as_float(rk2.x), __uint_as_float(rk2.y)), pack2(__uint_as_float(rk2.z), __uint_as_float(rk2.w))); \
      *(uint2*)(kd + 48) = make_uint2(pack2(__uint_as_float(rk3.x), __uint_as_float(rk3.y)), pack2(__uint_as_float(rk3.z), __uint_as_float(rk3.w))); \
      bf16_t* vd = (VB) + (cq * 16) * AL + keyv; \
      VT4(vd, pack2(__uint_as_float(rv0.x), __uint_as_float(rv0.y)), pack2(__uint_as_float(rv0.z), __uint_as_float(rv0.w))) \
      VT4(vd + 4 * AL, pack2(__uint_as_float(rv1.x), __uint_as_float(rv1.y)), pack2(__uint_as_float(rv1.z), __uint_as_float(rv1.w))) \
      VT4(vd + 8 * AL, pack2(__uint_as_float(rv2.x), __uint_as_float(rv2.y)), pack2(__uint_as_float(rv2.z), __uint_as_float(rv2.w))) \
      VT4(vd + 12 * AL, pack2(__uint_as_float(rv3.x), __uint_as_float(rv3.y)), pack2(__uint_as_float(rv3.z), __uint_as_float(rv3.w))) \
    } else { \
      float x[4][4]; \
      const unsigned kw[8] = {rk0.x, rk0.y, rk1.x, rk1.y, rk2.x, rk2.y, rk3.x, rk3.y}; \
      _Pragma("unroll") for (int c = 0; c < 4; ++c) { \
        x[c][0] = __uint_as_float(kw[2 * c] << 16); x[c][1] = __uint_as_float(kw[2 * c] & 0xffff0000u); \
        x[c][2] = __uint_as_float(kw[2 * c + 1] << 16); x[c][3] = __uint_as_float(kw[2 * c + 1] & 0xffff0000u); } \
      float ss = 0.f; \
      _Pragma("unroll") for (int c = 0; c < 4; ++c) _Pragma("unroll") for (int i = 0; i < 4; ++i) ss += x[c][i] * x[c][i]; \
      ss += __shfl_xor(ss, 1); ss += __shfl_xor(ss, 2); \
      const float rstd = rsqrtf(ss * (1.f / 64.f) + EPSF); \
      _Pragma("unroll") for (int c = 0; c < 4; ++c) _Pragma("unroll") for (int i = 0; i < 4; ++i) x[c][i] *= rstd * knw[c * 4 + i]; \
      if (lat) { \
        _Pragma("unroll") for (int i = 0; i < 4; ++i) { \
          float x1 = x[0][i], x2 = x[1][i]; x[0][i] = x1 * rrc[i] - x2 * rrs[i]; x[1][i] = x2 * rrc[i] + x1 * rrs[i]; \
          x1 = x[2][i]; x2 = x[3][i]; x[2][i] = x1 * ccs[i] - x2 * csn[i]; x[3][i] = x2 * ccs[i] + x1 * csn[i]; } \
      } \
      bf16_t* kd = (KB) + keyk * AL + 4 * s4; \
      _Pragma("unroll") for (int c = 0; c < 4; ++c) *(uint2*)(kd + 16 * c) = make_uint2(pack2(x[c][0], x[c][1]), pack2(x[c][2], x[c][3])); \
      if (wr) { \
        float* fd = p.out + OUT_CK + ((size_t)((b * 2 + e) * 2 + kvh) * 256 + kt0_ + keyk) * 64 + 4 * s4; \
        _Pragma("unroll") for (int c = 0; c < 4; ++c) *(float4*)(fd + 16 * c) = make_float4(x[c][0], x[c][1], x[c][2], x[c][3]); \
        float* fv = p.out + OUT_CV + ((size_t)((b * 2 + e) * 2 + kvh) * 256 + kt0_ + keyv) * 64 + cq * 16; \
        *(float4*)(fv) = make_float4(__uint_as_float(rv0.x << 16), __uint_as_float(rv0.x & 0xffff0000u), __uint_as_float(rv0.y << 16), __uint_as_float(rv0.y & 0xffff0000u)); \
        *(float4*)(fv + 4) = make_float4(__uint_as_float(rv0.z << 16), __uint_as_float(rv0.z & 0xffff0000u), __uint_as_float(rv0.w << 16), __uint_as_float(rv0.w & 0xffff0000u)); \
        *(float4*)(fv + 8) = make_float4(__uint_as_float(rv1.x << 16), __uint_as_float(rv1.x & 0xffff0000u), __uint_as_float(rv1.y << 16), __uint_as_float(rv1.y & 0xffff0000u)); \
        *(float4*)(fv + 12) = make_float4(__uint_as_float(rv1.z << 16), __uint_as_float(rv1.z & 0xffff0000u), __uint_as_float(rv1.w << 16), __uint_as_float(rv1.w & 0xffff0000u)); \
      } \
      bf16_t* vd = (VB) + (cq * 16) * AL + keyv; \
      VT4(vd, rv0.x, rv0.y) VT4(vd + 4 * AL, rv0.z, rv0.w) VT4(vd + 8 * AL, rv1.x, rv1.y) VT4(vd + 12 * AL, rv1.z, rv1.w) \
    } }
  int cur = 0;
  TILE_LOAD(tlo)
  uint2 zq[2][4];
#pragma unroll
  for (int dvt = 0; dvt < 2; ++dvt)
#pragma unroll
    for (int g4 = 0; g4 < 4; ++g4)
      zq[dvt][g4] = *(const uint2*)(P + (size_t)(tokbase + q0 + r) * LDP_O + PO_ZA + hq * 64 + dvt * 32 + 8 * g4 + 4 * h);
  {
    const int qi = lane >> 1, sub = lane & 1;
    const bf16_t* src = P + (size_t)(tokbase + q0 + qi) * LDP_O + PO_Q + hq * 64;
    qk_prep<8>(src, p.in[I_QNW] + e * 64, lat, q0 + qi, 0.125f, sub, RT, Qs + (w * 32 + qi) * AL, nullptr);
  }
  __syncthreads();
  bf16x8 qf[4];
#pragma unroll
  for (int ks = 0; ks < 4; ++ks) qf[ks] = *(const bf16x8*)(Qs + (w * 32 + r) * AL + ks * 16 + h * 8);
  float m_run = p.in[I_SINK][e * 8 + hq];
  float l_run = 1.f;
  f32x16 o[2];
  o[0] = zero16(); o[1] = zero16();
  TILE_STORE(tlo, Ks, Vt)
  __syncthreads();
  for (int ti = tlo; ti < ntile;) {
    const bool fromcache = lat && ti >= 5;
    const int kt0 = fromcache ? (ti - 5) * 64 : kbase + ti * 64;
    const int tn = TILE_NEXT(ti);
    if (tn < ntile) { TILE_LOAD(tn) }
    const bf16_t* Kc = cur ? Ks1 : Ks;
    const bf16_t* Vc = cur ? Vt1 : Vt;
    f32x16 s[2];
#pragma unroll
    for (int mt = 0; mt < 2; ++mt) {
      s[mt] = zero16();
#pragma unroll
      for (int ks = 0; ks < 4; ++ks) {
        bf16x8 a = *(const bf16x8*)(Kc + (mt * 32 + r) * AL + ks * 16 + h * 8);
        s[mt] = mfma(a, qf[ks], s[mt]);
      }
    }
    if (lat && !fromcache) {
      const int qpos = q0 + r;
#pragma unroll
      for (int mt = 0; mt < 2; ++mt)
#pragma unroll
        for (int q = 0; q < 16; ++q) {
          int kpos = kt0 + mt * 32 + crow(q, h);
          int dd = kpos - qpos;
          if (dd > 128 || dd < -128) s[mt][q] = -1e30f;
        }
    }
    float mx = -3e38f;
#pragma unroll
    for (int mt = 0; mt < 2; ++mt)
#pragma unroll
      for (int q = 0; q < 16; ++q) mx = fmaxf(mx, s[mt][q]);
    mx = fmaxf(mx, __shfl_xor(mx, 32));
    const float m_new = fmaxf(m_run, mx);
    const float alpha = __expf(m_run - m_new);
    float rs = 0.f;
#pragma unroll
    for (int mt = 0; mt < 2; ++mt)
#pragma unroll
      for (int q = 0; q < 16; ++q) { float pv = __expf(s[mt][q] - m_new); s[mt][q] = pv; rs += pv; }
    rs += __shfl_xor(rs, 32);
    l_run = l_run * alpha + rs;
    m_run = m_new;
#pragma unroll
    for (int q = 0; q < 16; ++q) { o[0][q] *= alpha; o[1][q] *= alpha; }
#pragma unroll
    for (int mt = 0; mt < 2; ++mt)
#pragma unroll
      for (int sx = 0; sx < 2; ++sx) {
        bf16x8 pf;
#pragma unroll
        for (int j = 0; j < 8; ++j) pf[j] = (short)f2bf(s[mt][8 * sx + j]);
#pragma unroll
        for (int dvt = 0; dvt < 2; ++dvt) {
          const bf16_t* vp = Vc + (dvt * 32 + r) * AL + mt * 32 + 16 * sx + 4 * h;
          s16x4 lo = *(const s16x4*)vp;
          s16x4 hi4 = *(const s16x4*)(vp + 8);
          bf16x8 a = __builtin_shufflevector(lo, hi4, 0, 1, 2, 3, 4, 5, 6, 7);
          o[dvt] = mfma(a, pf, o[dvt]);
        }
      }
      if (tn < ntile) {
      if (cur) { TILE_STORE(tn, Ks, Vt) } else { TILE_STORE(tn, Ks1, Vt1) }
    }
    __syncthreads();
    ti = tn;
    cur ^= 1;
  }
#undef TILE_NEXT
#undef TILE_LOAD
#undef TILE_STORE
#undef VT4
  const float inv = 1.f / l_run;
  const int tok = tokbase + q0 + r;
#pragma unroll
  for (int dvt = 0; dvt < 2; ++dvt)
#pragma unroll
    for (int g4 = 0; g4 < 4; ++g4) {
      const int dv = dvt * 32 + 8 * g4 + 4 * h;
      uint2 zz = zq[dvt][g4];
      float z0 = __uint_as_float(zz.x << 16), z1 = __uint_as_float(zz.x & 0xffff0000u);
      float z2 = __uint_as_float(zz.y << 16), z3 = __uint_as_float(zz.y & 0xffff0000u);
      float y0 = o[dvt][4 * g4 + 0] * inv * siluf(z0);
      float y1 = o[dvt][4 * g4 + 1] * inv * siluf(z1);
      float y2 = o[dvt][4 * g4 + 2] * inv * siluf(z2);
      float y3 = o[dvt][4 * g4 + 3] * inv * siluf(z3);
      *(uint2*)(Y + (size_t)tok * DM + hq * 64 + dv) = make_uint2(pack2(y0, y1), pack2(y2, y3));
    }
}

DI void conv_unit(const Params& p, int e, int u) {
  const int tid = otid();
  const bf16_t* P = (const bf16_t*)(p.ws + OFF_P);
  bf16_t* Y = (bf16_t*)(p.ws + OFF_HY);
  const int t0 = u * 16;
  const int c = tid * 2;
  int seg0, seg1;
  if (t0 < NTOK_P) { seg0 = t0 & ~255; seg1 = seg0 + 256; }
  else { seg0 = NTOK_P + ((t0 - NTOK_P) & ~4095); seg1 = seg0 + 4096; }
  const float* cw = p.in[I_CONVW] + (size_t)e * 3 * 512;
  const float w00 = cw[c], w01 = cw[c + 1], w10 = cw[512 + c], w11 = cw[512 + c + 1], w20 = cw[1024 + c], w21 = cw[1024 + c + 1];
  const float b0 = p.in[I_CONVB][e * 512 + c], b1 = p.in[I_CONVB][e * 512 + c + 1];
  auto prod = [&](int t, float& a, float& b) {
    if (t < seg0 || t >= seg1) { a = 0.f; b = 0.f; return; }
    unsigned xc = *(const unsigned*)(P + (size_t)t * LDP_O + PO_XC + c);
    unsigned cg_ = *(const unsigned*)(P + (size_t)t * LDP_O + PO_CG + c);
    a = __uint_as_float(xc << 16) * __uint_as_float(cg_ << 16);
    b = __uint_as_float(xc & 0xffff0000u) * __uint_as_float(cg_ & 0xffff0000u);
  };
  float pa0, pa1, pb0, pb1, pc0, pc1;
  prod(t0 - 1, pa0, pa1);
  prod(t0, pb0, pb1);
#pragma unroll
  for (int i = 0; i < 16; ++i) {
    const int t = t0 + i;
    prod(t + 1, pc0, pc1);
    unsigned bg = *(const unsigned*)(P + (size_t)t * LDP_O + PO_BG + c);
    unsigned zc = *(const unsigned*)(P + (size_t)t * LDP_O + PO_ZC + c);
    float y0 = __uint_as_float(bg << 16) * (w00 * pa0 + w10 * pb0 + w20 * pc0 + b0) * siluf(__uint_as_float(zc << 16));
    float y1 = __uint_as_float(bg & 0xffff0000u) * (w01 * pa1 + w11 * pb1 + w21 * pc1 + b1) * siluf(__uint_as_float(zc & 0xffff0000u));
    *(unsigned*)(Y + (size_t)t * DM + 512 + c) = pack2(y0, y1);
    pa0 = pb0; pa1 = pb1; pb0 = pc0; pb1 = pc1;
  }
}


#define QCTR(l, ph) ((unsigned*)(p.ws + OFF_BAR) + 3584 + 16 * ((l) * 4 + (ph)))
DI int next_unit(unsigned* ctr, volatile int* sh) {
  __syncthreads();
  if (threadIdx.x == 0) *sh = (int)atomicAdd(ctr, 1u);
  __syncthreads();
  return *sh;
}
#ifndef REP_A
#define REP_A 1
#endif
#ifndef REP_INPROJ
#define REP_INPROJ 1
#endif
#ifndef REP_EVEN
#define REP_EVEN 1
#endif
#ifndef REP_ODD
#define REP_ODD 1
#endif
#define REP_G1 1
#define REP_S1 1
#define REP_G3 1
#define REP_S3 1
#ifndef REP_SYNC
#define REP_SYNC 1
#endif
#define GSYNC() do { _Pragma("unroll 1") for (int rs_ = 0; rs_ < REP_SYNC; ++rs_) xcd_barrier(xb); } while (0)
__global__ void __launch_bounds__(256, 2) fwd_megakernel(Params p) {
  cg::grid_group grid = cg::this_grid();
  __shared__ __attribute__((aligned(16))) char smem[SMEM_BYTES];
  __shared__ uint4 xb_words;
  __shared__ int qsh;
  if (threadIdx.x == 0) xb_words = make_uint4(0u, 0u, 0u, 0u);
  __syncthreads();
  XcdBarrier xb = xcd_barrier_post((unsigned*)(p.ws + OFF_BAR), (volatile LAS unsigned*)&xb_words);
  if (p.ws == nullptr) grid.sync();
  phase0(p, smem);
  GSYNC();
#pragma unroll 1
  for (int l = 0; l < 4; ++l) {
    const int e = l >> 1;
#pragma unroll 1
    for (int rep = 0; rep < REP_A; ++rep) {
      phaseA(p, l);
      GSYNC();
    }
    const int odd = l & 1;
#pragma unroll 1
    for (int rep = 0; rep < REP_INPROJ; ++rep) {
      gemm_phase<EPI_P, 16>(p, l, (const bf16_t*)(p.ws + OFF_HY), DM, (const bf16_t*)(p.ws + OFF_WIN), DM, odd ? LDP_O / 128 : LDP_E / 128, odd ? LDP_O : LDP_E, smem);
      GSYNC();
    }
    if (!odd) {
#pragma unroll 1
      for (int rep = 0; rep < REP_EVEN; ++rep) {
        if (blockIdx.x >= (gridDim.x >> 1)) { __builtin_amdgcn_s_sleep(127); }
        for (int u = next_unit(QCTR(l, 0), &qsh); u < 512 + 512; u = next_unit(QCTR(l, 0), &qsh)) {
          if (u < 512) { _Pragma("unroll 1") for (int r2 = 0; r2 < REP_G1; ++r2) gla_pass1_unit(p, e, u, smem); }
          else { _Pragma("unroll 1") for (int r2 = 0; r2 < REP_S1; ++r2) s5_pass1_unit(p, e, u - 512, smem); }
        }
        GSYNC();
        if (blockIdx.x >= (gridDim.x >> 1)) { __builtin_amdgcn_s_sleep(127); }
        for (int u = next_unit(QCTR(l, 1), &qsh); u < 384 + 768; u = next_unit(QCTR(l, 1), &qsh)) {
          if (u < 384) { _Pragma("unroll 1") for (int r2 = 0; r2 < REP_G3; ++r2) gla_pass3_unit(p, e, u, smem); }
          else { _Pragma("unroll 1") for (int r2 = 0; r2 < REP_S3; ++r2) s5_pass3_unit(p, e, u - 384, smem); }
        }
        GSYNC();
        gemm_phase<EPI_GLU, 8>(p, l, (const bf16_t*)(p.ws + OFF_Z5), 512, (const bf16_t*)(p.ws + OFF_WGLU), 512, 4, 0, smem);
        GSYNC();
      }
    } else {
#pragma unroll 1
      for (int rep = 0; rep < REP_ODD; ++rep) {
        if (blockIdx.x >= (gridDim.x >> 1)) { __builtin_amdgcn_s_sleep(127); }
        for (int u = next_unit(QCTR(l, 2), &qsh); u < 1536 + 1536; u = next_unit(QCTR(l, 2), &qsh)) {
          if (u < 1024) attn_unit(p, e, u + 512, smem);
          else if (u < 1536) attn_unit(p, e, u - 1024, smem);
          else conv_unit(p, e, u - 1536);
        }
        GSYNC();
      }
    }
    gemm_phase<EPI_RES, 16>(p, l, (const bf16_t*)(p.ws + OFF_HY), DM, (const bf16_t*)(p.ws + OFF_WOUT), DM, 8, 0, smem);
    if (l < 3) GSYNC();
  }
}

extern "C" void kernel_launch(void* const* d_in, const int* in_sizes, int n_in, void* d_out, int out_size,
                              void* d_ws, size_t ws_size, hipStream_t stream) {
  static int grid_blocks = 0;
  if (!grid_blocks) {
    int dev = 0, cus = 0, per_cu = 0;
    hipGetDevice(&dev);
    hipDeviceGetAttribute(&cus, hipDeviceAttributeMultiprocessorCount, dev);
    hipOccupancyMaxActiveBlocksPerMultiprocessor(&per_cu, fwd_megakernel, 256, 0);
    if (per_cu > 2) per_cu = 2;
    if (per_cu < 1) per_cu = 1;
    grid_blocks = cus * per_cu;
  }
  if (ws_size < WS_NEED || n_in < 34) { fprintf(stderr, "workspace too small\n"); return; }
  Params p{};
  for (int i = 0; i < 34; ++i) p.in[i] = (const float*)d_in[i];
  p.out = (float*)d_out;
  p.ws = (char*)d_ws;
  (void)hipMemsetAsync((char*)d_ws + OFF_BAR, 0, 16384, stream);
  void* args[] = {&p};
  hipError_t err = hipLaunchCooperativeKernel((void*)fwd_megakernel, dim3(grid_blocks), dim3(256), args, 0, stream);
  if (err != hipSuccess) fprintf(stderr, "cooperative launch failed: %s (grid %d)\n", hipGetErrorString(err), grid_blocks);
}
```

```cpp
#include <hip/hip_runtime.h>
#include <hip/hip_cooperative_groups.h>
#include <cstdio>
namespace cg = cooperative_groups;

typedef unsigned short bf16_t;
using bf16x8 = __attribute__((ext_vector_type(8))) short;
using s16x4  = __attribute__((ext_vector_type(4))) short;
using f32x16 = __attribute__((ext_vector_type(16))) float;
#define DI __device__ __forceinline__

#define NTOK    24576
#define NTOK_P  8192
#define DM      1024
#define LDP_E   2688
#define LDP_O   3328
#define EPSF    1e-6f

#define PE_Q   0
#define PE_K   256
#define PE_V   512
#define PE_ZG  1024
#define PE_U   1536
#define PE_ZS  2048
#define PE_LF  2560
#define PO_Q   0
#define PO_K   512
#define PO_V   640
#define PO_ZA  768
#define PO_XC  1280
#define PO_BG  1792
#define PO_CG  2304
#define PO_ZC  2816

#define OUT_GLA  25165824
#define OUT_S5R  29360128
#define OUT_S5I  29622272
#define OUT_CK   29884416
#define OUT_CV   31981568

#define OFF_WIN   0ull
#define OFF_WOUT  6815744ull
#define OFF_WGLU  8912896ull
#define OFF_MOD   9437184ull
#define OFF_LB    9682944ull
#define OFF_LB256 (OFF_LB + 65536ull)
#define OFF_BBT   (OFF_LB256 + 65536ull)
#define OFF_CM    (OFF_BBT + 524288ull)
#define OFF_ROPE  (OFF_CM + 524288ull)
#define OFF_S5ES  (OFF_ROPE + 8192ull)
#define OFF_GLAL  (OFF_S5ES + 2097152ull)
#define OFF_GLAD  (OFF_GLAL + 16777216ull)
#define OFF_HY    (OFF_GLAD + 131072ull)
#define OFF_P     (OFF_HY + 50331648ull)
#define OFF_Z5    (OFF_P + 132120576ull)
#define OFF_BAR   (OFF_P + 163577856ull)
#define WS_NEED   (OFF_BAR + 16384ull)

#define SMEM_BYTES 80896

struct Params {
  const float* in[34];
  float* out;
  char* ws;
};

enum { I_XP = 0, I_XS, I_C, I_SGLA, I_S5R, I_S5I, I_CK, I_CV, I_CCTX, I_NORMW, I_WADA, I_BADA, I_WINE, I_WOUTE,
       I_GW2, I_GB2, I_GON, I_LAMR, I_LAMI, I_LOGDT, I_BRE, I_BIM, I_CRE, I_CIM, I_S5D, I_WGLU, I_BGLU,
       I_WINO, I_WOUTO, I_QNW, I_KNW, I_SINK, I_CONVW, I_CONVB };

DI int otid() { int t = threadIdx.x; asm volatile("" : "+v"(t)); return t; }
typedef __bf16 hbf16x2 __attribute__((ext_vector_type(2)));
typedef float hf32x2 __attribute__((ext_vector_type(2)));
DI unsigned pack2(float a, float b) { hf32x2 v = {a, b}; return __builtin_bit_cast(unsigned, __builtin_convertvector(v, hbf16x2)); }
DI bf16_t f2bf(float x) { return (bf16_t)(pack2(x, x) & 0xffffu); }
DI float bf2f(bf16_t b) { return __uint_as_float(((unsigned)b) << 16); }
DI float siluf(float x) { return x * __builtin_amdgcn_rcpf(1.f + __expf(-x)); }
DI float sigmf(float x) { return __builtin_amdgcn_rcpf(1.f + __expf(-x)); }
DI int crow(int q, int h) { return (q & 3) + 8 * (q >> 2) + 4 * h; }
DI f32x16 mfma(bf16x8 a, bf16x8 b, f32x16 c) { return __builtin_amdgcn_mfma_f32_32x32x16_bf16(a, b, c, 0, 0, 0); }
DI f32x16 zero16() { f32x16 z; for (int i = 0; i < 16; ++i) z[i] = 0.f; return z; }

template <int K>
DI void mma_tile(f32x16& acc, const bf16_t* A, int lda, const bf16_t* Bt, int ldb, int lane) {
  const int r = lane & 31, h = lane >> 5;
#pragma unroll
  for (int s = 0; s < K / 16; ++s) {
    bf16x8 a = *(const bf16x8*)(A + r * lda + s * 16 + h * 8);
    bf16x8 b = *(const bf16x8*)(Bt + r * ldb + s * 16 + h * 8);
    acc = mfma(a, b, acc);
  }
}

#define XB_TMO      128
#define XB_XCNT(j)  (256  + 64 * (j))
#define XB_XSUB(j)  (1280 + 64 * (j))
#define XB_XGEN(j)  (2304 + 64 * (j))
#define XB_TOP      3328
#define XB_TOPGEN   3392
#define XCD_BAR_WORDS 3456
#define XB_SPIN_CAP (1u << 18)
#define LAS __attribute__((address_space(3)))

__device__ __forceinline__ unsigned xb_ld(unsigned* p)              { return __hip_atomic_load(p, __ATOMIC_RELAXED, __HIP_MEMORY_SCOPE_AGENT); }
__device__ __forceinline__ unsigned xb_add(unsigned* p, unsigned v) { return __hip_atomic_fetch_add(p, v, __ATOMIC_RELAXED, __HIP_MEMORY_SCOPE_AGENT); }
__device__ __forceinline__ unsigned xb_xcc_id() { return (unsigned)__builtin_amdgcn_s_getreg((3 << 11) | 20) & 0xFu; }
#define XB_SPIN(cond, bar) do { unsigned _sp = 0; while (cond) { __builtin_amdgcn_s_sleep(1); \
    if ((++_sp & 255u) == 0u) { if (xb_ld(&(bar)[XB_TMO])) break; if (_sp > XB_SPIN_CAP) { atomicAdd(&(bar)[XB_TMO], 1u); break; } } } } while (0)

struct XcdBarrier {
    unsigned* bar; unsigned x;
    volatile LAS unsigned* st;
};

__device__ __forceinline__ XcdBarrier xcd_barrier_post(unsigned* bar, volatile LAS unsigned* st) {
    XcdBarrier b; b.bar = bar; b.x = xb_xcc_id(); b.st = st;
    if (threadIdx.x == 0) (void)xb_add(&bar[XB_XCNT(b.x)], 1u);
    return b;
}
__device__ __forceinline__ void xcd_barrier_complete(unsigned* bar, unsigned x, unsigned& nloc, unsigned& nx) {
    const unsigned G = gridDim.x * gridDim.y * gridDim.z;
    unsigned sum, cnt, mine, sp = 0u;
    for (;;) {
        sum = 0u; cnt = 0u; mine = 0u;
#pragma unroll
        for (unsigned j = 0; j < 16; ++j) { const unsigned c = xb_ld(&bar[XB_XCNT(j)]); sum += c; cnt += (c > 0u) ? 1u : 0u; mine = (j == x) ? c : mine; }
        if (sum == G) break;
        __builtin_amdgcn_s_sleep(1);
        if ((++sp & 255u) == 0u) { if (xb_ld(&bar[XB_TMO])) break; if (sp > XB_SPIN_CAP) { atomicAdd(&bar[XB_TMO], 1u); break; } }
    }
    nloc = mine > 0u ? mine : 1u; nx = cnt > 0u ? cnt : 1u;
}

__device__ __forceinline__ void xcd_barrier(const XcdBarrier& b) {
    asm volatile("s_waitcnt vmcnt(0)" ::: "memory");
    __syncthreads();
    if (threadIdx.x == 0) {
        unsigned* bar = b.bar;
        __builtin_amdgcn_s_waitcnt(0);
        unsigned nloc = b.st[0], nx = b.st[1];
        if (nloc == 0u) { xcd_barrier_complete(bar, b.x, nloc, nx); b.st[0] = nloc; b.st[1] = nx; }
        const unsigned old = xb_add(&bar[XB_XSUB(b.x)], 1u);
        const unsigned gen = old / nloc;
        if (old + 1u == (gen + 1u) * nloc) {
            __builtin_amdgcn_fence(__ATOMIC_RELEASE, "agent");
            asm volatile("s_waitcnt vmcnt(0)" ::: "memory");
            const unsigned og = xb_add(&bar[XB_TOP], 1u);
            const unsigned tg = og / nx;
            if (og + 1u == (tg + 1u) * nx) xb_add(&bar[XB_TOPGEN], 1u);
            else XB_SPIN(xb_ld(&bar[XB_TOPGEN]) == tg, bar);
            __builtin_amdgcn_fence(__ATOMIC_ACQUIRE, "agent");
            xb_add(&bar[XB_XGEN(b.x)], 1u);
            asm volatile("s_waitcnt vmcnt(0)" ::: "memory");
        } else {
            XB_SPIN(xb_ld(&bar[XB_XGEN(b.x)]) == gen, bar);
            __builtin_amdgcn_fence(__ATOMIC_ACQUIRE, "agent");
            asm volatile("s_waitcnt vmcnt(0)" ::: "memory");
        }
    }
    __syncthreads();
}


DI void phase0(const Params& p, char* smem) {
  const int tid = otid();
  float* sc = (float*)smem;
  float* red = sc + 5 * 1024;
  float* MOD = (float*)(p.ws + OFF_MOD);
  const int NU = 384 + 128 + 1;
  for (int u = blockIdx.x; u < NU; u += gridDim.x) {
    if (u < 384) {
      const int l = u / 96, nc = u % 96;
      __syncthreads();
      for (int i = tid; i < 5 * 1024; i += 256) {
        int j = i >> 10, k = i & 1023;
        float v = (j == 0) ? p.in[I_CCTX][k] : p.in[I_C][(j - 1) * 1024 + k];
        sc[i] = v / (1.f + expf(-v));
      }
      __syncthreads();
      const int col = tid & 31, kg = tid >> 5;
      const float* w = p.in[I_WADA] + (size_t)l * 1024 * 3072 + nc * 32 + col;
      float a0 = 0, a1 = 0, a2 = 0, a3 = 0, a4 = 0;
#pragma unroll 16
      for (int k = kg; k < 1024; k += 8) {
        float wv = w[(size_t)k * 3072];
        a0 += sc[k] * wv; a1 += sc[1024 + k] * wv; a2 += sc[2048 + k] * wv; a3 += sc[3072 + k] * wv; a4 += sc[4096 + k] * wv;
      }
      red[(kg * 5 + 0) * 32 + col] = a0; red[(kg * 5 + 1) * 32 + col] = a1; red[(kg * 5 + 2) * 32 + col] = a2;
      red[(kg * 5 + 3) * 32 + col] = a3; red[(kg * 5 + 4) * 32 + col] = a4;
      __syncthreads();
      if (tid < 160) {
        int j = tid >> 5, c2 = tid & 31;
        float s = 0;
        for (int g = 0; g < 8; ++g) s += red[(g * 5 + j) * 32 + c2];
        int n = nc * 32 + c2;
        MOD[(l * 5 + j) * 3072 + n] = s + p.in[I_BADA][l * 3072 + n];
      }
    } else if (u < 384 + 128) {
      const int v = u - 384;
      const int e = v >> 6, dir = (v >> 5) & 1, g = v & 31;
      if (tid < 64) {
        const int pp = tid;
        const int idx = ((e * 2 + dir) * 32 + g) * 64 + pp;
        double dt = exp((double)p.in[I_LOGDT][(e * 2 + dir) * 32 + g]);
        double lr = (double)p.in[I_LAMR][idx], li = (double)p.in[I_LAMI][idx];
        double mag = exp(lr * dt);
        double ang = li * dt;
        double tw = 6.283185307179586476925286766559;
        double kq = rint(ang / tw);
        double ra = ang - kq * tw;
        double lbr = mag * cos(ra), lbi = mag * sin(ra);
        double den = lr * lr + li * li;
        double nr = lbr - 1.0, ni = lbi;
        double cr = (nr * lr + ni * li) / den, ci = (ni * lr - nr * li) / den;
        float* LB = (float*)(p.ws + OFF_LB);
        float* LB256 = (float*)(p.ws + OFF_LB256);
        LB[idx * 2] = (float)lbr; LB[idx * 2 + 1] = (float)lbi;
        double pr = lbr, pi = lbi;
        for (int i = 0; i < 8; ++i) { double t = pr * pr - pi * pi; pi = 2.0 * pr * pi; pr = t; }
        LB256[idx * 2] = (float)pr; LB256[idx * 2 + 1] = (float)pi;
        bf16_t* BBT = (bf16_t*)(p.ws + OFF_BBT) + (size_t)((e * 2 + dir) * 32 + g) * 128 * 16;
        const float* bre = p.in[I_BRE] + ((size_t)(e * 32 + g) * 64 + pp) * 16;
        const float* bim = p.in[I_BIM] + ((size_t)(e * 32 + g) * 64 + pp) * 16;
        for (int hh = 0; hh < 16; ++hh) {
          double br = bre[hh], bi = bim[hh];
          const int nre = (pp >> 5) * 64 + (pp & 31);
          BBT[nre * 16 + hh] = f2bf((float)(cr * br - ci * bi));
          BBT[(nre + 32) * 16 + hh] = f2bf((float)(cr * bi + ci * br));
        }
        if (dir == 0) {
          bf16_t* CM = (bf16_t*)(p.ws + OFF_CM) + (size_t)(e * 32 + g) * 32 * 128;
          for (int hh = 0; hh < 32; ++hh) {
            float cre = 0.f, cim = 0.f;
            if (hh < 16) {
              cre = p.in[I_CRE][((size_t)(e * 32 + g) * 16 + hh) * 64 + pp];
              cim = p.in[I_CIM][((size_t)(e * 32 + g) * 16 + hh) * 64 + pp];
            }
            CM[hh * 128 + 2 * pp] = f2bf(cre);
            CM[hh * 128 + 2 * pp + 1] = f2bf(-cim);
          }
        }
      }
    } else {
      float* RT = (float*)(p.ws + OFF_ROPE);
      for (int i = tid; i < 64 * 16; i += 256) {
        int pos = i >> 4, f = i & 15;
        double fr = exp(-(double)f / 16.0 * 9.2103403719761827360719658187375);
        double ang = (double)pos * fr;
        double tw = 6.283185307179586476925286766559;
        double ra = ang - rint(ang / tw) * tw;
        RT[i * 2] = (float)cos(ra); RT[i * 2 + 1] = (float)sin(ra);
      }
    }
  }
}

DI void convert_tile(const float* src, int nsrc, bf16_t* dst, int K, int n0, int k0, int mapmode, int tid) {
  const int n = n0 + (tid & 63), kq = tid >> 6;
  int sc = n;
  if (mapmode == 1) {
    if (n < 1024) sc = n;
    else if (n < 2560) sc = n + 32;
    else if (n < 2592) sc = n - 1536;
    else sc = -1;
  }
  unsigned w[8];
#pragma unroll
  for (int i = 0; i < 8; ++i) {
    int k = k0 + kq * 16 + 2 * i;
    float a = 0.f, b = 0.f;
    if (sc >= 0) { a = src[(size_t)k * nsrc + sc]; b = src[(size_t)(k + 1) * nsrc + sc]; }
    w[i] = pack2(a, b);
  }
  uint4* d = (uint4*)(dst + (size_t)n * K + k0 + kq * 16);
  d[0] = make_uint4(w[0], w[1], w[2], w[3]);
  d[1] = make_uint4(w[4], w[5], w[6], w[7]);
}

DI void phaseA(const Params& p, int l) {
  const int tid = otid();
  const int odd = l & 1, e = l >> 1;
  const int n_in = (odd ? 52 : 42) * 16;
  const int n_out = 256;
  const int n_glu = odd ? 0 : 64;
  const int n_norm = NTOK / 16;
  const int total = n_in + n_out + n_glu + n_norm;
  bf16_t* WIN = (bf16_t*)(p.ws + OFF_WIN);
  bf16_t* WOUT = (bf16_t*)(p.ws + OFF_WOUT);
  bf16_t* WGLU = (bf16_t*)(p.ws + OFF_WGLU);
  bf16_t* H = (bf16_t*)(p.ws + OFF_HY);
  const float* MOD = (const float*)(p.ws + OFF_MOD);
  for (int u = blockIdx.x; u < total; u += gridDim.x) {
    if (u < n_in) {
      int nt = u >> 4, kt = u & 15;
      if (odd) convert_tile(p.in[I_WINO] + (size_t)e * 1024 * 3328, 3328, WIN, 1024, nt * 64, kt * 64, 0, tid);
      else convert_tile(p.in[I_WINE] + (size_t)e * 1024 * 2592, 2592, WIN, 1024, nt * 64, kt * 64, 1, tid);
    } else if (u < n_in + n_out) {
      int v = u - n_in; int nt = v >> 4, kt = v & 15;
      const float* src = (odd ? p.in[I_WOUTO] : p.in[I_WOUTE]) + (size_t)e * 1024 * 1024;
      convert_tile(src, 1024, WOUT, 1024, nt * 64, kt * 64, 0, tid);
    } else if (u < n_in + n_out + n_glu) {
      int v = u - n_in - n_out; int nt = v >> 3, kt = v & 7;
      convert_tile(p.in[I_WGLU] + (size_t)e * 512 * 512, 512, WGLU, 512, nt * 64, kt * 64, 0, tid);
    } else {
      int v = u - n_in - n_out - n_glu;
      const int tok0 = v * 16 + (tid >> 6) * 4;
      const int lane = tid & 63;
      const float* x;
      if (l == 0) x = (tok0 < NTOK_P) ? p.in[I_XP] + (size_t)tok0 * DM : p.in[I_XS] + (size_t)(tok0 - NTOK_P) * DM;
      else x = p.out + (size_t)tok0 * DM;
      const int j = (tok0 < NTOK_P) ? 0 : 1 + ((tok0 - NTOK_P) >> 12);
      const float* mod = MOD + (l * 5 + j) * 3072;
      const float* nw = p.in[I_NORMW] + l * 1024;
      float4 xv[4][4];
#pragma unroll
      for (int rr = 0; rr < 4; ++rr)
#pragma unroll
        for (int i = 0; i < 4; ++i) xv[rr][i] = *(const float4*)(x + (size_t)rr * DM + lane * 4 + 256 * i);
      float rstd[4];
#pragma unroll
      for (int rr = 0; rr < 4; ++rr) {
        float ss = 0.f;
#pragma unroll
        for (int i = 0; i < 4; ++i) ss += xv[rr][i].x * xv[rr][i].x + xv[rr][i].y * xv[rr][i].y + xv[rr][i].z * xv[rr][i].z + xv[rr][i].w * xv[rr][i].w;
#pragma unroll
        for (int o = 32; o >= 1; o >>= 1) ss += __shfl_xor(ss, o);
        rstd[rr] = rsqrtf(ss * (1.f / 1024.f) + EPSF);
      }
#pragma unroll
      for (int i = 0; i < 4; ++i) {
        const int k = lane * 4 + 256 * i;
        float4 w4 = *(const float4*)(nw + k);
        float4 sh = *(const float4*)(mod + k);
        float4 scl = *(const float4*)(mod + 1024 + k);
        const float c0 = w4.x * (1.f + scl.x), c1 = w4.y * (1.f + scl.y), c2 = w4.z * (1.f + scl.z), c3 = w4.w * (1.f + scl.w);
#pragma unroll
        for (int rr = 0; rr < 4; ++rr) {
          float h0 = xv[rr][i].x * rstd[rr] * c0 + sh.x;
          float h1 = xv[rr][i].y * rstd[rr] * c1 + sh.y;
          float h2 = xv[rr][i].z * rstd[rr] * c2 + sh.z;
          float h3 = xv[rr][i].w * rstd[rr] * c3 + sh.w;
          *(uint2*)(H + (size_t)(tok0 + rr) * DM + k) = make_uint2(pack2(h0, h1), pack2(h2, h3));
        }
      }
    }
  }
}

#define GLD 72
enum { EPI_P = 0, EPI_RES = 1, EPI_GLU = 2 };

template <int EPI, int KT>
DI void gemm_phase(const Params& p, int l, const bf16_t* A, int lda, const bf16_t* Bt, int ldb,
                           int NT, int ldp, char* smem) {
  const int tid = otid(), lane = tid & 63, w = tid >> 6;
  const int r = lane & 31, h = lane >> 5;
  const int wm = w >> 1, wn = w & 1;
  bf16_t* As = (bf16_t*)smem;
  bf16_t* Bs = As + 2 * 128 * GLD;
  const int lr = tid >> 3, lc = (tid & 7) * 8;
  const int MT = NTOK / 128;
  const int total = MT * NT;
  const float* MOD = (const float*)(p.ws + OFF_MOD);
  const int nslot = gridDim.x >> 3;
  if (blockIdx.x >= (gridDim.x >> 1)) { __builtin_amdgcn_s_sleep(56); }
  for (int k = 0;; ++k) {
    const int t = ((blockIdx.x & 7) + 8 * k) * nslot + (blockIdx.x >> 3);
    if (t >= total) break;
    const int band = t / (8 * NT), rem = t - band * 8 * NT;
    const int nt = rem >> 3, mt = band * 8 + (rem & 7);
    const int m0 = mt * 128, n0 = nt * 128;
    const bf16_t* Ag = A + (size_t)(m0 + lr) * lda + lc;
    const bf16_t* Bg = Bt + (size_t)(n0 + lr) * ldb + lc;
    uint4 xa0, xa1, xa2, xa3, xb0, xb1, xb2, xb3;
    uint4 ya0, ya1, ya2, ya3, yb0, yb1, yb2, yb3;
#define GLOADS(S, KOFS) \
    S##a0 = *(const uint4*)(Ag + (KOFS)); S##a1 = *(const uint4*)(Ag + (size_t)32 * lda + (KOFS)); \
    S##a2 = *(const uint4*)(Ag + (size_t)64 * lda + (KOFS)); S##a3 = *(const uint4*)(Ag + (size_t)96 * lda + (KOFS)); \
    S##b0 = *(const uint4*)(Bg + (KOFS)); S##b1 = *(const uint4*)(Bg + (size_t)32 * ldb + (KOFS)); \
    S##b2 = *(const uint4*)(Bg + (size_t)64 * ldb + (KOFS)); S##b3 = *(const uint4*)(Bg + (size_t)96 * ldb + (KOFS));
#define LSTORES(S, ST) \
    *(uint4*)(As + (ST) * 128 * GLD + (lr) * GLD + lc) = S##a0; *(uint4*)(As + (ST) * 128 * GLD + (lr + 32) * GLD + lc) = S##a1; \
    *(uint4*)(As + (ST) * 128 * GLD + (lr + 64) * GLD + lc) = S##a2; *(uint4*)(As + (ST) * 128 * GLD + (lr + 96) * GLD + lc) = S##a3; \
    *(uint4*)(Bs + (ST) * 128 * GLD + (lr) * GLD + lc) = S##b0; *(uint4*)(Bs + (ST) * 128 * GLD + (lr + 32) * GLD + lc) = S##b1; \
    *(uint4*)(Bs + (ST) * 128 * GLD + (lr + 64) * GLD + lc) = S##b2; *(uint4*)(Bs + (ST) * 128 * GLD + (lr + 96) * GLD + lc) = S##b3;
    bf16x8 fa0[4], fa1[4], fb0[4], fb1[4];
#define FRAGS(ST) { \
      const bf16_t* as = As + (ST) * 128 * GLD + (wm * 64 + r) * GLD + h * 8; \
      const bf16_t* bs = Bs + (ST) * 128 * GLD + (wn * 64 + r) * GLD + h * 8; \
      _Pragma("unroll") for (int s = 0; s < 4; ++s) { \
        fa0[s] = *(const bf16x8*)(as + s * 16); \
        fb0[s] = *(const bf16x8*)(bs + s * 16); \
        fa1[s] = *(const bf16x8*)(as + 32 * GLD + s * 16); \
        fb1[s] = *(const bf16x8*)(bs + 32 * GLD + s * 16); \
      } \
      __builtin_amdgcn_sched_barrier(0); }
#define MFMAS() { \
      _Pragma("unroll") for (int s = 0; s < 4; ++s) { \
        acc00 = mfma(fa0[s], fb0[s], acc00); acc01 = mfma(fa0[s], fb1[s], acc01); \
        acc10 = mfma(fa1[s], fb0[s], acc10); acc11 = mfma(fa1[s], fb1[s], acc11); \
      } \
      _Pragma("unroll") for (int g = 0; g < 8; ++g) { \
        __builtin_amdgcn_sched_group_barrier(0x008, 2, 0); \
        __builtin_amdgcn_sched_group_barrier(0x200, 1, 0); \
        __builtin_amdgcn_sched_group_barrier(0x020, 1, 0); \
      } }
    GLOADS(x, 0)
    LSTORES(x, 0)
    GLOADS(x, 64)
    GLOADS(y, 128)
    __syncthreads();
    f32x16 acc00 = zero16(), acc01 = zero16(), acc10 = zero16(), acc11 = zero16();
#pragma unroll
    for (int kt = 0; kt < KT; kt += 2) {
      FRAGS(0)
      LSTORES(x, 1)
      if (kt + 3 < KT) { GLOADS(x, (kt + 3) * 64) }
      MFMAS()
      __syncthreads();
      __builtin_amdgcn_sched_barrier(0);
      FRAGS(1)
      if (kt + 2 < KT) { LSTORES(y, 0) }
      if (kt + 4 < KT) { GLOADS(y, (kt + 4) * 64) }
      MFMAS()
      __syncthreads();
      __builtin_amdgcn_sched_barrier(0);
    }
#undef FRAGS
#undef MFMAS
#undef GLOADS
#undef LSTORES
    {
      float* Cs = (float*)smem;
      const int er = tid >> 4, ec = (tid & 15) * 8;
      const int jm = (m0 < NTOK_P) ? 0 : 1 + ((m0 - NTOK_P) >> 12);
      float4 px[8][2];
      uint4 pz[8][2];
      if (EPI == EPI_RES) {
        const float* xsrc;
        if (l == 0) xsrc = (m0 < NTOK_P) ? p.in[I_XP] : p.in[I_XS] - (size_t)NTOK_P * DM;
        else xsrc = p.out;
#pragma unroll
        for (int ps = 0; ps < 8; ++ps) {
          const float* xp_ = xsrc + (size_t)(m0 + ps * 16 + er) * DM + n0 + ec;
          px[ps][0] = *(const float4*)xp_; px[ps][1] = *(const float4*)(xp_ + 4);
        }
      } else if (EPI == EPI_GLU) {
        const bf16_t* Pz = (const bf16_t*)(p.ws + OFF_P);
        const bf16_t* Z5z = (const bf16_t*)(p.ws + OFF_Z5);
#pragma unroll
        for (int ps = 0; ps < 8; ++ps) {
          const size_t gr = (size_t)(m0 + ps * 16 + er);
          pz[ps][0] = *(const uint4*)(Z5z + gr * 512 + n0 + ec);
          pz[ps][1] = *(const uint4*)(Pz + gr * LDP_E + PE_ZS + n0 + ec);
        }
      }
#pragma unroll
      for (int q = 0; q < 16; ++q) {
        const int rr = wm * 64 + crow(q, h), cc = wn * 64 + r;
        Cs[rr * 132 + cc] = acc00[q];
        Cs[rr * 132 + cc + 32] = acc01[q];
        Cs[(rr + 32) * 132 + cc] = acc10[q];
        Cs[(rr + 32) * 132 + cc + 32] = acc11[q];
      }
      __syncthreads();
#pragma unroll
      for (int ps = 0; ps < 8; ++ps) {
        const int row = ps * 16 + er;
        const float4 c0 = *(const float4*)(Cs + row * 132 + ec);
        const float4 c1 = *(const float4*)(Cs + row * 132 + ec + 4);
        const size_t grow = (size_t)(m0 + row);
        const int gcol = n0 + ec;
        if (EPI == EPI_P) {
          bf16_t* P = (bf16_t*)(p.ws + OFF_P);
          *(uint4*)(P + grow * ldp + gcol) = make_uint4(pack2(c0.x, c0.y), pack2(c0.z, c0.w), pack2(c1.x, c1.y), pack2(c1.z, c1.w));
        } else if (EPI == EPI_RES) {
          const float* gate = MOD + (l * 5 + jm) * 3072 + 2048 + gcol;
          const float4 g0 = *(const float4*)gate, g1 = *(const float4*)(gate + 4);
          const float4 x0 = px[ps][0], x1 = px[ps][1];
          float4 o0, o1;
          o0.x = x0.x + g0.x * c0.x; o0.y = x0.y + g0.y * c0.y; o0.z = x0.z + g0.z * c0.z; o0.w = x0.w + g0.w * c0.w;
          o1.x = x1.x + g1.x * c1.x; o1.y = x1.y + g1.y * c1.y; o1.z = x1.z + g1.z * c1.z; o1.w = x1.w + g1.w * c1.w;
          *(float4*)(p.out + grow * DM + gcol) = o0;
          *(float4*)(p.out + grow * DM + gcol + 4) = o1;
        } else {
          const bf16_t* P = (const bf16_t*)(p.ws + OFF_P);
          const bf16_t* Z5 = (const bf16_t*)(p.ws + OFF_Z5);
          bf16_t* Y = (bf16_t*)(p.ws + OFF_HY);
          const float* bglu = p.in[I_BGLU] + (l >> 1) * 512 + gcol;
          const float4 b0 = *(const float4*)bglu, b1 = *(const float4*)(bglu + 4);
          const uint4 zv = pz[ps][0];
          const uint4 zs = pz[ps][1];
#define GLU1(ZW, SW, CA, CB, BA, BB) pack2(__uint_as_float((ZW) << 16) * sigmf((CA) + (BA)) * siluf(__uint_as_float((SW) << 16)), \
                                           __uint_as_float((ZW) & 0xffff0000u) * sigmf((CB) + (BB)) * siluf(__uint_as_float((SW) & 0xffff0000u)))
          uint4 o;
          o.x = GLU1(zv.x, zs.x, c0.x, c0.y, b0.x, b0.y);
          o.y = GLU1(zv.y, zs.y, c0.z, c0.w, b0.z, b0.w);
          o.z = GLU1(zv.z, zs.z, c1.x, c1.y, b1.x, b1.y);
          o.w = GLU1(zv.w, zs.w, c1.z, c1.w, b1.z, b1.w);
#undef GLU1
          *(uint4*)(Y + grow * DM + 512 + gcol) = o;
        }
      }
      __syncthreads();
    }
  }
}

#define GL 72
struct GlaSmem {
  bf16_t Qd[64 * GL];
  bf16_t Kn[64 * GL];
  bf16_t KdT[64 * GL];
  bf16_t Att[64 * GL];
  bf16_t VT[128 * GL];
  bf16_t ST[128 * GL];
  float lfS[64 * 16];
  float qtot[4 * 64];
  float Dl[64];
  float Gtot[64];
};
#define OLD 132
static_assert(sizeof(GlaSmem) <= SMEM_BYTES, "GLA smem");

template <bool FULL>
DI void gla_sweep(const Params& p, int e, int hd, int dir, int tok0, f32x16 (&sacc)[2], GlaSmem& S) {
  const int tid = otid(), lane = tid & 63, w = tid >> 6;
  const int r = lane & 31, h = lane >> 5;
  const bf16_t* P = (const bf16_t*)(p.ws + OFF_P);
  bf16_t* Y = (bf16_t*)(p.ws + OFF_HY);
  const int tq = tid >> 6;
  if (tid < 64) S.Gtot[tid] = 0.f;
  unsigned w2p[8];
  float bias;
  {
    const int d0 = tid & 63;
#pragma unroll
    for (int i = 0; i < 8; ++i)
      w2p[i] = pack2(p.in[I_GW2][((size_t)(e * 2 + dir) * 16 + 2 * i) * 256 + hd * 64 + d0],
                     p.in[I_GW2][((size_t)(e * 2 + dir) * 16 + 2 * i + 1) * 256 + hd * 64 + d0]);
    bias = p.in[I_GB2][(e * 2 + dir) * 256 + hd * 64 + d0];
  }
  __syncthreads();
  if (FULL) {
#pragma unroll
    for (int ni = 0; ni < 2; ++ni)
#pragma unroll
      for (int q = 0; q < 16; ++q) S.ST[(w * 32 + crow(q, h)) * GL + ni * 32 + r] = f2bf(sacc[ni][q]);
  }
  uint4 pq0, pq1, pk0, pk1;
  bf16_t plf[4];
  pq0 = pq1 = pk0 = pk1 = make_uint4(0, 0, 0, 0);
  plf[0] = plf[1] = plf[2] = plf[3] = 0;
#pragma unroll 1
  for (int cc = 0; cc < 4; ++cc) {
    const int c = dir ? 3 - cc : cc;
    const int ct0 = tok0 + c * 64;
    const int tv = tid & 63, cgp = tid >> 6;
    uint4 v0, v1, v2, v3;
    {
      const bf16_t* vsrc = P + (size_t)(ct0 + tv) * LDP_E + PE_V + hd * 128 + cgp * 32;
      v0 = *(const uint4*)(vsrc); v1 = *(const uint4*)(vsrc + 8); v2 = *(const uint4*)(vsrc + 16); v3 = *(const uint4*)(vsrc + 24);
    }
    {
      const int row = tid >> 2, c8 = (tid & 3) * 16;
      if (cc == 0) {
        const bf16_t* src = P + (size_t)(ct0 + row) * LDP_E + hd * 64 + c8;
        pk0 = *(const uint4*)(src + PE_K); pk1 = *(const uint4*)(src + PE_K + 8);
        if (FULL) { pq0 = *(const uint4*)(src + PE_Q); pq1 = *(const uint4*)(src + PE_Q + 8); }
#pragma unroll
        for (int i = 0; i < 4; ++i) {
          int idx = tid + 256 * i; int t = idx >> 4, rr = idx & 15;
          plf[i] = P[(size_t)(ct0 + t) * LDP_E + PE_LF + dir * 16 + rr];
        }
      }
#pragma unroll
      for (int i = 0; i < 4; ++i) S.lfS[tid + 256 * i] = bf2f(plf[i]);
      *(uint4*)(S.Kn + row * GL + c8) = pk0; *(uint4*)(S.Kn + row * GL + c8 + 8) = pk1;
      if (FULL) { *(uint4*)(S.Qd + row * GL + c8) = pq0; *(uint4*)(S.Qd + row * GL + c8 + 8) = pq1; }
      if (cc < 3) {
        const int cn = dir ? 2 - cc : cc + 1;
        const int cn0 = tok0 + cn * 64;
        const bf16_t* src = P + (size_t)(cn0 + row) * LDP_E + hd * 64 + c8;
        pk0 = *(const uint4*)(src + PE_K); pk1 = *(const uint4*)(src + PE_K + 8);
        if (FULL) { pq0 = *(const uint4*)(src + PE_Q); pq1 = *(const uint4*)(src + PE_Q + 8); }
#pragma unroll
        for (int i = 0; i < 4; ++i) {
          int idx = tid + 256 * i; int t = idx >> 4, rr = idx & 15;
          plf[i] = P[(size_t)(cn0 + t) * LDP_E + PE_LF + dir * 16 + rr];
        }
      }
    }
    __syncthreads();
    const int d = tid & 63;
    float w2r[16];
#pragma unroll
    for (int i = 0; i < 8; ++i) { w2r[2 * i] = __uint_as_float(w2p[i] << 16); w2r[2 * i + 1] = __uint_as_float(w2p[i] & 0xffff0000u); }
    float g[16];
    float run = 0.f;
#pragma unroll
    for (int i = 0; i < 16; ++i) {
      int t = tq * 16 + i;
      float x = bias;
#pragma unroll
      for (int rr = 0; rr < 16; ++rr) x += S.lfS[t * 16 + rr] * w2r[rr];
      float ls = fminf(x, 0.f) - __logf(1.f + __expf(-fabsf(x)));
      g[i] = ls * (1.f / 16.f);
      run += g[i];
    }
    S.qtot[tq * 64 + d] = run;
    __syncthreads();
    float q0 = S.qtot[d], q1 = S.qtot[64 + d], q2 = S.qtot[128 + d], q3 = S.qtot[192 + d];
    const float total = q0 + q1 + q2 + q3;
    float off;
    if (dir == 0) off = (tq > 0 ? q0 : 0.f) + (tq > 1 ? q1 : 0.f) + (tq > 2 ? q2 : 0.f);
    else off = (tq < 1 ? q1 : 0.f) + (tq < 2 ? q2 : 0.f) + (tq < 3 ? q3 : 0.f);
    float b[16];
    if (dir == 0) {
      float a = off;
#pragma unroll
      for (int i = 0; i < 16; ++i) { a += g[i]; b[i] = a; }
    } else {
      float a = off;
#pragma unroll
      for (int i = 15; i >= 0; --i) { a += g[i]; b[i] = a; }
    }
    if (tq == 0) { S.Dl[d] = __expf(total); S.Gtot[d] += total; }
    {
      unsigned kd[8];
      float kprev = 0.f;
#pragma unroll
      for (int i = 0; i < 16; ++i) {
        int t = tq * 16 + i;
        float kv = bf2f(S.Kn[t * GL + d]);
        if (FULL) {
          float qv = bf2f(S.Qd[t * GL + d]);
          S.Qd[t * GL + d] = f2bf(qv * 0.125f * __expf(b[i]));
          S.Kn[t * GL + d] = f2bf(kv * __expf(-b[i]));
        }
        float kdv = kv * __expf(total - b[i]);
        if (i & 1) kd[i >> 1] = pack2(kprev, kdv); else kprev = kdv;
      }
      uint4* dst = (uint4*)(S.KdT + d * GL + tq * 16);
      dst[0] = make_uint4(kd[0], kd[1], kd[2], kd[3]);
      dst[1] = make_uint4(kd[4], kd[5], kd[6], kd[7]);
    }
    {
      bf16_t* vd = S.VT + (cgp * 32) * GL + tv;
#define VTW(VV, B) vd[((B) + 0) * GL] = (bf16_t)(VV.x & 0xffffu); vd[((B) + 1) * GL] = (bf16_t)(VV.x >> 16); \
                   vd[((B) + 2) * GL] = (bf16_t)(VV.y & 0xffffu); vd[((B) + 3) * GL] = (bf16_t)(VV.y >> 16); \
                   vd[((B) + 4) * GL] = (bf16_t)(VV.z & 0xffffu); vd[((B) + 5) * GL] = (bf16_t)(VV.z >> 16); \
                   vd[((B) + 6) * GL] = (bf16_t)(VV.w & 0xffffu); vd[((B) + 7) * GL] = (bf16_t)(VV.w >> 16);
      VTW(v0, 0) VTW(v1, 8) VTW(v2, 16) VTW(v3, 24)
#undef VTW
    }
    __syncthreads();
    const int mi = w >> 1;
    f32x16 oacc[2];
    bf16_t* orec = Y + (size_t)(ct0 + mi * 32 + h * 16 + (r >> 1)) * DM + hd * 128 + (w & 1) * 64 + (r & 1) * 16;
    uint4 of0 = make_uint4(0, 0, 0, 0), of1 = of0, of2 = of0, of3 = of0, zg0 = of0, zg1 = of0, zg2 = of0, zg3 = of0;
    if (FULL && dir) {
      of0 = *(const uint4*)(orec); of1 = *(const uint4*)(orec + 8);
      of2 = *(const uint4*)(orec + 32); of3 = *(const uint4*)(orec + 40);
      const bf16_t* zg = P + (size_t)(ct0 + (tid >> 2)) * LDP_E + PE_ZG + hd * 128 + (tid & 3) * 32;
      zg0 = *(const uint4*)(zg); zg1 = *(const uint4*)(zg + 8); zg2 = *(const uint4*)(zg + 16); zg3 = *(const uint4*)(zg + 24);
    }
    if (FULL) {
      const int ni = w & 1;
      const bool skip = dir ? (ni < mi) : (ni > mi);
      f32x16 a = zero16();
      if (!skip) mma_tile<64>(a, S.Qd + mi * 32 * GL, GL, S.Kn + ni * 32 * GL, GL, lane);
#pragma unroll
      for (int q = 0; q < 16; ++q) {
        int i = mi * 32 + crow(q, h), j = ni * 32 + r;
        bool keep = dir ? (j >= i) : (j <= i);
        S.Att[i * GL + j] = f2bf(keep ? a[q] : 0.f);
      }
#pragma unroll
      for (int jj = 0; jj < 2; ++jj) {
        int nj = (w & 1) * 2 + jj;
        oacc[jj] = zero16();
        mma_tile<64>(oacc[jj], S.Qd + mi * 32 * GL, GL, S.ST + nj * 32 * GL, GL, lane);
      }
      __syncthreads();
#pragma unroll
      for (int jj = 0; jj < 2; ++jj) {
        int nj = (w & 1) * 2 + jj;
        mma_tile<64>(oacc[jj], S.Att + mi * 32 * GL, GL, S.VT + nj * 32 * GL, GL, lane);
      }
    }
#pragma unroll
    for (int ni = 0; ni < 2; ++ni) {
      float dec = S.Dl[ni * 32 + r];
#pragma unroll
      for (int q = 0; q < 16; ++q) sacc[ni][q] *= dec;
      mma_tile<64>(sacc[ni], S.VT + w * 32 * GL, GL, S.KdT + ni * 32 * GL, GL, lane);
    }
    __syncthreads();
    if (FULL) {
#pragma unroll
      for (int ni = 0; ni < 2; ++ni)
#pragma unroll
        for (int q = 0; q < 16; ++q) S.ST[(w * 32 + crow(q, h)) * GL + ni * 32 + r] = f2bf(sacc[ni][q]);
      if (dir == 0) {
#pragma unroll
        for (int jj = 0; jj < 2; ++jj) {
          *(uint4*)(orec + jj * 32) = make_uint4(pack2(oacc[jj][0], oacc[jj][1]), pack2(oacc[jj][2], oacc[jj][3]), pack2(oacc[jj][4], oacc[jj][5]), pack2(oacc[jj][6], oacc[jj][7]));
          *(uint4*)(orec + jj * 32 + 8) = make_uint4(pack2(oacc[jj][8], oacc[jj][9]), pack2(oacc[jj][10], oacc[jj][11]), pack2(oacc[jj][12], oacc[jj][13]), pack2(oacc[jj][14], oacc[jj][15]));
        }
      } else {
        float* Ob = (float*)S.Qd;
        {
          const unsigned ofw[16] = {of0.x, of0.y, of0.z, of0.w, of1.x, of1.y, of1.z, of1.w, of2.x, of2.y, of2.z, of2.w, of3.x, of3.y, of3.z, of3.w};
#pragma unroll
          for (int jj = 0; jj < 2; ++jj) {
            int cl = ((w & 1) * 2 + jj) * 32 + r;
#pragma unroll
            for (int q = 0; q < 16; ++q) {
              int tl = mi * 32 + crow(q, h);
              const unsigned wv = ofw[jj * 8 + (q >> 1)];
              float prev = (q & 1) ? __uint_as_float(wv & 0xffff0000u) : __uint_as_float(wv << 16);
              Ob[tl * OLD + cl] = oacc[jj][q] + prev;
            }
          }
        }
        __syncthreads();
        {
          const int tl = tid >> 2, qtr = tid & 3;
          float ss = 0.f;
#pragma unroll
          for (int i = 0; i < 32; ++i) { float v = Ob[tl * OLD + qtr * 32 + i]; ss += v * v; }
          ss += __shfl_xor(ss, 1);
          ss += __shfl_xor(ss, 2);
          const float rstd = rsqrtf(ss * (1.f / 128.f) + EPSF);
          const float* onw = p.in[I_GON] + e * 128 + qtr * 32;
          bf16_t* yo = Y + (size_t)(ct0 + tl) * DM + hd * 128 + qtr * 32;
          const unsigned zgw[16] = {zg0.x, zg0.y, zg0.z, zg0.w, zg1.x, zg1.y, zg1.z, zg1.w, zg2.x, zg2.y, zg2.z, zg2.w, zg3.x, zg3.y, zg3.z, zg3.w};
#pragma unroll
          for (int i = 0; i < 32; i += 2) {
            unsigned zz = zgw[i >> 1];
            float y0 = Ob[tl * OLD + qtr * 32 + i] * rstd * onw[i] * siluf(__uint_as_float(zz << 16));
            float y1 = Ob[tl * OLD + qtr * 32 + i + 1] * rstd * onw[i + 1] * siluf(__uint_as_float(zz & 0xffff0000u));
            *(unsigned*)(yo + i) = pack2(y0, y1);
          }
        }
        __syncthreads();
      }
    }
  }
}

DI void gla_pass1_unit(const Params& p, int e, int u, char* smem) {
  GlaSmem& S = *(GlaSmem*)smem;
  const int tid = otid(), lane = tid & 63, w = tid >> 6;
  const int r = lane & 31, h = lane >> 5;
  const int seg = u >> 3, hd = (u >> 1) & 3, dir = u & 1;
  const int tok0 = NTOK_P + seg * 256;
  f32x16 sacc[2];
  sacc[0] = zero16(); sacc[1] = zero16();
  __syncthreads();
  gla_sweep<false>(p, e, hd, dir, tok0, sacc, S);
  float* L = (float*)(p.ws + OFF_GLAL) + (size_t)((seg * 4 + hd) * 2 + dir) * 8192;
#pragma unroll
  for (int ni = 0; ni < 2; ++ni)
#pragma unroll
    for (int q = 0; q < 16; ++q) L[(w * 32 + crow(q, h)) * 64 + ni * 32 + r] = sacc[ni][q];
  if (tid < 64) {
    float* D = (float*)(p.ws + OFF_GLAD) + ((seg * 4 + hd) * 2 + dir) * 64;
    D[tid] = expf(S.Gtot[tid]);
  }
  __syncthreads();
}

DI void gla_pass3_unit(const Params& p, int e, int u, char* smem) {
  GlaSmem& S = *(GlaSmem*)smem;
  const int tid = otid(), lane = tid & 63, w = tid >> 6;
  const int r = lane & 31, h = lane >> 5;
  const int seg = ((u >> 2) + 32) % 96, hd = u & 3;
  const int tok0 = seg * 256;
  const bool samp = seg >= 32;
  const int sb = samp ? (seg - 32) >> 4 : 0, sl = samp ? (seg - 32) & 15 : 0;
  const float* Lb = (const float*)(p.ws + OFF_GLAL);
  const float* Db = (const float*)(p.ws + OFF_GLAD);
  for (int dir = 0; dir < 2; ++dir) {
    f32x16 sacc[2];
    sacc[0] = zero16(); sacc[1] = zero16();
    if (samp) {
      const float* s0 = p.in[I_SGLA] + (size_t)(((sb * 2 + e) * 2 + dir) * 4 + hd) * 8192;
#pragma unroll
      for (int ni = 0; ni < 2; ++ni)
#pragma unroll
        for (int q = 0; q < 16; ++q) sacc[ni][q] = s0[(ni * 32 + r) * 128 + w * 32 + crow(q, h)];
      const int nst = dir ? 15 - sl : sl;
      float Lc[32], dc[2];
      {
        const int sp0 = dir ? 15 : 0;
        const int sidx0 = ((sb * 16 + sp0) * 4 + hd) * 2 + dir;
        const float* L0 = Lb + (size_t)sidx0 * 8192;
        const float* D0 = Db + sidx0 * 64;
#pragma unroll
        for (int ni = 0; ni < 2; ++ni) {
          dc[ni] = D0[ni * 32 + r];
#pragma unroll
          for (int q = 0; q < 16; ++q) Lc[ni * 16 + q] = L0[(w * 32 + crow(q, h)) * 64 + ni * 32 + r];
        }
      }
#pragma unroll 1
      for (int k = 0; k < nst; ++k) {
        float Ln[32], dn[2];
        const int kn = (k + 1 < nst) ? k + 1 : k;
        const int sp = dir ? 15 - kn : kn;
        const int sidx = ((sb * 16 + sp) * 4 + hd) * 2 + dir;
        const float* L = Lb + (size_t)sidx * 8192;
        const float* D = Db + sidx * 64;
#pragma unroll
        for (int ni = 0; ni < 2; ++ni) {
          dn[ni] = D[ni * 32 + r];
#pragma unroll
          for (int q = 0; q < 16; ++q) Ln[ni * 16 + q] = L[(w * 32 + crow(q, h)) * 64 + ni * 32 + r];
        }
#pragma unroll
        for (int ni = 0; ni < 2; ++ni)
#pragma unroll
          for (int q = 0; q < 16; ++q) sacc[ni][q] = sacc[ni][q] * dc[ni] + Lc[ni * 16 + q];
#pragma unroll
        for (int i = 0; i < 32; ++i) Lc[i] = Ln[i];
        dc[0] = dn[0]; dc[1] = dn[1];
      }
    }
    __syncthreads();
    gla_sweep<true>(p, e, hd, dir, tok0, sacc, S);
    if (!samp) {
      float* o = p.out + OUT_GLA + (size_t)(((seg * 2 + e) * 2 + dir) * 4 + hd) * 8192;
#pragma unroll
      for (int ni = 0; ni < 2; ++ni)
#pragma unroll
        for (int q = 0; q < 16; ++q) o[(ni * 32 + r) * 128 + w * 32 + crow(q, h)] = sacc[ni][q];
    }
    __syncthreads();
  }
}

#define XLD 136
#define WSYNC() do { __builtin_amdgcn_fence(__ATOMIC_RELEASE, "wavefront"); __builtin_amdgcn_wave_barrier(); __builtin_amdgcn_fence(__ATOMIC_ACQUIRE, "wavefront"); } while (0)
DI void s5_sweep(const Params& p, int e, int g, int dir, int mode, int tok0, float& hr, float& hi, bf16_t* X) {
  const int lane = otid() & 63;
  const int r = lane & 31, h = lane >> 5;
  const bf16_t* P = (const bf16_t*)(p.ws + OFF_P);
  bf16_t* Z5 = (bf16_t*)(p.ws + OFF_Z5);
  bf16_t* Yb = (bf16_t*)(p.ws + OFF_HY);
  const float* LB = (const float*)(p.ws + OFF_LB) + (size_t)(((e * 2 + dir) * 32 + g) * 64 + lane) * 2;
  const float lbr = LB[0], lbi = LB[1];
  const bf16_t* BBT = (const bf16_t*)(p.ws + OFF_BBT) + (size_t)((e * 2 + dir) * 32 + g) * 128 * 16;
  const bf16_t* CM = (const bf16_t*)(p.ws + OFF_CM) + (size_t)(e * 32 + g) * 32 * 128;
  bf16x8 bfr[4];
#pragma unroll
  for (int j = 0; j < 4; ++j) bfr[j] = *(const bf16x8*)(BBT + (32 * j + r) * 16 + 8 * h);
  bf16x8 cfr[8];
#pragma unroll
  for (int s = 0; s < 8; ++s) cfr[s] = *(const bf16x8*)(CM + r * 128 + s * 16 + h * 8);
  bf16x8 dfr;
  {
    const short dv = (r < 16) ? (short)f2bf(p.in[I_S5D][e * 512 + g * 16 + r]) : (short)0;
#pragma unroll
    for (int j = 0; j < 8; ++j) dfr[j] = (8 * h + j == r) ? dv : (short)0;
  }
  const bf16_t* Ub = P + (size_t)(tok0 + r) * LDP_E + PE_U + g * 16 + 8 * h;
  bf16x8 a_cur = *(const bf16x8*)(Ub + (size_t)((dir ? 7 : 0) * 32) * LDP_E);
#pragma unroll 1
  for (int ss = 0; ss < 8; ++ss) {
    const int sc = dir ? 7 - ss : ss;
    const int t0 = tok0 + sc * 32;
    bf16x8 a_nxt = a_cur;
    if (ss < 7) a_nxt = *(const bf16x8*)(Ub + (size_t)((dir ? 6 - ss : ss + 1) * 32) * LDP_E);
    bf16_t* prec = Yb + (size_t)(t0 + 16 * h + (r & 15)) * DM + 512 + g * 16;
    uint4 pp0 = make_uint4(0, 0, 0, 0), pp1 = make_uint4(0, 0, 0, 0);
    if (mode == 2 && r < 16) { pp0 = *(const uint4*)prec; pp1 = *(const uint4*)(prec + 8); }
#pragma unroll
    for (int jp = 0; jp < 2; ++jp) {
      f32x16 are = mfma(a_cur, bfr[2 * jp], zero16());
      f32x16 aim = mfma(a_cur, bfr[2 * jp + 1], zero16());
#pragma unroll
      for (int q = 0; q < 16; ++q) *(unsigned*)(X + crow(q, h) * XLD + 2 * (32 * jp + r)) = pack2(are[q], aim[q]);
    }
    WSYNC();
#define S5STEP(T) { float br = __uint_as_float(wv[T] << 16), bi = __uint_as_float(wv[T] & 0xffff0000u); \
        float nr = lbr * hr - lbi * hi + br; float ni = lbr * hi + lbi * hr + bi; hr = nr; hi = ni; wv[T] = pack2(nr, ni); }
#pragma unroll
    for (int hf = 0; hf < 2; ++hf) {
      bf16_t* Xh = X + ((dir ? 1 - hf : hf) * 16) * XLD + 2 * lane;
      unsigned wv[16];
#pragma unroll
      for (int tt = 0; tt < 16; ++tt) wv[tt] = *(const unsigned*)(Xh + tt * XLD);
      if (dir == 0) {
#pragma unroll
        for (int tt = 0; tt < 16; ++tt) S5STEP(tt)
      } else {
#pragma unroll
        for (int tt = 15; tt >= 0; --tt) S5STEP(tt)
      }
#pragma unroll
      for (int tt = 0; tt < 16; ++tt) *(unsigned*)(Xh + tt * XLD) = wv[tt];
    }
#undef S5STEP
    WSYNC();
    if (mode >= 1) {
      f32x16 acc = zero16();
#pragma unroll
      for (int s = 0; s < 8; ++s) {
        bf16x8 xa = *(const bf16x8*)(X + r * XLD + s * 16 + h * 8);
        acc = mfma(xa, cfr[s], acc);
      }
      if (mode == 2) acc = mfma(a_cur, dfr, acc);
      if (r < 16) {
        if (mode == 1) {
          *(uint4*)prec = make_uint4(pack2(acc[0], acc[1]), pack2(acc[2], acc[3]), pack2(acc[4], acc[5]), pack2(acc[6], acc[7]));
          *(uint4*)(prec + 8) = make_uint4(pack2(acc[8], acc[9]), pack2(acc[10], acc[11]), pack2(acc[12], acc[13]), pack2(acc[14], acc[15]));
        } else {
          const unsigned pw[8] = {pp0.x, pp0.y, pp0.z, pp0.w, pp1.x, pp1.y, pp1.z, pp1.w};
          const int col = g * 16 + r;
#pragma unroll
          for (int q = 0; q < 16; ++q) {
            const float prev = (q & 1) ? __uint_as_float(pw[q >> 1] & 0xffff0000u) : __uint_as_float(pw[q >> 1] << 16);
            const float y = acc[q] + prev;
            const float t3 = 1.5957691216057308f * (y + 0.044715f * y * y * y);
            Z5[(size_t)(t0 + crow(q, h)) * 512 + col] = f2bf(y * sigmf(t3));
          }
        }
      }
    }
    WSYNC();
    a_cur = a_nxt;
  }
}

DI void s5_pass1_unit(const Params& p, int e, int u, char* smem) {
  const int tid = otid(), lane = tid & 63, w = tid >> 6;
  const int seg = u >> 3, g = (u & 7) * 4 + w;
  bf16_t* X = (bf16_t*)smem + w * 32 * XLD;
  float* ES = (float*)(p.ws + OFF_S5ES);
  for (int dir = 0; dir < 2; ++dir) {
    float hr = 0.f, hi = 0.f;
    s5_sweep(p, e, g, dir, 0, NTOK_P + seg * 256, hr, hi, X);
    size_t o = ((size_t)((seg * 32 + g) * 2 + dir) * 64 + lane) * 2;
    ES[o] = hr; ES[o + 1] = hi;
  }
}

DI void s5_pass3_unit(const Params& p, int e, int u, char* smem) {
  const int tid = otid(), lane = tid & 63, w = tid >> 6;
  const int seg = u >> 3, g = (u & 7) * 4 + w;
  bf16_t* X = (bf16_t*)smem + w * 32 * XLD;
  const bool samp = seg >= 32;
  const int sb = samp ? (seg - 32) >> 4 : 0, sl = samp ? (seg - 32) & 15 : 0;
  const float* ES = (const float*)(p.ws + OFF_S5ES);
  for (int dir = 0; dir < 2; ++dir) {
    float hr = 0.f, hi = 0.f;
    if (samp) {
      const size_t si = (size_t)(((sb * 2 + e) * 2 + dir) * 32 + g) * 64 + lane;
      hr = p.in[I_S5R][si]; hi = p.in[I_S5I][si];
      const float* L2 = (const float*)(p.ws + OFF_LB256) + (size_t)(((e * 2 + dir) * 32 + g) * 64 + lane) * 2;
      const float ar = L2[0], ai = L2[1];
      const int nst = dir ? 15 - sl : sl;
      float er[15], ei[15];
#pragma unroll
      for (int k = 0; k < 15; ++k) {
        const int kk = k < nst ? k : 0;
        const int sp = dir ? 15 - kk : kk;
        size_t o = ((size_t)(((sb * 16 + sp) * 32 + g) * 2 + dir) * 64 + lane) * 2;
        float2 ev = *(const float2*)(ES + o);
        er[k] = ev.x; ei[k] = ev.y;
      }
#pragma unroll
      for (int k = 0; k < 15; ++k) {
        if (k < nst) {
          float nr = ar * hr - ai * hi + er[k];
          float ni = ar * hi + ai * hr + ei[k];
          hr = nr; hi = ni;
        }
      }
    }
    s5_sweep(p, e, g, dir, dir + 1, seg * 256, hr, hi, X);
    if (!samp) {
      const size_t so = (size_t)(((seg * 2 + e) * 2 + dir) * 32 + g) * 64 + lane;
      p.out[OUT_S5R + so] = hr;
      p.out[OUT_S5I + so] = hi;
    }
  }
}

#define AL 72
template <int W>
DI void qk_prep(const bf16_t* src, const float* nw, bool rope, int pos, float mult, int sub, const float* RT,
                bf16_t* dst, float* fdst) {
  float x[4][W];
#pragma unroll
  for (int c = 0; c < 4; ++c) {
    if (W == 4) {
      uint2 v = *(const uint2*)(src + 16 * c + 4 * sub);
      x[c][0] = __uint_as_float(v.x << 16); x[c][1] = __uint_as_float(v.x & 0xffff0000u);
      x[c][2] = __uint_as_float(v.y << 16); x[c][3] = __uint_as_float(v.y & 0xffff0000u);
    } else {
      uint4 v = *(const uint4*)(src + 16 * c + 8 * sub);
      x[c][0] = __uint_as_float(v.x << 16); x[c][1] = __uint_as_float(v.x & 0xffff0000u);
      x[c][2] = __uint_as_float(v.y << 16); x[c][3] = __uint_as_float(v.y & 0xffff0000u);
      x[c][4 % W] = __uint_as_float(v.z << 16); x[c][5 % W] = __uint_as_float(v.z & 0xffff0000u);
      x[c][6 % W] = __uint_as_float(v.w << 16); x[c][7 % W] = __uint_as_float(v.w & 0xffff0000u);
    }
  }
  float ss = 0.f;
#pragma unroll
  for (int c = 0; c < 4; ++c)
#pragma unroll
    for (int i = 0; i < W; ++i) ss += x[c][i] * x[c][i];
  ss += __shfl_xor(ss, 1);
  if (W == 4) ss += __shfl_xor(ss, 2);
  const float rstd = rsqrtf(ss * (1.f / 64.f) + EPSF);
#pragma unroll
  for (int c = 0; c < 4; ++c)
#pragma unroll
    for (int i = 0; i < W; ++i) x[c][i] *= rstd * nw[16 * c + W * sub + i];
  if (rope) {
    const int row = pos >> 6, col = pos & 63;
#pragma unroll
    for (int i = 0; i < W; ++i) {
      const int f = W * sub + i;
      float cs = RT[(row * 16 + f) * 2], sn = RT[(row * 16 + f) * 2 + 1];
      float x1 = x[0][i], x2 = x[1][i];
      x[0][i] = x1 * cs - x2 * sn; x[1][i] = x2 * cs + x1 * sn;
      cs = RT[(col * 16 + f) * 2]; sn = RT[(col * 16 + f) * 2 + 1];
      x1 = x[2][i]; x2 = x[3][i];
      x[2][i] = x1 * cs - x2 * sn; x[3][i] = x2 * cs + x1 * sn;
    }
  }
#pragma unroll
  for (int c = 0; c < 4; ++c)
#pragma unroll
    for (int i = 0; i < W; ++i) {
      dst[16 * c + W * sub + i] = f2bf(x[c][i] * mult);
      if (fdst) fdst[16 * c + W * sub + i] = x[c][i];
    }
}

DI void attn_unit(const Params& p, int e, int u, char* smem) {
  const int tid = otid(), lane = tid & 63, w = tid >> 6;
  const int r = lane & 31, h = lane >> 5;
  bf16_t* Ks = (bf16_t*)smem;
  bf16_t* Vt = Ks + 64 * AL;
  bf16_t* Qs = Vt + 64 * AL;
  const bf16_t* P = (const bf16_t*)(p.ws + OFF_P);
  bf16_t* Y = (bf16_t*)(p.ws + OFF_HY);
  const float* RT = (const float*)(p.ws + OFF_ROPE);
  const bool lat = u >= 512;
  int b, kvh, qb;
  if (!lat) { b = u >> 4; kvh = (u >> 3) & 1; qb = u & 7; }
  else { int v = u - 512; b = v >> 8; kvh = (v >> 7) & 1; qb = v & 127; }
  const int tokbase = lat ? NTOK_P + b * 4096 : b * 256;
  const int q0 = qb * 32;
  const int hq = kvh * 4 + w;
  __syncthreads();
  const int kbase = lat ? (((q0 - 128) >> 6) << 6) : 0;
  const int ntile = lat ? 9 : 4;
  bf16_t* Ks1 = Qs + 4 * 32 * AL;
  bf16_t* Vt1 = Ks1 + 64 * AL;
  const int keyk = tid >> 2, s4 = tid & 3;
  const int keyv = tid & 63, cq = tid >> 6;
  const bool wr = (!lat) && (qb == 0);
  float knw[16];
#pragma unroll
  for (int c = 0; c < 4; ++c)
#pragma unroll
    for (int i = 0; i < 4; ++i) knw[c * 4 + i] = p.in[I_KNW][e * 64 + 16 * c + 4 * s4 + i];
  float ccs[4], csn[4];
#pragma unroll
  for (int i = 0; i < 4; ++i) { ccs[i] = RT[(keyk * 16 + 4 * s4 + i) * 2]; csn[i] = RT[(keyk * 16 + 4 * s4 + i) * 2 + 1]; }
  uint4 rk0, rk1, rk2, rk3, rv0, rv1, rv2, rv3;
  float rrc[4] = {1.f, 1.f, 1.f, 1.f}, rrs[4] = {0.f, 0.f, 0.f, 0.f};
  rk0 = rk1 = rk2 = rk3 = rv0 = rv1 = rv2 = rv3 = make_uint4(0, 0, 0, 0);
  int tlo = 0, thi = ntile - 1;
  if (lat) {
    tlo = kbase < 0 ? (-kbase) >> 6 : 0;
    thi = 4;
    while (kbase + thi * 64 >= 4096) --thi;
  }
#define TILE_NEXT(ti) (lat ? ((ti) < thi ? (ti) + 1 : ((ti) < 5 ? 5 : (ti) + 1)) : (ti) + 1)
#define TILE_LOAD(ti) { \
    const bool fc_ = lat && (ti) >= 5; \
    const int kt0_ = fc_ ? ((ti) - 5) * 64 : kbase + (ti) * 64; \
    if (fc_) { \
      const float* ck = p.in[I_CK] + ((size_t)((b * 2 + e) * 2 + kvh) * 256 + kt0_ + keyk) * 64 + 4 * s4; \
      const float* cv = p.in[I_CV] + ((size_t)((b * 2 + e) * 2 + kvh) * 256 + kt0_ + keyv) * 64 + cq * 16; \
      rk0 = *(const uint4*)(ck); rk1 = *(const uint4*)(ck + 16); rk2 = *(const uint4*)(ck + 32); rk3 = *(const uint4*)(ck + 48); \
      rv0 = *(const uint4*)(cv); rv1 = *(const uint4*)(cv + 4); rv2 = *(const uint4*)(cv + 8); rv3 = *(const uint4*)(cv + 12); \
    } else { \
      const bf16_t* ksrc = P + (size_t)(tokbase + kt0_ + keyk) * LDP_O + PO_K + kvh * 64 + 4 * s4; \
      const bf16_t* vsrc = P + (size_t)(tokbase + kt0_ + keyv) * LDP_O + PO_V + kvh * 64 + cq * 16; \
      uint2 t0_ = *(const uint2*)(ksrc), t1_ = *(const uint2*)(ksrc + 16), t2_ = *(const uint2*)(ksrc + 32), t3_ = *(const uint2*)(ksrc + 48); \
      rk0.x = t0_.x; rk0.y = t0_.y; rk1.x = t1_.x; rk1.y = t1_.y; rk2.x = t2_.x; rk2.y = t2_.y; rk3.x = t3_.x; rk3.y = t3_.y; \
      rv0 = *(const uint4*)(vsrc); rv1 = *(const uint4*)(vsrc + 8); \
      if (lat) { \
        const int row_ = kt0_ >> 6; \
        _Pragma("unroll") for (int i = 0; i < 4; ++i) { rrc[i] = RT[(row_ * 16 + 4 * s4 + i) * 2]; rrs[i] = RT[(row_ * 16 + 4 * s4 + i) * 2 + 1]; } \
      } \
    } }
#define VT4(VD, W0, W1) { (VD)[0] = (bf16_t)((W0) & 0xffffu); (VD)[AL] = (bf16_t)((W0) >> 16); (VD)[2 * AL] = (bf16_t)((W1) & 0xffffu); (VD)[3 * AL] = (bf16_t)((W1) >> 16); }
#define TILE_STORE(ti, KB, VB) { \
    const bool fc_ = lat && (ti) >= 5; \
    const int kt0_ = fc_ ? ((ti) - 5) * 64 : kbase + (ti) * 64; \
    if (fc_) { \
      bf16_t* kd = (KB) + keyk * AL + 4 * s4; \
      *(uint2*)(kd) = make_uint2(pack2(__uint_as_float(rk0.x), __uint_as_float(rk0.y)), pack2(__uint_as_float(rk0.z), __uint_as_float(rk0.w))); \
      *(uint2*)(kd + 16) = make_uint2(pack2(__uint_as_float(rk1.x), __uint_as_float(rk1.y)), pack2(__uint_as_float(rk1.z), __uint_as_float(rk1.w))); \
      *(uint2*)(kd + 32) = make_uint2(pack2(__uint_as_float(rk2.x), __uint_as_float(rk2.y)), pack2(__uint_as_float(rk2.z), __uint_as_float(rk2.w))); \
      *(uint2*)(kd + 48) = make_uint2(pack2(__uint_as_float(rk3.x), __uint_as_float(rk3.y)), pack2(__uint_as_float(rk3.z), __uint_as_float(rk3.w))); \
      bf16_t* vd = (VB) + (cq * 16) * AL + keyv; \
      VT4(vd, pack2(__uint_as_float(rv0.x), __uint_as_float(rv0.y)), pack2(__uint_as_float(rv0.z), __uint_as_float(rv0.w))) \
      VT4(vd + 4 * AL, pack2(__uint_as_float(rv1.x), __uint_as_float(rv1.y)), pack2(__uint_as_float(rv1.z), __uint_as_float(rv1.w))) \
      VT4(vd + 8 * AL, pack2(__uint_as_float(rv2.x), __uint_as_float(rv2.y)), pack2(__uint_as_float(rv2.z), __uint_as_float(rv2.w))) \
      VT4(vd + 12 * AL, pack2(__uint_as_float(rv3.x), __uint_as_float(rv3.y)), pack2(__uint_as_float(rv3.z), __uint_as_float(rv3.w))) \
    } else { \
      float x[4][4]; \
      const unsigned kw[8] = {rk0.x, rk0.y, rk1.x, rk1.y, rk2.x, rk2.y, rk3.x, rk3.y}; \
      _Pragma("unroll") for (int c = 0; c < 4; ++c) { \
        x[c][0] = __uint_as_float(kw[2 * c] << 16); x[c][1] = __uint_as_float(kw[2 * c] & 0xffff0000u); \
        x[c][2] = __uint_as_float(kw[2 * c + 1] << 16); x[c][3] = __uint_as_float(kw[2 * c + 1] & 0xffff0000u); } \
      float ss = 0.f; \
      _Pragma("unroll") for (int c = 0; c < 4; ++c) _Pragma("unroll") for (int i = 0; i < 4; ++i) ss += x[c][i] * x[c][i]; \
      ss += __shfl_xor(ss, 1); ss += __shfl_xor(ss, 2); \
      const float rstd = rsqrtf(ss * (1.f / 64.f) + EPSF); \
      _Pragma("unroll") for (int c = 0; c < 4; ++c) _Pragma("unroll") for (int i = 0; i < 4; ++i) x[c][i] *= rstd * knw[c * 4 + i]; \
      if (lat) { \
        _Pragma("unroll") for (int i = 0; i < 4; ++i) { \
          float x1 = x[0][i], x2 = x[1][i]; x[0][i] = x1 * rrc[i] - x2 * rrs[i]; x[1][i] = x2 * rrc[i] + x1 * rrs[i]; \
          x1 = x[2][i]; x2 = x[3][i]; x[2][i] = x1 * ccs[i] - x2 * csn[i]; x[3][i] = x2 * ccs[i] + x1 * csn[i]; } \
      } \
      bf16_t* kd = (KB) + keyk * AL + 4 * s4; \
      _Pragma("unroll") for (int c = 0; c < 4; ++c) *(uint2*)(kd + 16 * c) = make_uint2(pack2(x[c][0], x[c][1]), pack2(x[c][2], x[c][3])); \
      if (wr) { \
        float* fd = p.out + OUT_CK + ((size_t)((b * 2 + e) * 2 + kvh) * 256 + kt0_ + keyk) * 64 + 4 * s4; \
        _Pragma("unroll") for (int c = 0; c < 4; ++c) *(float4*)(fd + 16 * c) = make_float4(x[c][0], x[c][1], x[c][2], x[c][3]); \
        float* fv = p.out + OUT_CV + ((size_t)((b * 2 + e) * 2 + kvh) * 256 + kt0_ + keyv) * 64 + cq * 16; \
        *(float4*)(fv) = make_float4(__uint_as_float(rv0.x << 16), __uint_as_float(rv0.x & 0xffff0000u), __uint_as_float(rv0.y << 16), __uint_as_float(rv0.y & 0xffff0000u)); \
        *(float4*)(fv + 4) = make_float4(__uint_as_float(rv0.z << 16), __uint_as_float(rv0.z & 0xffff0000u), __uint_as_float(rv0.w << 16), __uint_as_float(rv0.w & 0xffff0000u)); \
        *(float4*)(fv + 8) = make_float4(__uint_as_float(rv1.x << 16), __uint_as_float(rv1.x & 0xffff0000u), __uint_as_float(rv1.y << 16), __uint_as_float(rv1.y & 0xffff0000u)); \
        *(float4*)(fv + 12) = make_float4(__uint_as_float(rv1.z << 16), __uint_as_float(rv1.z & 0xffff0000u), __uint_as_float(rv1.w << 16), __uint_as_float(rv1.w & 0xffff0000u)); \
      } \
      bf16_t* vd = (VB) + (cq * 16) * AL + keyv; \
      VT4(vd, rv0.x, rv0.y) VT4(vd + 4 * AL, rv0.z, rv0.w) VT4(vd + 8 * AL, rv1.x, rv1.y) VT4(vd + 12 * AL, rv1.z, rv1.w) \
    } }
  int cur = 0;
  TILE_LOAD(tlo)
  uint2 zq[2][4];
#pragma unroll
  for (int dvt = 0; dvt < 2; ++dvt)
#pragma unroll
    for (int g4 = 0; g4 < 4; ++g4)
      zq[dvt][g4] = *(const uint2*)(P + (size_t)(tokbase + q0 + r) * LDP_O + PO_ZA + hq * 64 + dvt * 32 + 8 * g4 + 4 * h);
  {
    const int qi = lane >> 1, sub = lane & 1;
    const bf16_t* src = P + (size_t)(tokbase + q0 + qi) * LDP_O + PO_Q + hq * 64;
    qk_prep<8>(src, p.in[I_QNW] + e * 64, lat, q0 + qi, 0.125f, sub, RT, Qs + (w * 32 + qi) * AL, nullptr);
  }
  __syncthreads();
  bf16x8 qf[4];
#pragma unroll
  for (int ks = 0; ks < 4; ++ks) qf[ks] = *(const bf16x8*)(Qs + (w * 32 + r) * AL + ks * 16 + h * 8);
  float m_run = p.in[I_SINK][e * 8 + hq];
  float l_run = 1.f;
  f32x16 o[2];
  o[0] = zero16(); o[1] = zero16();
  TILE_STORE(tlo, Ks, Vt)
  __syncthreads();
  for (int ti = tlo; ti < ntile;) {
    const bool fromcache = lat && ti >= 5;
    const int kt0 = fromcache ? (ti - 5) * 64 : kbase + ti * 64;
    const int tn = TILE_NEXT(ti);
    if (tn < ntile) { TILE_LOAD(tn) }
    const bf16_t* Kc = cur ? Ks1 : Ks;
    const bf16_t* Vc = cur ? Vt1 : Vt;
    f32x16 s[2];
#pragma unroll
    for (int mt = 0; mt < 2; ++mt) {
      s[mt] = zero16();
#pragma unroll
      for (int ks = 0; ks < 4; ++ks) {
        bf16x8 a = *(const bf16x8*)(Kc + (mt * 32 + r) * AL + ks * 16 + h * 8);
        s[mt] = mfma(a, qf[ks], s[mt]);
      }
    }
    if (lat && !fromcache) {
      const int qpos = q0 + r;
#pragma unroll
      for (int mt = 0; mt < 2; ++mt)
#pragma unroll
        for (int q = 0; q < 16; ++q) {
          int kpos = kt0 + mt * 32 + crow(q, h);
          int dd = kpos - qpos;
          if (dd > 128 || dd < -128) s[mt][q] = -1e30f;
        }
    }
    float mx = -3e38f;
#pragma unroll
    for (int mt = 0; mt < 2; ++mt)
#pragma unroll
      for (int q = 0; q < 16; ++q) mx = fmaxf(mx, s[mt][q]);
    mx = fmaxf(mx, __shfl_xor(mx, 32));
    const float m_new = fmaxf(m_run, mx);
    const float alpha = __expf(m_run - m_new);
    float rs = 0.f;
#pragma unroll
    for (int mt = 0; mt < 2; ++mt)
#pragma unroll
      for (int q = 0; q < 16; ++q) { float pv = __expf(s[mt][q] - m_new); s[mt][q] = pv; rs += pv; }
    rs += __shfl_xor(rs, 32);
    l_run = l_run * alpha + rs;
    m_run = m_new;
#pragma unroll
    for (int q = 0; q < 16; ++q) { o[0][q] *= alpha; o[1][q] *= alpha; }
#pragma unroll
    for (int mt = 0; mt < 2; ++mt)
#pragma unroll
      for (int sx = 0; sx < 2; ++sx) {
        bf16x8 pf;
#pragma unroll
        for (int j = 0; j < 8; ++j) pf[j] = (short)f2bf(s[mt][8 * sx + j]);
#pragma unroll
        for (int dvt = 0; dvt < 2; ++dvt) {
          const bf16_t* vp = Vc + (dvt * 32 + r) * AL + mt * 32 + 16 * sx + 4 * h;
          s16x4 lo = *(const s16x4*)vp;
          s16x4 hi4 = *(const s16x4*)(vp + 8);
          bf16x8 a = __builtin_shufflevector(lo, hi4, 0, 1, 2, 3, 4, 5, 6, 7);
          o[dvt] = mfma(a, pf, o[dvt]);
        }
      }
      if (tn < ntile) {
      if (cur) { TILE_STORE(tn, Ks, Vt) } else { TILE_STORE(tn, Ks1, Vt1) }
    }
    __syncthreads();
    ti = tn;
    cur ^= 1;
  }
#undef TILE_NEXT
#undef TILE_LOAD
#undef TILE_STORE
#undef VT4
  const float inv = 1.f / l_run;
  const int tok = tokbase + q0 + r;
#pragma unroll
  for (int dvt = 0; dvt < 2; ++dvt)
#pragma unroll
    for (int g4 = 0; g4 < 4; ++g4) {
      const int dv = dvt * 32 + 8 * g4 + 4 * h;
      uint2 zz = zq[dvt][g4];
      float z0 = __uint_as_float(zz.x << 16), z1 = __uint_as_float(zz.x & 0xffff0000u);
      float z2 = __uint_as_float(zz.y << 16), z3 = __uint_as_float(zz.y & 0xffff0000u);
      float y0 = o[dvt][4 * g4 + 0] * inv * siluf(z0);
      float y1 = o[dvt][4 * g4 + 1] * inv * siluf(z1);
      float y2 = o[dvt][4 * g4 + 2] * inv * siluf(z2);
      float y3 = o[dvt][4 * g4 + 3] * inv * siluf(z3);
      *(uint2*)(Y + (size_t)tok * DM + hq * 64 + dv) = make_uint2(pack2(y0, y1), pack2(y2, y3));
    }
}

DI void conv_unit(const Params& p, int e, int u) {
  const int tid = otid();
  const bf16_t* P = (const bf16_t*)(p.ws + OFF_P);
  bf16_t* Y = (bf16_t*)(p.ws + OFF_HY);
  const int t0 = u * 16;
  const int c = tid * 2;
  int seg0, seg1;
  if (t0 < NTOK_P) { seg0 = t0 & ~255; seg1 = seg0 + 256; }
  else { seg0 = NTOK_P + ((t0 - NTOK_P) & ~4095); seg1 = seg0 + 4096; }
  const float* cw = p.in[I_CONVW] + (size_t)e * 3 * 512;
  const float w00 = cw[c], w01 = cw[c + 1], w10 = cw[512 + c], w11 = cw[512 + c + 1], w20 = cw[1024 + c], w21 = cw[1024 + c + 1];
  const float b0 = p.in[I_CONVB][e * 512 + c], b1 = p.in[I_CONVB][e * 512 + c + 1];
  auto prod = [&](int t, float& a, float& b) {
    if (t < seg0 || t >= seg1) { a = 0.f; b = 0.f; return; }
    unsigned xc = *(const unsigned*)(P + (size_t)t * LDP_O + PO_XC + c);
    unsigned cg_ = *(const unsigned*)(P + (size_t)t * LDP_O + PO_CG + c);
    a = __uint_as_float(xc << 16) * __uint_as_float(cg_ << 16);
    b = __uint_as_float(xc & 0xffff0000u) * __uint_as_float(cg_ & 0xffff0000u);
  };
  float pa0, pa1, pb0, pb1, pc0, pc1;
  prod(t0 - 1, pa0, pa1);
  prod(t0, pb0, pb1);
#pragma unroll
  for (int i = 0; i < 16; ++i) {
    const int t = t0 + i;
    prod(t + 1, pc0, pc1);
    unsigned bg = *(const unsigned*)(P + (size_t)t * LDP_O + PO_BG + c);
    unsigned zc = *(const unsigned*)(P + (size_t)t * LDP_O + PO_ZC + c);
    float y0 = __uint_as_float(bg << 16) * (w00 * pa0 + w10 * pb0 + w20 * pc0 + b0) * siluf(__uint_as_float(zc << 16));
    float y1 = __uint_as_float(bg & 0xffff0000u) * (w01 * pa1 + w11 * pb1 + w21 * pc1 + b1) * siluf(__uint_as_float(zc & 0xffff0000u));
    *(unsigned*)(Y + (size_t)t * DM + 512 + c) = pack2(y0, y1);
    pa0 = pb0; pa1 = pb1; pb0 = pc0; pb1 = pc1;
  }
}


#define QCTR(l, ph) ((unsigned*)(p.ws + OFF_BAR) + 3584 + 16 * ((l) * 4 + (ph)))
DI int next_unit(unsigned* ctr, volatile int* sh) {
  __syncthreads();
  if (threadIdx.x == 0) *sh = (int)atomicAdd(ctr, 1u);
  __syncthreads();
  return *sh;
}
#ifndef REP_A
#define REP_A 1
#endif
#ifndef REP_INPROJ
#define REP_INPROJ 1
#endif
#ifndef REP_EVEN
#define REP_EVEN 1
#endif
#ifndef REP_ODD
#define REP_ODD 1
#endif
#define REP_G1 1
#define REP_S1 1
#define REP_G3 1
#define REP_S3 1
#ifndef REP_SYNC
#define REP_SYNC 1
#endif
#define GSYNC() do { _Pragma("unroll 1") for (int rs_ = 0; rs_ < REP_SYNC; ++rs_) xcd_barrier(xb); } while (0)
__global__ void __launch_bounds__(256, 2) fwd_megakernel(Params p) {
  cg::grid_group grid = cg::this_grid();
  __shared__ __attribute__((aligned(16))) char smem[SMEM_BYTES];
  __shared__ uint4 xb_words;
  __shared__ int qsh;
  if (threadIdx.x == 0) xb_words = make_uint4(0u, 0u, 0u, 0u);
  __syncthreads();
  XcdBarrier xb = xcd_barrier_post((unsigned*)(p.ws + OFF_BAR), (volatile LAS unsigned*)&xb_words);
  if (p.ws == nullptr) grid.sync();
  phase0(p, smem);
  GSYNC();
#pragma unroll 1
  for (int l = 0; l < 4; ++l) {
    const int e = l >> 1;
#pragma unroll 1
    for (int rep = 0; rep < REP_A; ++rep) {
      phaseA(p, l);
      GSYNC();
    }
    const int odd = l & 1;
#pragma unroll 1
    for (int rep = 0; rep < REP_INPROJ; ++rep) {
      gemm_phase<EPI_P, 16>(p, l, (const bf16_t*)(p.ws + OFF_HY), DM, (const bf16_t*)(p.ws + OFF_WIN), DM, odd ? LDP_O / 128 : LDP_E / 128, odd ? LDP_O : LDP_E, smem);
      GSYNC();
    }
    if (!odd) {
#pragma unroll 1
      for (int rep = 0; rep < REP_EVEN; ++rep) {
        if (blockIdx.x >= (gridDim.x >> 1)) { __builtin_amdgcn_s_sleep(127); __builtin_amdgcn_s_sleep(127); }
        for (int u = next_unit(QCTR(l, 0), &qsh); u < 512 + 512; u = next_unit(QCTR(l, 0), &qsh)) {
          if (u < 512) { _Pragma("unroll 1") for (int r2 = 0; r2 < REP_G1; ++r2) gla_pass1_unit(p, e, u, smem); }
          else { _Pragma("unroll 1") for (int r2 = 0; r2 < REP_S1; ++r2) s5_pass1_unit(p, e, u - 512, smem); }
        }
        GSYNC();
        if (blockIdx.x >= (gridDim.x >> 1)) { __builtin_amdgcn_s_sleep(127); __builtin_amdgcn_s_sleep(127); }
        for (int u = next_unit(QCTR(l, 1), &qsh); u < 384 + 768; u = next_unit(QCTR(l, 1), &qsh)) {
          if (u < 384) { _Pragma("unroll 1") for (int r2 = 0; r2 < REP_G3; ++r2) gla_pass3_unit(p, e, u, smem); }
          else { _Pragma("unroll 1") for (int r2 = 0; r2 < REP_S3; ++r2) s5_pass3_unit(p, e, u - 384, smem); }
        }
        GSYNC();
        gemm_phase<EPI_GLU, 8>(p, l, (const bf16_t*)(p.ws + OFF_Z5), 512, (const bf16_t*)(p.ws + OFF_WGLU), 512, 4, 0, smem);
        GSYNC();
      }
    } else {
#pragma unroll 1
      for (int rep = 0; rep < REP_ODD; ++rep) {
        if (blockIdx.x >= (gridDim.x >> 1)) { __builtin_amdgcn_s_sleep(127); __builtin_amdgcn_s_sleep(127); }
        for (int u = next_unit(QCTR(l, 2), &qsh); u < 1536 + 1536; u = next_unit(QCTR(l, 2), &qsh)) {
          if (u < 1024) attn_unit(p, e, u + 512, smem);
          else if (u < 1536) attn_unit(p, e, u - 1024, smem);
          else conv_unit(p, e, u - 1536);
        }
        GSYNC();
      }
    }
    gemm_phase<EPI_RES, 16>(p, l, (const bf16_t*)(p.ws + OFF_HY), DM, (const bf16_t*)(p.ws + OFF_WOUT), DM, 8, 0, smem);
    if (l < 3) GSYNC();
  }
}

extern "C" void kernel_launch(void* const* d_in, const int* in_sizes, int n_in, void* d_out, int out_size,
                              void* d_ws, size_t ws_size, hipStream_t stream) {
  static int grid_blocks = 0;
  if (!grid_blocks) {
    int dev = 0, cus = 0, per_cu = 0;
    hipGetDevice(&dev);
    hipDeviceGetAttribute(&cus, hipDeviceAttributeMultiprocessorCount, dev);
    hipOccupancyMaxActiveBlocksPerMultiprocessor(&per_cu, fwd_megakernel, 256, 0);
    if (per_cu > 2) per_cu = 2;
    if (per_cu < 1) per_cu = 1;
    grid_blocks = cus * per_cu;
  }
  if (ws_size < WS_NEED || n_in < 34) { fprintf(stderr, "workspace too small\n"); return; }
  Params p{};
  for (int i = 0; i < 34; ++i) p.in[i] = (const float*)d_in[i];
  p.out = (float*)d_out;
  p.ws = (char*)d_ws;
  (void)hipMemsetAsync((char*)d_ws + OFF_BAR, 0, 16384, stream);
  void* args[] = {&p};
  hipError_t err = hipLaunchCooperativeKernel((void*)fwd_megakernel, dim3(grid_blocks), dim3(256), args, 0, stream);
  if (err != hipSuccess) fprintf(stderr, "cooperative launch failed: %s (grid %d)\n", hipGetErrorString(err), grid_blocks);
}
```

```cpp
#include <hip/hip_runtime.h>
#include <hip/hip_cooperative_groups.h>
#include <cstdio>
namespace cg = cooperative_groups;

typedef unsigned short bf16_t;
using bf16x8 = __attribute__((ext_vector_type(8))) short;
using s16x4  = __attribute__((ext_vector_type(4))) short;
using f32x16 = __attribute__((ext_vector_type(16))) float;
#define DI __device__ __forceinline__

#define NTOK    24576
#define NTOK_P  8192
#define DM      1024
#define LDP_E   2688
#define LDP_O   3328
#define EPSF    1e-6f

#define PE_Q   0
#define PE_K   256
#define PE_V   512
#define PE_ZG  1024
#define PE_U   1536
#define PE_ZS  2048
#define PE_LF  2560
#define PO_Q   0
#define PO_K   512
#define PO_V   640
#define PO_ZA  768
#define PO_XC  1280
#define PO_BG  1792
#define PO_CG  2304
#define PO_ZC  2816

#define OUT_GLA  25165824
#define OUT_S5R  29360128
#define OUT_S5I  29622272
#define OUT_CK   29884416
#define OUT_CV   31981568

#define OFF_WIN   0ull
#define OFF_WOUT  6815744ull
#define OFF_WGLU  8912896ull
#define OFF_MOD   9437184ull
#define OFF_LB    9682944ull
#define OFF_LB256 (OFF_LB + 65536ull)
#define OFF_BBT   (OFF_LB256 + 65536ull)
#define OFF_CM    (OFF_BBT + 524288ull)
#define OFF_ROPE  (OFF_CM + 524288ull)
#define OFF_S5ES  (OFF_ROPE + 8192ull)
#define OFF_GLAL  (OFF_S5ES + 2097152ull)
#define OFF_GLAD  (OFF_GLAL + 16777216ull)
#define OFF_HY    (OFF_GLAD + 131072ull)
#define OFF_P     (OFF_HY + 50331648ull)
#define OFF_Z5    (OFF_P + 132120576ull)
#define OFF_BAR   (OFF_P + 163577856ull)
#define WS_NEED   (OFF_BAR + 16384ull)

#define SMEM_BYTES 80896

struct Params {
  const float* in[34];
  float* out;
  char* ws;
};

enum { I_XP = 0, I_XS, I_C, I_SGLA, I_S5R, I_S5I, I_CK, I_CV, I_CCTX, I_NORMW, I_WADA, I_BADA, I_WINE, I_WOUTE,
       I_GW2, I_GB2, I_GON, I_LAMR, I_LAMI, I_LOGDT, I_BRE, I_BIM, I_CRE, I_CIM, I_S5D, I_WGLU, I_BGLU,
       I_WINO, I_WOUTO, I_QNW, I_KNW, I_SINK, I_CONVW, I_CONVB };

DI int otid() { int t = threadIdx.x; asm volatile("" : "+v"(t)); return t; }
typedef __bf16 hbf16x2 __attribute__((ext_vector_type(2)));
typedef float hf32x2 __attribute__((ext_vector_type(2)));
DI unsigned pack2(float a, float b) { hf32x2 v = {a, b}; return __builtin_bit_cast(unsigned, __builtin_convertvector(v, hbf16x2)); }
DI bf16_t f2bf(float x) { return (bf16_t)(pack2(x, x) & 0xffffu); }
DI float bf2f(bf16_t b) { return __uint_as_float(((unsigned)b) << 16); }
DI float siluf(float x) { return x * __builtin_amdgcn_rcpf(1.f + __expf(-x)); }
DI float sigmf(float x) { return __builtin_amdgcn_rcpf(1.f + __expf(-x)); }
DI int crow(int q, int h) { return (q & 3) + 8 * (q >> 2) + 4 * h; }
DI f32x16 mfma(bf16x8 a, bf16x8 b, f32x16 c) { return __builtin_amdgcn_mfma_f32_32x32x16_bf16(a, b, c, 0, 0, 0); }
DI f32x16 zero16() { f32x16 z; for (int i = 0; i < 16; ++i) z[i] = 0.f; return z; }

template <int K>
DI void mma_tile(f32x16& acc, const bf16_t* A, int lda, const bf16_t* Bt, int ldb, int lane) {
  const int r = lane & 31, h = lane >> 5;
#pragma unroll
  for (int s = 0; s < K / 16; ++s) {
    bf16x8 a = *(const bf16x8*)(A + r * lda + s * 16 + h * 8);
    bf16x8 b = *(const bf16x8*)(Bt + r * ldb + s * 16 + h * 8);
    acc = mfma(a, b, acc);
  }
}

#define XB_TMO      128
#define XB_XCNT(j)  (256  + 64 * (j))
#define XB_XSUB(j)  (1280 + 64 * (j))
#define XB_XGEN(j)  (2304 + 64 * (j))
#define XB_TOP      3328
#define XB_TOPGEN   3392
#define XCD_BAR_WORDS 3456
#define XB_SPIN_CAP (1u << 18)
#define LAS __attribute__((address_space(3)))

__device__ __forceinline__ unsigned xb_ld(unsigned* p)              { return __hip_atomic_load(p, __ATOMIC_RELAXED, __HIP_MEMORY_SCOPE_AGENT); }
__device__ __forceinline__ unsigned xb_add(unsigned* p, unsigned v) { return __hip_atomic_fetch_add(p, v, __ATOMIC_RELAXED, __HIP_MEMORY_SCOPE_AGENT); }
__device__ __forceinline__ unsigned xb_xcc_id() { return (unsigned)__builtin_amdgcn_s_getreg((3 << 11) | 20) & 0xFu; }
#define XB_SPIN(cond, bar) do { unsigned _sp = 0; while (cond) { __builtin_amdgcn_s_sleep(1); \
    if ((++_sp & 255u) == 0u) { if (xb_ld(&(bar)[XB_TMO])) break; if (_sp > XB_SPIN_CAP) { atomicAdd(&(bar)[XB_TMO], 1u); break; } } } } while (0)

struct XcdBarrier {
    unsigned* bar; unsigned x;
    volatile LAS unsigned* st;
};

__device__ __forceinline__ XcdBarrier xcd_barrier_post(unsigned* bar, volatile LAS unsigned* st) {
    XcdBarrier b; b.bar = bar; b.x = xb_xcc_id(); b.st = st;
    if (threadIdx.x == 0) (void)xb_add(&bar[XB_XCNT(b.x)], 1u);
    return b;
}
__device__ __forceinline__ void xcd_barrier_complete(unsigned* bar, unsigned x, unsigned& nloc, unsigned& nx) {
    const unsigned G = gridDim.x * gridDim.y * gridDim.z;
    unsigned sum, cnt, mine, sp = 0u;
    for (;;) {
        sum = 0u; cnt = 0u; mine = 0u;
#pragma unroll
        for (unsigned j = 0; j < 16; ++j) { const unsigned c = xb_ld(&bar[XB_XCNT(j)]); sum += c; cnt += (c > 0u) ? 1u : 0u; mine = (j == x) ? c : mine; }
        if (sum == G) break;
        __builtin_amdgcn_s_sleep(1);
        if ((++sp & 255u) == 0u) { if (xb_ld(&bar[XB_TMO])) break; if (sp > XB_SPIN_CAP) { atomicAdd(&bar[XB_TMO], 1u); break; } }
    }
    nloc = mine > 0u ? mine : 1u; nx = cnt > 0u ? cnt : 1u;
}

__device__ __forceinline__ void xcd_barrier(const XcdBarrier& b) {
    asm volatile("s_waitcnt vmcnt(0)" ::: "memory");
    __syncthreads();
    if (threadIdx.x == 0) {
        unsigned* bar = b.bar;
        __builtin_amdgcn_s_waitcnt(0);
        unsigned nloc = b.st[0], nx = b.st[1];
        if (nloc == 0u) { xcd_barrier_complete(bar, b.x, nloc, nx); b.st[0] = nloc; b.st[1] = nx; }
        const unsigned old = xb_add(&bar[XB_XSUB(b.x)], 1u);
        const unsigned gen = old / nloc;
        if (old + 1u == (gen + 1u) * nloc) {
            __builtin_amdgcn_fence(__ATOMIC_RELEASE, "agent");
            asm volatile("s_waitcnt vmcnt(0)" ::: "memory");
            const unsigned og = xb_add(&bar[XB_TOP], 1u);
            const unsigned tg = og / nx;
            if (og + 1u == (tg + 1u) * nx) xb_add(&bar[XB_TOPGEN], 1u);
            else XB_SPIN(xb_ld(&bar[XB_TOPGEN]) == tg, bar);
            __builtin_amdgcn_fence(__ATOMIC_ACQUIRE, "agent");
            xb_add(&bar[XB_XGEN(b.x)], 1u);
            asm volatile("s_waitcnt vmcnt(0)" ::: "memory");
        } else {
            XB_SPIN(xb_ld(&bar[XB_XGEN(b.x)]) == gen, bar);
            __builtin_amdgcn_fence(__ATOMIC_ACQUIRE, "agent");
            asm volatile("s_waitcnt vmcnt(0)" ::: "memory");
        }
    }
    __syncthreads();
}


DI void phase0(const Params& p, char* smem) {
  const int tid = otid();
  float* sc = (float*)smem;
  float* red = sc + 5 * 1024;
  float* MOD = (float*)(p.ws + OFF_MOD);
  const int NU = 384 + 128 + 1;
  for (int u = blockIdx.x; u < NU; u += gridDim.x) {
    if (u < 384) {
      const int l = u / 96, nc = u % 96;
      __syncthreads();
      for (int i = tid; i < 5 * 1024; i += 256) {
        int j = i >> 10, k = i & 1023;
        float v = (j == 0) ? p.in[I_CCTX][k] : p.in[I_C][(j - 1) * 1024 + k];
        sc[i] = v / (1.f + expf(-v));
      }
      __syncthreads();
      const int col = tid & 31, kg = tid >> 5;
      const float* w = p.in[I_WADA] + (size_t)l * 1024 * 3072 + nc * 32 + col;
      float a0 = 0, a1 = 0, a2 = 0, a3 = 0, a4 = 0;
#pragma unroll 16
      for (int k = kg; k < 1024; k += 8) {
        float wv = w[(size_t)k * 3072];
        a0 += sc[k] * wv; a1 += sc[1024 + k] * wv; a2 += sc[2048 + k] * wv; a3 += sc[3072 + k] * wv; a4 += sc[4096 + k] * wv;
      }
      red[(kg * 5 + 0) * 32 + col] = a0; red[(kg * 5 + 1) * 32 + col] = a1; red[(kg * 5 + 2) * 32 + col] = a2;
      red[(kg * 5 + 3) * 32 + col] = a3; red[(kg * 5 + 4) * 32 + col] = a4;
      __syncthreads();
      if (tid < 160) {
        int j = tid >> 5, c2 = tid & 31;
        float s = 0;
        for (int g = 0; g < 8; ++g) s += red[(g * 5 + j) * 32 + c2];
        int n = nc * 32 + c2;
        MOD[(l * 5 + j) * 3072 + n] = s + p.in[I_BADA][l * 3072 + n];
      }
    } else if (u < 384 + 128) {
      const int v = u - 384;
      const int e = v >> 6, dir = (v >> 5) & 1, g = v & 31;
      if (tid < 64) {
        const int pp = tid;
        const int idx = ((e * 2 + dir) * 32 + g) * 64 + pp;
        double dt = exp((double)p.in[I_LOGDT][(e * 2 + dir) * 32 + g]);
        double lr = (double)p.in[I_LAMR][idx], li = (double)p.in[I_LAMI][idx];
        double mag = exp(lr * dt);
        double ang = li * dt;
        double tw = 6.283185307179586476925286766559;
        double kq = rint(ang / tw);
        double ra = ang - kq * tw;
        double lbr = mag * cos(ra), lbi = mag * sin(ra);
        double den = lr * lr + li * li;
        double nr = lbr - 1.0, ni = lbi;
        double cr = (nr * lr + ni * li) / den, ci = (ni * lr - nr * li) / den;
        float* LB = (float*)(p.ws + OFF_LB);
        float* LB256 = (float*)(p.ws + OFF_LB256);
        LB[idx * 2] = (float)lbr; LB[idx * 2 + 1] = (float)lbi;
        double pr = lbr, pi = lbi;
        for (int i = 0; i < 8; ++i) { double t = pr * pr - pi * pi; pi = 2.0 * pr * pi; pr = t; }
        LB256[idx * 2] = (float)pr; LB256[idx * 2 + 1] = (float)pi;
        bf16_t* BBT = (bf16_t*)(p.ws + OFF_BBT) + (size_t)((e * 2 + dir) * 32 + g) * 128 * 16;
        const float* bre = p.in[I_BRE] + ((size_t)(e * 32 + g) * 64 + pp) * 16;
        const float* bim = p.in[I_BIM] + ((size_t)(e * 32 + g) * 64 + pp) * 16;
        for (int hh = 0; hh < 16; ++hh) {
          double br = bre[hh], bi = bim[hh];
          const int nre = (pp >> 5) * 64 + (pp & 31);
          BBT[nre * 16 + hh] = f2bf((float)(cr * br - ci * bi));
          BBT[(nre + 32) * 16 + hh] = f2bf((float)(cr * bi + ci * br));
        }
        if (dir == 0) {
          bf16_t* CM = (bf16_t*)(p.ws + OFF_CM) + (size_t)(e * 32 + g) * 32 * 128;
          for (int hh = 0; hh < 32; ++hh) {
            float cre = 0.f, cim = 0.f;
            if (hh < 16) {
              cre = p.in[I_CRE][((size_t)(e * 32 + g) * 16 + hh) * 64 + pp];
              cim = p.in[I_CIM][((size_t)(e * 32 + g) * 16 + hh) * 64 + pp];
            }
            CM[hh * 128 + 2 * pp] = f2bf(cre);
            CM[hh * 128 + 2 * pp + 1] = f2bf(-cim);
          }
        }
      }
    } else {
      float* RT = (float*)(p.ws + OFF_ROPE);
      for (int i = tid; i < 64 * 16; i += 256) {
        int pos = i >> 4, f = i & 15;
        double fr = exp(-(double)f / 16.0 * 9.2103403719761827360719658187375);
        double ang = (double)pos * fr;
        double tw = 6.283185307179586476925286766559;
        double ra = ang - rint(ang / tw) * tw;
        RT[i * 2] = (float)cos(ra); RT[i * 2 + 1] = (float)sin(ra);
      }
    }
  }
}

DI void convert_tile(const float* src, int nsrc, bf16_t* dst, int K, int n0, int k0, int mapmode, int tid) {
  const int n = n0 + (tid & 63), kq = tid >> 6;
  int sc = n;
  if (mapmode == 1) {
    if (n < 1024) sc = n;
    else if (n < 2560) sc = n + 32;
    else if (n < 2592) sc = n - 1536;
    else sc = -1;
  }
  unsigned w[8];
#pragma unroll
  for (int i = 0; i < 8; ++i) {
    int k = k0 + kq * 16 + 2 * i;
    float a = 0.f, b = 0.f;
    if (sc >= 0) { a = src[(size_t)k * nsrc + sc]; b = src[(size_t)(k + 1) * nsrc + sc]; }
    w[i] = pack2(a, b);
  }
  uint4* d = (uint4*)(dst + (size_t)n * K + k0 + kq * 16);
  d[0] = make_uint4(w[0], w[1], w[2], w[3]);
  d[1] = make_uint4(w[4], w[5], w[6], w[7]);
}

DI void phaseA(const Params& p, int l) {
  const int tid = otid();
  const int odd = l & 1, e = l >> 1;
  const int n_in = (odd ? 52 : 42) * 16;
  const int n_out = 256;
  const int n_glu = odd ? 0 : 64;
  const int n_norm = NTOK / 16;
  const int total = n_in + n_out + n_glu + n_norm;
  bf16_t* WIN = (bf16_t*)(p.ws + OFF_WIN);
  bf16_t* WOUT = (bf16_t*)(p.ws + OFF_WOUT);
  bf16_t* WGLU = (bf16_t*)(p.ws + OFF_WGLU);
  bf16_t* H = (bf16_t*)(p.ws + OFF_HY);
  const float* MOD = (const float*)(p.ws + OFF_MOD);
  for (int u = blockIdx.x; u < total; u += gridDim.x) {
    if (u < n_in) {
      int nt = u >> 4, kt = u & 15;
      if (odd) convert_tile(p.in[I_WINO] + (size_t)e * 1024 * 3328, 3328, WIN, 1024, nt * 64, kt * 64, 0, tid);
      else convert_tile(p.in[I_WINE] + (size_t)e * 1024 * 2592, 2592, WIN, 1024, nt * 64, kt * 64, 1, tid);
    } else if (u < n_in + n_out) {
      int v = u - n_in; int nt = v >> 4, kt = v & 15;
      const float* src = (odd ? p.in[I_WOUTO] : p.in[I_WOUTE]) + (size_t)e * 1024 * 1024;
      convert_tile(src, 1024, WOUT, 1024, nt * 64, kt * 64, 0, tid);
    } else if (u < n_in + n_out + n_glu) {
      int v = u - n_in - n_out; int nt = v >> 3, kt = v & 7;
      convert_tile(p.in[I_WGLU] + (size_t)e * 512 * 512, 512, WGLU, 512, nt * 64, kt * 64, 0, tid);
    } else {
      int v = u - n_in - n_out - n_glu;
      const int tok0 = v * 16 + (tid >> 6) * 4;
      const int lane = tid & 63;
      const float* x;
      if (l == 0) x = (tok0 < NTOK_P) ? p.in[I_XP] + (size_t)tok0 * DM : p.in[I_XS] + (size_t)(tok0 - NTOK_P) * DM;
      else x = p.out + (size_t)tok0 * DM;
      const int j = (tok0 < NTOK_P) ? 0 : 1 + ((tok0 - NTOK_P) >> 12);
      const float* mod = MOD + (l * 5 + j) * 3072;
      const float* nw = p.in[I_NORMW] + l * 1024;
      float4 xv[4][4];
#pragma unroll
      for (int rr = 0; rr < 4; ++rr)
#pragma unroll
        for (int i = 0; i < 4; ++i) {
          typedef float nt_f4 __attribute__((ext_vector_type(4)));
          nt_f4 t_ = __builtin_nontemporal_load((const nt_f4*)(x + (size_t)rr * DM + lane * 4 + 256 * i));
          xv[rr][i] = make_float4(t_[0], t_[1], t_[2], t_[3]);
        }
      float rstd[4];
#pragma unroll
      for (int rr = 0; rr < 4; ++rr) {
        float ss = 0.f;
#pragma unroll
        for (int i = 0; i < 4; ++i) ss += xv[rr][i].x * xv[rr][i].x + xv[rr][i].y * xv[rr][i].y + xv[rr][i].z * xv[rr][i].z + xv[rr][i].w * xv[rr][i].w;
#pragma unroll
        for (int o = 32; o >= 1; o >>= 1) ss += __shfl_xor(ss, o);
        rstd[rr] = rsqrtf(ss * (1.f / 1024.f) + EPSF);
      }
#pragma unroll
      for (int i = 0; i < 4; ++i) {
        const int k = lane * 4 + 256 * i;
        float4 w4 = *(const float4*)(nw + k);
        float4 sh = *(const float4*)(mod + k);
        float4 scl = *(const float4*)(mod + 1024 + k);
        const float c0 = w4.x * (1.f + scl.x), c1 = w4.y * (1.f + scl.y), c2 = w4.z * (1.f + scl.z), c3 = w4.w * (1.f + scl.w);
#pragma unroll
        for (int rr = 0; rr < 4; ++rr) {
          float h0 = xv[rr][i].x * rstd[rr] * c0 + sh.x;
          float h1 = xv[rr][i].y * rstd[rr] * c1 + sh.y;
          float h2 = xv[rr][i].z * rstd[rr] * c2 + sh.z;
          float h3 = xv[rr][i].w * rstd[rr] * c3 + sh.w;
          *(uint2*)(H + (size_t)(tok0 + rr) * DM + k) = make_uint2(pack2(h0, h1), pack2(h2, h3));
        }
      }
    }
  }
}

#define GLD 72
enum { EPI_P = 0, EPI_RES = 1, EPI_GLU = 2 };

template <int EPI, int KT>
DI void gemm_phase(const Params& p, int l, const bf16_t* A, int lda, const bf16_t* Bt, int ldb,
                           int NT, int ldp, char* smem) {
  const int tid = otid(), lane = tid & 63, w = tid >> 6;
  const int r = lane & 31, h = lane >> 5;
  const int wm = w >> 1, wn = w & 1;
  bf16_t* As = (bf16_t*)smem;
  bf16_t* Bs = As + 2 * 128 * GLD;
  const int lr = tid >> 3, lc = (tid & 7) * 8;
  const int MT = NTOK / 128;
  const int total = MT * NT;
  const float* MOD = (const float*)(p.ws + OFF_MOD);
  const int nslot = gridDim.x >> 3;
  if (blockIdx.x >= (gridDim.x >> 1)) { __builtin_amdgcn_s_sleep(56); }
  for (int k = 0;; ++k) {
    const int t = ((blockIdx.x & 7) + 8 * k) * nslot + (blockIdx.x >> 3);
    if (t >= total) break;
    const int band = t / (8 * NT), rem = t - band * 8 * NT;
    const int nt = rem >> 3, mt = band * 8 + (rem & 7);
    const int m0 = mt * 128, n0 = nt * 128;
    const bf16_t* Ag = A + (size_t)(m0 + lr) * lda + lc;
    const bf16_t* Bg = Bt + (size_t)(n0 + lr) * ldb + lc;
    uint4 xa0, xa1, xa2, xa3, xb0, xb1, xb2, xb3;
    uint4 ya0, ya1, ya2, ya3, yb0, yb1, yb2, yb3;
#define GLOADS(S, KOFS) \
    S##a0 = *(const uint4*)(Ag + (KOFS)); S##a1 = *(const uint4*)(Ag + (size_t)32 * lda + (KOFS)); \
    S##a2 = *(const uint4*)(Ag + (size_t)64 * lda + (KOFS)); S##a3 = *(const uint4*)(Ag + (size_t)96 * lda + (KOFS)); \
    S##b0 = *(const uint4*)(Bg + (KOFS)); S##b1 = *(const uint4*)(Bg + (size_t)32 * ldb + (KOFS)); \
    S##b2 = *(const uint4*)(Bg + (size_t)64 * ldb + (KOFS)); S##b3 = *(const uint4*)(Bg + (size_t)96 * ldb + (KOFS));
#define LSTORES(S, ST) \
    *(uint4*)(As + (ST) * 128 * GLD + (lr) * GLD + lc) = S##a0; *(uint4*)(As + (ST) * 128 * GLD + (lr + 32) * GLD + lc) = S##a1; \
    *(uint4*)(As + (ST) * 128 * GLD + (lr + 64) * GLD + lc) = S##a2; *(uint4*)(As + (ST) * 128 * GLD + (lr + 96) * GLD + lc) = S##a3; \
    *(uint4*)(Bs + (ST) * 128 * GLD + (lr) * GLD + lc) = S##b0; *(uint4*)(Bs + (ST) * 128 * GLD + (lr + 32) * GLD + lc) = S##b1; \
    *(uint4*)(Bs + (ST) * 128 * GLD + (lr + 64) * GLD + lc) = S##b2; *(uint4*)(Bs + (ST) * 128 * GLD + (lr + 96) * GLD + lc) = S##b3;
    bf16x8 fa0[4], fa1[4], fb0[4], fb1[4];
#define FRAGS(ST) { \
      const bf16_t* as = As + (ST) * 128 * GLD + (wm * 64 + r) * GLD + h * 8; \
      const bf16_t* bs = Bs + (ST) * 128 * GLD + (wn * 64 + r) * GLD + h * 8; \
      _Pragma("unroll") for (int s = 0; s < 4; ++s) { \
        fa0[s] = *(const bf16x8*)(as + s * 16); \
        fb0[s] = *(const bf16x8*)(bs + s * 16); \
        fa1[s] = *(const bf16x8*)(as + 32 * GLD + s * 16); \
        fb1[s] = *(const bf16x8*)(bs + 32 * GLD + s * 16); \
      } \
      __builtin_amdgcn_sched_barrier(0); }
#define MFMAS() { \
      _Pragma("unroll") for (int s = 0; s < 4; ++s) { \
        acc00 = mfma(fa0[s], fb0[s], acc00); acc01 = mfma(fa0[s], fb1[s], acc01); \
        acc10 = mfma(fa1[s], fb0[s], acc10); acc11 = mfma(fa1[s], fb1[s], acc11); \
      } \
      _Pragma("unroll") for (int g = 0; g < 8; ++g) { \
        __builtin_amdgcn_sched_group_barrier(0x008, 2, 0); \
        __builtin_amdgcn_sched_group_barrier(0x200, 1, 0); \
        __builtin_amdgcn_sched_group_barrier(0x020, 1, 0); \
      } }
    GLOADS(x, 0)
    LSTORES(x, 0)
    GLOADS(x, 64)
    GLOADS(y, 128)
    __syncthreads();
    f32x16 acc00 = zero16(), acc01 = zero16(), acc10 = zero16(), acc11 = zero16();
#pragma unroll
    for (int kt = 0; kt < KT; kt += 2) {
      FRAGS(0)
      LSTORES(x, 1)
      if (kt + 3 < KT) { GLOADS(x, (kt + 3) * 64) }
      MFMAS()
      __syncthreads();
      __builtin_amdgcn_sched_barrier(0);
      FRAGS(1)
      if (kt + 2 < KT) { LSTORES(y, 0) }
      if (kt + 4 < KT) { GLOADS(y, (kt + 4) * 64) }
      MFMAS()
      __syncthreads();
      __builtin_amdgcn_sched_barrier(0);
    }
#undef FRAGS
#undef MFMAS
#undef GLOADS
#undef LSTORES
    {
      float* Cs = (float*)smem;
      const int er = tid >> 4, ec = (tid & 15) * 8;
      const int jm = (m0 < NTOK_P) ? 0 : 1 + ((m0 - NTOK_P) >> 12);
      float4 px[8][2];
      uint4 pz[8][2];
      if (EPI == EPI_RES) {
        const float* xsrc;
        if (l == 0) xsrc = (m0 < NTOK_P) ? p.in[I_XP] : p.in[I_XS] - (size_t)NTOK_P * DM;
        else xsrc = p.out;
#pragma unroll
        for (int ps = 0; ps < 8; ++ps) {
          const float* xp_ = xsrc + (size_t)(m0 + ps * 16 + er) * DM + n0 + ec;
          px[ps][0] = *(const float4*)xp_; px[ps][1] = *(const float4*)(xp_ + 4);
        }
      } else if (EPI == EPI_GLU) {
        const bf16_t* Pz = (const bf16_t*)(p.ws + OFF_P);
        const bf16_t* Z5z = (const bf16_t*)(p.ws + OFF_Z5);
#pragma unroll
        for (int ps = 0; ps < 8; ++ps) {
          const size_t gr = (size_t)(m0 + ps * 16 + er);
          pz[ps][0] = *(const uint4*)(Z5z + gr * 512 + n0 + ec);
          pz[ps][1] = *(const uint4*)(Pz + gr * LDP_E + PE_ZS + n0 + ec);
        }
      }
#pragma unroll
      for (int q = 0; q < 16; ++q) {
        const int rr = wm * 64 + crow(q, h), cc = wn * 64 + r;
        Cs[rr * 132 + cc] = acc00[q];
        Cs[rr * 132 + cc + 32] = acc01[q];
        Cs[(rr + 32) * 132 + cc] = acc10[q];
        Cs[(rr + 32) * 132 + cc + 32] = acc11[q];
      }
      __syncthreads();
#pragma unroll
      for (int ps = 0; ps < 8; ++ps) {
        const int row = ps * 16 + er;
        const float4 c0 = *(const float4*)(Cs + row * 132 + ec);
        const float4 c1 = *(const float4*)(Cs + row * 132 + ec + 4);
        const size_t grow = (size_t)(m0 + row);
        const int gcol = n0 + ec;
        if (EPI == EPI_P) {
          bf16_t* P = (bf16_t*)(p.ws + OFF_P);
          *(uint4*)(P + grow * ldp + gcol) = make_uint4(pack2(c0.x, c0.y), pack2(c0.z, c0.w), pack2(c1.x, c1.y), pack2(c1.z, c1.w));
        } else if (EPI == EPI_RES) {
          const float* gate = MOD + (l * 5 + jm) * 3072 + 2048 + gcol;
          const float4 g0 = *(const float4*)gate, g1 = *(const float4*)(gate + 4);
          const float4 x0 = px[ps][0], x1 = px[ps][1];
          float4 o0, o1;
          o0.x = x0.x + g0.x * c0.x; o0.y = x0.y + g0.y * c0.y; o0.z = x0.z + g0.z * c0.z; o0.w = x0.w + g0.w * c0.w;
          o1.x = x1.x + g1.x * c1.x; o1.y = x1.y + g1.y * c1.y; o1.z = x1.z + g1.z * c1.z; o1.w = x1.w + g1.w * c1.w;
          *(float4*)(p.out + grow * DM + gcol) = o0;
          *(float4*)(p.out + grow * DM + gcol + 4) = o1;
        } else {
          const bf16_t* P = (const bf16_t*)(p.ws + OFF_P);
          const bf16_t* Z5 = (const bf16_t*)(p.ws + OFF_Z5);
          bf16_t* Y = (bf16_t*)(p.ws + OFF_HY);
          const float* bglu = p.in[I_BGLU] + (l >> 1) * 512 + gcol;
          const float4 b0 = *(const float4*)bglu, b1 = *(const float4*)(bglu + 4);
          const uint4 zv = pz[ps][0];
          const uint4 zs = pz[ps][1];
#define GLU1(ZW, SW, CA, CB, BA, BB) pack2(__uint_as_float((ZW) << 16) * sigmf((CA) + (BA)) * siluf(__uint_as_float((SW) << 16)), \
                                           __uint_as_float((ZW) & 0xffff0000u) * sigmf((CB) + (BB)) * siluf(__uint_as_float((SW) & 0xffff0000u)))
          uint4 o;
          o.x = GLU1(zv.x, zs.x, c0.x, c0.y, b0.x, b0.y);
          o.y = GLU1(zv.y, zs.y, c0.z, c0.w, b0.z, b0.w);
          o.z = GLU1(zv.z, zs.z, c1.x, c1.y, b1.x, b1.y);
          o.w = GLU1(zv.w, zs.w, c1.z, c1.w, b1.z, b1.w);
#undef GLU1
          *(uint4*)(Y + grow * DM + 512 + gcol) = o;
        }
      }
      __syncthreads();
    }
  }
}

#define GL 72
struct GlaSmem {
  bf16_t Qd[64 * GL];
  bf16_t Kn[64 * GL];
  bf16_t KdT[64 * GL];
  bf16_t Att[64 * GL];
  bf16_t VT[128 * GL];
  bf16_t ST[128 * GL];
  float lfS[64 * 16];
  float qtot[4 * 64];
  float Dl[64];
  float Gtot[64];
};
#define OLD 132
static_assert(sizeof(GlaSmem) <= SMEM_BYTES, "GLA smem");

template <bool FULL>
DI void gla_sweep(const Params& p, int e, int hd, int dir, int tok0, f32x16 (&sacc)[2], GlaSmem& S) {
  const int tid = otid(), lane = tid & 63, w = tid >> 6;
  const int r = lane & 31, h = lane >> 5;
  const bf16_t* P = (const bf16_t*)(p.ws + OFF_P);
  bf16_t* Y = (bf16_t*)(p.ws + OFF_HY);
  const int tq = tid >> 6;
  if (tid < 64) S.Gtot[tid] = 0.f;
  unsigned w2p[8];
  float bias;
  {
    const int d0 = tid & 63;
#pragma unroll
    for (int i = 0; i < 8; ++i)
      w2p[i] = pack2(p.in[I_GW2][((size_t)(e * 2 + dir) * 16 + 2 * i) * 256 + hd * 64 + d0],
                     p.in[I_GW2][((size_t)(e * 2 + dir) * 16 + 2 * i + 1) * 256 + hd * 64 + d0]);
    bias = p.in[I_GB2][(e * 2 + dir) * 256 + hd * 64 + d0];
  }
  __syncthreads();
  if (FULL) {
#pragma unroll
    for (int ni = 0; ni < 2; ++ni)
#pragma unroll
      for (int q = 0; q < 16; ++q) S.ST[(w * 32 + crow(q, h)) * GL + ni * 32 + r] = f2bf(sacc[ni][q]);
  }
  uint4 pq0, pq1, pk0, pk1;
  bf16_t plf[4];
  pq0 = pq1 = pk0 = pk1 = make_uint4(0, 0, 0, 0);
  plf[0] = plf[1] = plf[2] = plf[3] = 0;
#pragma unroll 1
  for (int cc = 0; cc < 4; ++cc) {
    const int c = dir ? 3 - cc : cc;
    const int ct0 = tok0 + c * 64;
    const int tv = tid & 63, cgp = tid >> 6;
    uint4 v0, v1, v2, v3;
    {
      const bf16_t* vsrc = P + (size_t)(ct0 + tv) * LDP_E + PE_V + hd * 128 + cgp * 32;
      v0 = *(const uint4*)(vsrc); v1 = *(const uint4*)(vsrc + 8); v2 = *(const uint4*)(vsrc + 16); v3 = *(const uint4*)(vsrc + 24);
    }
    {
      const int row = tid >> 2, c8 = (tid & 3) * 16;
      if (cc == 0) {
        const bf16_t* src = P + (size_t)(ct0 + row) * LDP_E + hd * 64 + c8;
        pk0 = *(const uint4*)(src + PE_K); pk1 = *(const uint4*)(src + PE_K + 8);
        if (FULL) { pq0 = *(const uint4*)(src + PE_Q); pq1 = *(const uint4*)(src + PE_Q + 8); }
#pragma unroll
        for (int i = 0; i < 4; ++i) {
          int idx = tid + 256 * i; int t = idx >> 4, rr = idx & 15;
          plf[i] = P[(size_t)(ct0 + t) * LDP_E + PE_LF + dir * 16 + rr];
        }
      }
#pragma unroll
      for (int i = 0; i < 4; ++i) S.lfS[tid + 256 * i] = bf2f(plf[i]);
      *(uint4*)(S.Kn + row * GL + c8) = pk0; *(uint4*)(S.Kn + row * GL + c8 + 8) = pk1;
      if (FULL) { *(uint4*)(S.Qd + row * GL + c8) = pq0; *(uint4*)(S.Qd + row * GL + c8 + 8) = pq1; }
      if (cc < 3) {
        const int cn = dir ? 2 - cc : cc + 1;
        const int cn0 = tok0 + cn * 64;
        const bf16_t* src = P + (size_t)(cn0 + row) * LDP_E + hd * 64 + c8;
        pk0 = *(const uint4*)(src + PE_K); pk1 = *(const uint4*)(src + PE_K + 8);
        if (FULL) { pq0 = *(const uint4*)(src + PE_Q); pq1 = *(const uint4*)(src + PE_Q + 8); }
#pragma unroll
        for (int i = 0; i < 4; ++i) {
          int idx = tid + 256 * i; int t = idx >> 4, rr = idx & 15;
          plf[i] = P[(size_t)(cn0 + t) * LDP_E + PE_LF + dir * 16 + rr];
        }
      }
    }
    __syncthreads();
    const int d = tid & 63;
    float w2r[16];
#pragma unroll
    for (int i = 0; i < 8; ++i) { w2r[2 * i] = __uint_as_float(w2p[i] << 16); w2r[2 * i + 1] = __uint_as_float(w2p[i] & 0xffff0000u); }
    float g[16];
    float run = 0.f;
#pragma unroll
    for (int i = 0; i < 16; ++i) {
      int t = tq * 16 + i;
      float x = bias;
#pragma unroll
      for (int rr = 0; rr < 16; ++rr) x += S.lfS[t * 16 + rr] * w2r[rr];
      float ls = fminf(x, 0.f) - __logf(1.f + __expf(-fabsf(x)));
      g[i] = ls * (1.f / 16.f);
      run += g[i];
    }
    S.qtot[tq * 64 + d] = run;
    __syncthreads();
    float q0 = S.qtot[d], q1 = S.qtot[64 + d], q2 = S.qtot[128 + d], q3 = S.qtot[192 + d];
    const float total = q0 + q1 + q2 + q3;
    float off;
    if (dir == 0) off = (tq > 0 ? q0 : 0.f) + (tq > 1 ? q1 : 0.f) + (tq > 2 ? q2 : 0.f);
    else off = (tq < 1 ? q1 : 0.f) + (tq < 2 ? q2 : 0.f) + (tq < 3 ? q3 : 0.f);
    float b[16];
    if (dir == 0) {
      float a = off;
#pragma unroll
      for (int i = 0; i < 16; ++i) { a += g[i]; b[i] = a; }
    } else {
      float a = off;
#pragma unroll
      for (int i = 15; i >= 0; --i) { a += g[i]; b[i] = a; }
    }
    if (tq == 0) { S.Dl[d] = __expf(total); S.Gtot[d] += total; }
    {
      unsigned kd[8];
      float kprev = 0.f;
#pragma unroll
      for (int i = 0; i < 16; ++i) {
        int t = tq * 16 + i;
        float kv = bf2f(S.Kn[t * GL + d]);
        if (FULL) {
          float qv = bf2f(S.Qd[t * GL + d]);
          S.Qd[t * GL + d] = f2bf(qv * 0.125f * __expf(b[i]));
          S.Kn[t * GL + d] = f2bf(kv * __expf(-b[i]));
        }
        float kdv = kv * __expf(total - b[i]);
        if (i & 1) kd[i >> 1] = pack2(kprev, kdv); else kprev = kdv;
      }
      uint4* dst = (uint4*)(S.KdT + d * GL + tq * 16);
      dst[0] = make_uint4(kd[0], kd[1], kd[2], kd[3]);
      dst[1] = make_uint4(kd[4], kd[5], kd[6], kd[7]);
    }
    {
      bf16_t* vd = S.VT + (cgp * 32) * GL + tv;
#define VTW(VV, B) vd[((B) + 0) * GL] = (bf16_t)(VV.x & 0xffffu); vd[((B) + 1) * GL] = (bf16_t)(VV.x >> 16); \
                   vd[((B) + 2) * GL] = (bf16_t)(VV.y & 0xffffu); vd[((B) + 3) * GL] = (bf16_t)(VV.y >> 16); \
                   vd[((B) + 4) * GL] = (bf16_t)(VV.z & 0xffffu); vd[((B) + 5) * GL] = (bf16_t)(VV.z >> 16); \
                   vd[((B) + 6) * GL] = (bf16_t)(VV.w & 0xffffu); vd[((B) + 7) * GL] = (bf16_t)(VV.w >> 16);
      VTW(v0, 0) VTW(v1, 8) VTW(v2, 16) VTW(v3, 24)
#undef VTW
    }
    __syncthreads();
    const int mi = w >> 1;
    f32x16 oacc[2];
    bf16_t* orec = Y + (size_t)(ct0 + mi * 32 + h * 16 + (r >> 1)) * DM + hd * 128 + (w & 1) * 64 + (r & 1) * 16;
    uint4 of0 = make_uint4(0, 0, 0, 0), of1 = of0, of2 = of0, of3 = of0, zg0 = of0, zg1 = of0, zg2 = of0, zg3 = of0;
    if (FULL && dir) {
      of0 = *(const uint4*)(orec); of1 = *(const uint4*)(orec + 8);
      of2 = *(const uint4*)(orec + 32); of3 = *(const uint4*)(orec + 40);
      const bf16_t* zg = P + (size_t)(ct0 + (tid >> 2)) * LDP_E + PE_ZG + hd * 128 + (tid & 3) * 32;
      zg0 = *(const uint4*)(zg); zg1 = *(const uint4*)(zg + 8); zg2 = *(const uint4*)(zg + 16); zg3 = *(const uint4*)(zg + 24);
    }
    if (FULL) {
      const int ni = w & 1;
      const bool skip = dir ? (ni < mi) : (ni > mi);
      f32x16 a = zero16();
      if (!skip) mma_tile<64>(a, S.Qd + mi * 32 * GL, GL, S.Kn + ni * 32 * GL, GL, lane);
#pragma unroll
      for (int q = 0; q < 16; ++q) {
        int i = mi * 32 + crow(q, h), j = ni * 32 + r;
        bool keep = dir ? (j >= i) : (j <= i);
        S.Att[i * GL + j] = f2bf(keep ? a[q] : 0.f);
      }
#pragma unroll
      for (int jj = 0; jj < 2; ++jj) {
        int nj = (w & 1) * 2 + jj;
        oacc[jj] = zero16();
        mma_tile<64>(oacc[jj], S.Qd + mi * 32 * GL, GL, S.ST + nj * 32 * GL, GL, lane);
      }
      __syncthreads();
#pragma unroll
      for (int jj = 0; jj < 2; ++jj) {
        int nj = (w & 1) * 2 + jj;
        mma_tile<64>(oacc[jj], S.Att + mi * 32 * GL, GL, S.VT + nj * 32 * GL, GL, lane);
      }
    }
#pragma unroll
    for (int ni = 0; ni < 2; ++ni) {
      float dec = S.Dl[ni * 32 + r];
#pragma unroll
      for (int q = 0; q < 16; ++q) sacc[ni][q] *= dec;
      mma_tile<64>(sacc[ni], S.VT + w * 32 * GL, GL, S.KdT + ni * 32 * GL, GL, lane);
    }
    __syncthreads();
    if (FULL) {
#pragma unroll
      for (int ni = 0; ni < 2; ++ni)
#pragma unroll
        for (int q = 0; q < 16; ++q) S.ST[(w * 32 + crow(q, h)) * GL + ni * 32 + r] = f2bf(sacc[ni][q]);
      if (dir == 0) {
#pragma unroll
        for (int jj = 0; jj < 2; ++jj) {
          *(uint4*)(orec + jj * 32) = make_uint4(pack2(oacc[jj][0], oacc[jj][1]), pack2(oacc[jj][2], oacc[jj][3]), pack2(oacc[jj][4], oacc[jj][5]), pack2(oacc[jj][6], oacc[jj][7]));
          *(uint4*)(orec + jj * 32 + 8) = make_uint4(pack2(oacc[jj][8], oacc[jj][9]), pack2(oacc[jj][10], oacc[jj][11]), pack2(oacc[jj][12], oacc[jj][13]), pack2(oacc[jj][14], oacc[jj][15]));
        }
      } else {
        float* Ob = (float*)S.Qd;
        {
          const unsigned ofw[16] = {of0.x, of0.y, of0.z, of0.w, of1.x, of1.y, of1.z, of1.w, of2.x, of2.y, of2.z, of2.w, of3.x, of3.y, of3.z, of3.w};
#pragma unroll
          for (int jj = 0; jj < 2; ++jj) {
            int cl = ((w & 1) * 2 + jj) * 32 + r;
#pragma unroll
            for (int q = 0; q < 16; ++q) {
              int tl = mi * 32 + crow(q, h);
              const unsigned wv = ofw[jj * 8 + (q >> 1)];
              float prev = (q & 1) ? __uint_as_float(wv & 0xffff0000u) : __uint_as_float(wv << 16);
              Ob[tl * OLD + cl] = oacc[jj][q] + prev;
            }
          }
        }
        __syncthreads();
        {
          const int tl = tid >> 2, qtr = tid & 3;
          float ss = 0.f;
#pragma unroll
          for (int i = 0; i < 32; ++i) { float v = Ob[tl * OLD + qtr * 32 + i]; ss += v * v; }
          ss += __shfl_xor(ss, 1);
          ss += __shfl_xor(ss, 2);
          const float rstd = rsqrtf(ss * (1.f / 128.f) + EPSF);
          const float* onw = p.in[I_GON] + e * 128 + qtr * 32;
          bf16_t* yo = Y + (size_t)(ct0 + tl) * DM + hd * 128 + qtr * 32;
          const unsigned zgw[16] = {zg0.x, zg0.y, zg0.z, zg0.w, zg1.x, zg1.y, zg1.z, zg1.w, zg2.x, zg2.y, zg2.z, zg2.w, zg3.x, zg3.y, zg3.z, zg3.w};
#pragma unroll
          for (int i = 0; i < 32; i += 2) {
            unsigned zz = zgw[i >> 1];
            float y0 = Ob[tl * OLD + qtr * 32 + i] * rstd * onw[i] * siluf(__uint_as_float(zz << 16));
            float y1 = Ob[tl * OLD + qtr * 32 + i + 1] * rstd * onw[i + 1] * siluf(__uint_as_float(zz & 0xffff0000u));
            *(unsigned*)(yo + i) = pack2(y0, y1);
          }
        }
        __syncthreads();
      }
    }
  }
}

DI void gla_pass1_unit(const Params& p, int e, int u, char* smem) {
  GlaSmem& S = *(GlaSmem*)smem;
  const int tid = otid(), lane = tid & 63, w = tid >> 6;
  const int r = lane & 31, h = lane >> 5;
  const int seg = u >> 3, hd = (u >> 1) & 3, dir = u & 1;
  const int tok0 = NTOK_P + seg * 256;
  f32x16 sacc[2];
  sacc[0] = zero16(); sacc[1] = zero16();
  __syncthreads();
  gla_sweep<false>(p, e, hd, dir, tok0, sacc, S);
  float* L = (float*)(p.ws + OFF_GLAL) + (size_t)((seg * 4 + hd) * 2 + dir) * 8192;
#pragma unroll
  for (int ni = 0; ni < 2; ++ni)
#pragma unroll
    for (int q = 0; q < 16; ++q) L[(w * 32 + crow(q, h)) * 64 + ni * 32 + r] = sacc[ni][q];
  if (tid < 64) {
    float* D = (float*)(p.ws + OFF_GLAD) + ((seg * 4 + hd) * 2 + dir) * 64;
    D[tid] = expf(S.Gtot[tid]);
  }
  __syncthreads();
}

DI void gla_pass3_unit(const Params& p, int e, int u, char* smem) {
  GlaSmem& S = *(GlaSmem*)smem;
  const int tid = otid(), lane = tid & 63, w = tid >> 6;
  const int r = lane & 31, h = lane >> 5;
  const int seg = ((u >> 2) + 32) % 96, hd = u & 3;
  const int tok0 = seg * 256;
  const bool samp = seg >= 32;
  const int sb = samp ? (seg - 32) >> 4 : 0, sl = samp ? (seg - 32) & 15 : 0;
  const float* Lb = (const float*)(p.ws + OFF_GLAL);
  const float* Db = (const float*)(p.ws + OFF_GLAD);
  for (int dir = 0; dir < 2; ++dir) {
    f32x16 sacc[2];
    sacc[0] = zero16(); sacc[1] = zero16();
    if (samp) {
      const float* s0 = p.in[I_SGLA] + (size_t)(((sb * 2 + e) * 2 + dir) * 4 + hd) * 8192;
#pragma unroll
      for (int ni = 0; ni < 2; ++ni)
#pragma unroll
        for (int q = 0; q < 16; ++q) sacc[ni][q] = s0[(ni * 32 + r) * 128 + w * 32 + crow(q, h)];
      const int nst = dir ? 15 - sl : sl;
      float Lc[32], dc[2];
      {
        const int sp0 = dir ? 15 : 0;
        const int sidx0 = ((sb * 16 + sp0) * 4 + hd) * 2 + dir;
        const float* L0 = Lb + (size_t)sidx0 * 8192;
        const float* D0 = Db + sidx0 * 64;
#pragma unroll
        for (int ni = 0; ni < 2; ++ni) {
          dc[ni] = D0[ni * 32 + r];
#pragma unroll
          for (int q = 0; q < 16; ++q) Lc[ni * 16 + q] = L0[(w * 32 + crow(q, h)) * 64 + ni * 32 + r];
        }
      }
#pragma unroll 1
      for (int k = 0; k < nst; ++k) {
        float Ln[32], dn[2];
        const int kn = (k + 1 < nst) ? k + 1 : k;
        const int sp = dir ? 15 - kn : kn;
        const int sidx = ((sb * 16 + sp) * 4 + hd) * 2 + dir;
        const float* L = Lb + (size_t)sidx * 8192;
        const float* D = Db + sidx * 64;
#pragma unroll
        for (int ni = 0; ni < 2; ++ni) {
          dn[ni] = D[ni * 32 + r];
#pragma unroll
          for (int q = 0; q < 16; ++q) Ln[ni * 16 + q] = L[(w * 32 + crow(q, h)) * 64 + ni * 32 + r];
        }
#pragma unroll
        for (int ni = 0; ni < 2; ++ni)
#pragma unroll
          for (int q = 0; q < 16; ++q) sacc[ni][q] = sacc[ni][q] * dc[ni] + Lc[ni * 16 + q];
#pragma unroll
        for (int i = 0; i < 32; ++i) Lc[i] = Ln[i];
        dc[0] = dn[0]; dc[1] = dn[1];
      }
    }
    __syncthreads();
    gla_sweep<true>(p, e, hd, dir, tok0, sacc, S);
    if (!samp) {
      float* o = p.out + OUT_GLA + (size_t)(((seg * 2 + e) * 2 + dir) * 4 + hd) * 8192;
#pragma unroll
      for (int ni = 0; ni < 2; ++ni)
#pragma unroll
        for (int q = 0; q < 16; ++q) o[(ni * 32 + r) * 128 + w * 32 + crow(q, h)] = sacc[ni][q];
    }
    __syncthreads();
  }
}

#define XLD 136
#define WSYNC() do { __builtin_amdgcn_fence(__ATOMIC_RELEASE, "wavefront"); __builtin_amdgcn_wave_barrier(); __builtin_amdgcn_fence(__ATOMIC_ACQUIRE, "wavefront"); } while (0)
DI void s5_sweep(const Params& p, int e, int g, int dir, int mode, int tok0, float& hr, float& hi, bf16_t* X) {
  const int lane = otid() & 63;
  const int r = lane & 31, h = lane >> 5;
  const bf16_t* P = (const bf16_t*)(p.ws + OFF_P);
  bf16_t* Z5 = (bf16_t*)(p.ws + OFF_Z5);
  bf16_t* Yb = (bf16_t*)(p.ws + OFF_HY);
  const float* LB = (const float*)(p.ws + OFF_LB) + (size_t)(((e * 2 + dir) * 32 + g) * 64 + lane) * 2;
  const float lbr = LB[0], lbi = LB[1];
  const bf16_t* BBT = (const bf16_t*)(p.ws + OFF_BBT) + (size_t)((e * 2 + dir) * 32 + g) * 128 * 16;
  const bf16_t* CM = (const bf16_t*)(p.ws + OFF_CM) + (size_t)(e * 32 + g) * 32 * 128;
  bf16x8 bfr[4];
#pragma unroll
  for (int j = 0; j < 4; ++j) bfr[j] = *(const bf16x8*)(BBT + (32 * j + r) * 16 + 8 * h);
  bf16x8 cfr[8];
#pragma unroll
  for (int s = 0; s < 8; ++s) cfr[s] = *(const bf16x8*)(CM + r * 128 + s * 16 + h * 8);
  bf16x8 dfr;
  {
    const short dv = (r < 16) ? (short)f2bf(p.in[I_S5D][e * 512 + g * 16 + r]) : (short)0;
#pragma unroll
    for (int j = 0; j < 8; ++j) dfr[j] = (8 * h + j == r) ? dv : (short)0;
  }
  const bf16_t* Ub = P + (size_t)(tok0 + r) * LDP_E + PE_U + g * 16 + 8 * h;
  bf16x8 a_cur = *(const bf16x8*)(Ub + (size_t)((dir ? 7 : 0) * 32) * LDP_E);
#pragma unroll 1
  for (int ss = 0; ss < 8; ++ss) {
    const int sc = dir ? 7 - ss : ss;
    const int t0 = tok0 + sc * 32;
    bf16x8 a_nxt = a_cur;
    if (ss < 7) a_nxt = *(const bf16x8*)(Ub + (size_t)((dir ? 6 - ss : ss + 1) * 32) * LDP_E);
    bf16_t* prec = Yb + (size_t)(t0 + 16 * h + (r & 15)) * DM + 512 + g * 16;
    uint4 pp0 = make_uint4(0, 0, 0, 0), pp1 = make_uint4(0, 0, 0, 0);
    if (mode == 2 && r < 16) { pp0 = *(const uint4*)prec; pp1 = *(const uint4*)(prec + 8); }
#pragma unroll
    for (int jp = 0; jp < 2; ++jp) {
      f32x16 are = mfma(a_cur, bfr[2 * jp], zero16());
      f32x16 aim = mfma(a_cur, bfr[2 * jp + 1], zero16());
#pragma unroll
      for (int q = 0; q < 16; ++q) *(unsigned*)(X + crow(q, h) * XLD + 2 * (32 * jp + r)) = pack2(are[q], aim[q]);
    }
    WSYNC();
#define S5STEP(T) { float br = __uint_as_float(wv[T] << 16), bi = __uint_as_float(wv[T] & 0xffff0000u); \
        float nr = lbr * hr - lbi * hi + br; float ni = lbr * hi + lbi * hr + bi; hr = nr; hi = ni; wv[T] = pack2(nr, ni); }
#pragma unroll
    for (int hf = 0; hf < 2; ++hf) {
      bf16_t* Xh = X + ((dir ? 1 - hf : hf) * 16) * XLD + 2 * lane;
      unsigned wv[16];
#pragma unroll
      for (int tt = 0; tt < 16; ++tt) wv[tt] = *(const unsigned*)(Xh + tt * XLD);
      if (dir == 0) {
#pragma unroll
        for (int tt = 0; tt < 16; ++tt) S5STEP(tt)
      } else {
#pragma unroll
        for (int tt = 15; tt >= 0; --tt) S5STEP(tt)
      }
#pragma unroll
      for (int tt = 0; tt < 16; ++tt) *(unsigned*)(Xh + tt * XLD) = wv[tt];
    }
#undef S5STEP
    WSYNC();
    if (mode >= 1) {
      f32x16 acc = zero16();
#pragma unroll
      for (int s = 0; s < 8; ++s) {
        bf16x8 xa = *(const bf16x8*)(X + r * XLD + s * 16 + h * 8);
        acc = mfma(xa, cfr[s], acc);
      }
      if (mode == 2) acc = mfma(a_cur, dfr, acc);
      if (r < 16) {
        if (mode == 1) {
          *(uint4*)prec = make_uint4(pack2(acc[0], acc[1]), pack2(acc[2], acc[3]), pack2(acc[4], acc[5]), pack2(acc[6], acc[7]));
          *(uint4*)(prec + 8) = make_uint4(pack2(acc[8], acc[9]), pack2(acc[10], acc[11]), pack2(acc[12], acc[13]), pack2(acc[14], acc[15]));
        } else {
          const unsigned pw[8] = {pp0.x, pp0.y, pp0.z, pp0.w, pp1.x, pp1.y, pp1.z, pp1.w};
          const int col = g * 16 + r;
#pragma unroll
          for (int q = 0; q < 16; ++q) {
            const float prev = (q & 1) ? __uint_as_float(pw[q >> 1] & 0xffff0000u) : __uint_as_float(pw[q >> 1] << 16);
            const float y = acc[q] + prev;
            const float t3 = 1.5957691216057308f * (y + 0.044715f * y * y * y);
            Z5[(size_t)(t0 + crow(q, h)) * 512 + col] = f2bf(y * sigmf(t3));
          }
        }
      }
    }
    WSYNC();
    a_cur = a_nxt;
  }
}

DI void s5_pass1_unit(const Params& p, int e, int u, char* smem) {
  const int tid = otid(), lane = tid & 63, w = tid >> 6;
  const int seg = u >> 3, g = (u & 7) * 4 + w;
  bf16_t* X = (bf16_t*)smem + w * 32 * XLD;
  float* ES = (float*)(p.ws + OFF_S5ES);
  for (int dir = 0; dir < 2; ++dir) {
    float hr = 0.f, hi = 0.f;
    s5_sweep(p, e, g, dir, 0, NTOK_P + seg * 256, hr, hi, X);
    size_t o = ((size_t)((seg * 32 + g) * 2 + dir) * 64 + lane) * 2;
    ES[o] = hr; ES[o + 1] = hi;
  }
}

DI void s5_pass3_unit(const Params& p, int e, int u, char* smem) {
  const int tid = otid(), lane = tid & 63, w = tid >> 6;
  const int seg = u >> 3, g = (u & 7) * 4 + w;
  bf16_t* X = (bf16_t*)smem + w * 32 * XLD;
  const bool samp = seg >= 32;
  const int sb = samp ? (seg - 32) >> 4 : 0, sl = samp ? (seg - 32) & 15 : 0;
  const float* ES = (const float*)(p.ws + OFF_S5ES);
  for (int dir = 0; dir < 2; ++dir) {
    float hr = 0.f, hi = 0.f;
    if (samp) {
      const size_t si = (size_t)(((sb * 2 + e) * 2 + dir) * 32 + g) * 64 + lane;
      hr = p.in[I_S5R][si]; hi = p.in[I_S5I][si];
      const float* L2 = (const float*)(p.ws + OFF_LB256) + (size_t)(((e * 2 + dir) * 32 + g) * 64 + lane) * 2;
      const float ar = L2[0], ai = L2[1];
      const int nst = dir ? 15 - sl : sl;
      float er[15], ei[15];
#pragma unroll
      for (int k = 0; k < 15; ++k) {
        const int kk = k < nst ? k : 0;
        const int sp = dir ? 15 - kk : kk;
        size_t o = ((size_t)(((sb * 16 + sp) * 32 + g) * 2 + dir) * 64 + lane) * 2;
        float2 ev = *(const float2*)(ES + o);
        er[k] = ev.x; ei[k] = ev.y;
      }
#pragma unroll
      for (int k = 0; k < 15; ++k) {
        if (k < nst) {
          float nr = ar * hr - ai * hi + er[k];
          float ni = ar * hi + ai * hr + ei[k];
          hr = nr; hi = ni;
        }
      }
    }
    s5_sweep(p, e, g, dir, dir + 1, seg * 256, hr, hi, X);
    if (!samp) {
      const size_t so = (size_t)(((seg * 2 + e) * 2 + dir) * 32 + g) * 64 + lane;
      p.out[OUT_S5R + so] = hr;
      p.out[OUT_S5I + so] = hi;
    }
  }
}

#define AL 72
template <int W>
DI void qk_prep(const bf16_t* src, const float* nw, bool rope, int pos, float mult, int sub, const float* RT,
                bf16_t* dst, float* fdst) {
  float x[4][W];
#pragma unroll
  for (int c = 0; c < 4; ++c) {
    if (W == 4) {
      uint2 v = *(const uint2*)(src + 16 * c + 4 * sub);
      x[c][0] = __uint_as_float(v.x << 16); x[c][1] = __uint_as_float(v.x & 0xffff0000u);
      x[c][2] = __uint_as_float(v.y << 16); x[c][3] = __uint_as_float(v.y & 0xffff0000u);
    } else {
      uint4 v = *(const uint4*)(src + 16 * c + 8 * sub);
      x[c][0] = __uint_as_float(v.x << 16); x[c][1] = __uint_as_float(v.x & 0xffff0000u);
      x[c][2] = __uint_as_float(v.y << 16); x[c][3] = __uint_as_float(v.y & 0xffff0000u);
      x[c][4 % W] = __uint_as_float(v.z << 16); x[c][5 % W] = __uint_as_float(v.z & 0xffff0000u);
      x[c][6 % W] = __uint_as_float(v.w << 16); x[c][7 % W] = __uint_as_float(v.w & 0xffff0000u);
    }
  }
  float ss = 0.f;
#pragma unroll
  for (int c = 0; c < 4; ++c)
#pragma unroll
    for (int i = 0; i < W; ++i) ss += x[c][i] * x[c][i];
  ss += __shfl_xor(ss, 1);
  if (W == 4) ss += __shfl_xor(ss, 2);
  const float rstd = rsqrtf(ss * (1.f / 64.f) + EPSF);
#pragma unroll
  for (int c = 0; c < 4; ++c)
#pragma unroll
    for (int i = 0; i < W; ++i) x[c][i] *= rstd * nw[16 * c + W * sub + i];
  if (rope) {
    const int row = pos >> 6, col = pos & 63;
#pragma unroll
    for (int i = 0; i < W; ++i) {
      const int f = W * sub + i;
      float cs = RT[(row * 16 + f) * 2], sn = RT[(row * 16 + f) * 2 + 1];
      float x1 = x[0][i], x2 = x[1][i];
      x[0][i] = x1 * cs - x2 * sn; x[1][i] = x2 * cs + x1 * sn;
      cs = RT[(col * 16 + f) * 2]; sn = RT[(col * 16 + f) * 2 + 1];
      x1 = x[2][i]; x2 = x[3][i];
      x[2][i] = x1 * cs - x2 * sn; x[3][i] = x2 * cs + x1 * sn;
    }
  }
#pragma unroll
  for (int c = 0; c < 4; ++c)
#pragma unroll
    for (int i = 0; i < W; ++i) {
      dst[16 * c + W * sub + i] = f2bf(x[c][i] * mult);
      if (fdst) fdst[16 * c + W * sub + i] = x[c][i];
    }
}

DI void attn_unit(const Params& p, int e, int u, char* smem) {
  const int tid = otid(), lane = tid & 63, w = tid >> 6;
  const int r = lane & 31, h = lane >> 5;
  bf16_t* Ks = (bf16_t*)smem;
  bf16_t* Vt = Ks + 64 * AL;
  bf16_t* Qs = Vt + 64 * AL;
  const bf16_t* P = (const bf16_t*)(p.ws + OFF_P);
  bf16_t* Y = (bf16_t*)(p.ws + OFF_HY);
  const float* RT = (const float*)(p.ws + OFF_ROPE);
  const bool lat = u >= 512;
  int b, kvh, qb;
  if (!lat) { b = u >> 4; kvh = (u >> 3) & 1; qb = u & 7; }
  else { int v = u - 512; b = v >> 8; kvh = (v >> 7) & 1; qb = v & 127; }
  const int tokbase = lat ? NTOK_P + b * 4096 : b * 256;
  const int q0 = qb * 32;
  const int hq = kvh * 4 + w;
  __syncthreads();
  const int kbase = lat ? (((q0 - 128) >> 6) << 6) : 0;
  const int ntile = lat ? 9 : 4;
  bf16_t* Ks1 = Qs + 4 * 32 * AL;
  bf16_t* Vt1 = Ks1 + 64 * AL;
  const int keyk = tid >> 2, s4 = tid & 3;
  const int keyv = tid & 63, cq = tid >> 6;
  const bool wr = (!lat) && (qb == 0);
  float knw[16];
#pragma unroll
  for (int c = 0; c < 4; ++c)
#pragma unroll
    for (int i = 0; i < 4; ++i) knw[c * 4 + i] = p.in[I_KNW][e * 64 + 16 * c + 4 * s4 + i];
  float ccs[4], csn[4];
#pragma unroll
  for (int i = 0; i < 4; ++i) { ccs[i] = RT[(keyk * 16 + 4 * s4 + i) * 2]; csn[i] = RT[(keyk * 16 + 4 * s4 + i) * 2 + 1]; }
  uint4 rk0, rk1, rk2, rk3, rv0, rv1, rv2, rv3;
  float rrc[4] = {1.f, 1.f, 1.f, 1.f}, rrs[4] = {0.f, 0.f, 0.f, 0.f};
  rk0 = rk1 = rk2 = rk3 = rv0 = rv1 = rv2 = rv3 = make_uint4(0, 0, 0, 0);
  int tlo = 0, thi = ntile - 1;
  if (lat) {
    tlo = kbase < 0 ? (-kbase) >> 6 : 0;
    thi = 4;
    while (kbase + thi * 64 >= 4096) --thi;
  }
#define TILE_NEXT(ti) (lat ? ((ti) < thi ? (ti) + 1 : ((ti) < 5 ? 5 : (ti) + 1)) : (ti) + 1)
#define TILE_LOAD(ti) { \
    const bool fc_ = lat && (ti) >= 5; \
    const int kt0_ = fc_ ? ((ti) - 5) * 64 : kbase + (ti) * 64; \
    if (fc_) { \
      const float* ck = p.in[I_CK] + ((size_t)((b * 2 + e) * 2 + kvh) * 256 + kt0_ + keyk) * 64 + 4 * s4; \
      const float* cv = p.in[I_CV] + ((size_t)((b * 2 + e) * 2 + kvh) * 256 + kt0_ + keyv) * 64 + cq * 16; \
      rk0 = *(const uint4*)(ck); rk1 = *(const uint4*)(ck + 16); rk2 = *(const uint4*)(ck + 32); rk3 = *(const uint4*)(ck + 48); \
      rv0 = *(const uint4*)(cv); rv1 = *(const uint4*)(cv + 4); rv2 = *(const uint4*)(cv + 8); rv3 = *(const uint4*)(cv + 12); \
    } else { \
      const bf16_t* ksrc = P + (size_t)(tokbase + kt0_ + keyk) * LDP_O + PO_K + kvh * 64 + 4 * s4; \
      const bf16_t* vsrc = P + (size_t)(tokbase + kt0_ + keyv) * LDP_O + PO_V + kvh * 64 + cq * 16; \
      uint2 t0_ = *(const uint2*)(ksrc), t1_ = *(const uint2*)(ksrc + 16), t2_ = *(const uint2*)(ksrc + 32), t3_ = *(const uint2*)(ksrc + 48); \
      rk0.x = t0_.x; rk0.y = t0_.y; rk1.x = t1_.x; rk1.y = t1_.y; rk2.x = t2_.x; rk2.y = t2_.y; rk3.x = t3_.x; rk3.y = t3_.y; \
      rv0 = *(const uint4*)(vsrc); rv1 = *(const uint4*)(vsrc + 8); \
      if (lat) { \
        const int row_ = kt0_ >> 6; \
        _Pragma("unroll") for (int i = 0; i < 4; ++i) { rrc[i] = RT[(row_ * 16 + 4 * s4 + i) * 2]; rrs[i] = RT[(row_ * 16 + 4 * s4 + i) * 2 + 1]; } \
      } \
    } }
#define VT4(VD, W0, W1) { (VD)[0] = (bf16_t)((W0) & 0xffffu); (VD)[AL] = (bf16_t)((W0) >> 16); (VD)[2 * AL] = (bf16_t)((W1) & 0xffffu); (VD)[3 * AL] = (bf16_t)((W1) >> 16); }
#define TILE_STORE(ti, KB, VB) { \
    const bool fc_ = lat && (ti) >= 5; \
    const int kt0_ = fc_ ? ((ti) - 5) * 64 : kbase + (ti) * 64; \
    if (fc_) { \
      bf16_t* kd = (KB) + keyk * AL + 4 * s4; \
      *(uint2*)(kd) = make_uint2(pack2(__uint_as_float(rk0.x), __uint_as_float(rk0.y)), pack2(__uint_as_float(rk0.z), __uint_as_float(rk0.w))); \
      *(uint2*)(kd + 16) = make_uint2(pack2(__uint_as_float(rk1.x), __uint_as_float(rk1.y)), pack2(__uint_as_float(rk1.z), __uint_as_float(rk1.w))); \
      *(uint2*)(kd + 32) = make_uint2(pack2(__uint_as_float(rk2.x), __uint_as_float(rk2.y)), pack2(__uint_as_float(rk2.z), __uint_as_float(rk2.w))); \
      *(uint2*)(kd + 48) = make_uint2(pack2(__uint_as_float(rk3.x), __uint_as_float(rk3.y)), pack2(__uint_as_float(rk3.z), __uint_as_float(rk3.w))); \
      bf16_t* vd = (VB) + (cq * 16) * AL + keyv; \
      VT4(vd, pack2(__uint_as_float(rv0.x), __uint_as_float(rv0.y)), pack2(__uint_as_float(rv0.z), __uint_as_float(rv0.w))) \
      VT4(vd + 4 * AL, pack2(__uint_as_float(rv1.x), __uint_as_float(rv1.y)), pack2(__uint_as_float(rv1.z), __uint_as_float(rv1.w))) \
      VT4(vd + 8 * AL, pack2(__uint_as_float(rv2.x), __uint_as_float(rv2.y)), pack2(__uint_as_float(rv2.z), __uint_as_float(rv2.w))) \
      VT4(vd + 12 * AL, pack2(__uint_as_float(rv3.x), __uint_as_float(rv3.y)), pack2(__uint_as_float(rv3.z), __uint_as_float(rv3.w))) \
    } else { \
      float x[4][4]; \
      const unsigned kw[8] = {rk0.x, rk0.y, rk1.x, rk1.y, rk2.x, rk2.y, rk3.x, rk3.y}; \
      _Pragma("unroll") for (int c = 0; c < 4; ++c) { \
        x[c][0] = __uint_as_float(kw[2 * c] << 16); x[c][1] = __uint_as_float(kw[2 * c] & 0xffff0000u); \
        x[c][2] = __uint_as_float(kw[2 * c + 1] << 16); x[c][3] = __uint_as_float(kw[2 * c + 1] & 0xffff0000u); } \
      float ss = 0.f; \
      _Pragma("unroll") for (int c = 0; c < 4; ++c) _Pragma("unroll") for (int i = 0; i < 4; ++i) ss += x[c][i] * x[c][i]; \
      ss += __shfl_xor(ss, 1); ss += __shfl_xor(ss, 2); \
      const float rstd = rsqrtf(ss * (1.f / 64.f) + EPSF); \
      _Pragma("unroll") for (int c = 0; c < 4; ++c) _Pragma("unroll") for (int i = 0; i < 4; ++i) x[c][i] *= rstd * knw[c * 4 + i]; \
      if (lat) { \
        _Pragma("unroll") for (int i = 0; i < 4; ++i) { \
          float x1 = x[0][i], x2 = x[1][i]; x[0][i] = x1 * rrc[i] - x2 * rrs[i]; x[1][i] = x2 * rrc[i] + x1 * rrs[i]; \
          x1 = x[2][i]; x2 = x[3][i]; x[2][i] = x1 * ccs[i] - x2 * csn[i]; x[3][i] = x2 * ccs[i] + x1 * csn[i]; } \
      } \
      bf16_t* kd = (KB) + keyk * AL + 4 * s4; \
      _Pragma("unroll") for (int c = 0; c < 4; ++c) *(uint2*)(kd + 16 * c) = make_uint2(pack2(x[c][0], x[c][1]), pack2(x[c][2], x[c][3])); \
      if (wr) { \
        float* fd = p.out + OUT_CK + ((size_t)((b * 2 + e) * 2 + kvh) * 256 + kt0_ + keyk) * 64 + 4 * s4; \
        _Pragma("unroll") for (int c = 0; c < 4; ++c) *(float4*)(fd + 16 * c) = make_float4(x[c][0], x[c][1], x[c][2], x[c][3]); \
        float* fv = p.out + OUT_CV + ((size_t)((b * 2 + e) * 2 + kvh) * 256 + kt0_ + keyv) * 64 + cq * 16; \
        *(float4*)(fv) = make_float4(__uint_as_float(rv0.x << 16), __uint_as_float(rv0.x & 0xffff0000u), __uint_as_float(rv0.y << 16), __uint_as_float(rv0.y & 0xffff0000u)); \
        *(float4*)(fv + 4) = make_float4(__uint_as_float(rv0.z << 16), __uint_as_float(rv0.z & 0xffff0000u), __uint_as_float(rv0.w << 16), __uint_as_float(rv0.w & 0xffff0000u)); \
        *(float4*)(fv + 8) = make_float4(__uint_as_float(rv1.x << 16), __uint_as_float(rv1.x & 0xffff0000u), __uint_as_float(rv1.y << 16), __uint_as_float(rv1.y & 0xffff0000u)); \
        *(float4*)(fv + 12) = make_float4(__uint_as_float(rv1.z << 16), __uint_as_float(rv1.z & 0xffff0000u), __uint_as_float(rv1.w << 16), __uint_as_float(rv1.w & 0xffff0000u)); \
      } \
      bf16_t* vd = (VB) + (cq * 16) * AL + keyv; \
      VT4(vd, rv0.x, rv0.y) VT4(vd + 4 * AL, rv0.z, rv0.w) VT4(vd + 8 * AL, rv1.x, rv1.y) VT4(vd + 12 * AL, rv1.z, rv1.w) \
    } }
  int cur = 0;
  TILE_LOAD(tlo)
  uint2 zq[2][4];
#pragma unroll
  for (int dvt = 0; dvt < 2; ++dvt)
#pragma unroll
    for (int g4 = 0; g4 < 4; ++g4)
      zq[dvt][g4] = *(const uint2*)(P + (size_t)(tokbase + q0 + r) * LDP_O + PO_ZA + hq * 64 + dvt * 32 + 8 * g4 + 4 * h);
  {
    const int qi = lane >> 1, sub = lane & 1;
    const bf16_t* src = P + (size_t)(tokbase + q0 + qi) * LDP_O + PO_Q + hq * 64;
    qk_prep<8>(src, p.in[I_QNW] + e * 64, lat, q0 + qi, 0.125f, sub, RT, Qs + (w * 32 + qi) * AL, nullptr);
  }
  __syncthreads();
  bf16x8 qf[4];
#pragma unroll
  for (int ks = 0; ks < 4; ++ks) qf[ks] = *(const bf16x8*)(Qs + (w * 32 + r) * AL + ks * 16 + h * 8);
  float m_run = p.in[I_SINK][e * 8 + hq];
  float l_run = 1.f;
  f32x16 o[2];
  o[0] = zero16(); o[1] = zero16();
  TILE_STORE(tlo, Ks, Vt)
  __syncthreads();
  for (int ti = tlo; ti < ntile;) {
    const bool fromcache = lat && ti >= 5;
    const int kt0 = fromcache ? (ti - 5) * 64 : kbase + ti * 64;
    const int tn = TILE_NEXT(ti);
    if (tn < ntile) { TILE_LOAD(tn) }
    const bf16_t* Kc = cur ? Ks1 : Ks;
    const bf16_t* Vc = cur ? Vt1 : Vt;
    f32x16 s[2];
#pragma unroll
    for (int mt = 0; mt < 2; ++mt) {
      s[mt] = zero16();
#pragma unroll
      for (int ks = 0; ks < 4; ++ks) {
        bf16x8 a = *(const bf16x8*)(Kc + (mt * 32 + r) * AL + ks * 16 + h * 8);
        s[mt] = mfma(a, qf[ks], s[mt]);
      }
    }
    if (lat && !fromcache) {
      const int qpos = q0 + r;
#pragma unroll
      for (int mt = 0; mt < 2; ++mt)
#pragma unroll
        for (int q = 0; q < 16; ++q) {
          int kpos = kt0 + mt * 32 + crow(q, h);
          int dd = kpos - qpos;
          if (dd > 128 || dd < -128) s[mt][q] = -1e30f;
        }
    }
    float mx = -3e38f;
#pragma unroll
    for (int mt = 0; mt < 2; ++mt)
#pragma unroll
      for (int q = 0; q < 16; ++q) mx = fmaxf(mx, s[mt][q]);
    mx = fmaxf(mx, __shfl_xor(mx, 32));
    const float m_new = fmaxf(m_run, mx);
    const float alpha = __expf(m_run - m_new);
    float rs = 0.f;
#pragma unroll
    for (int mt = 0; mt < 2; ++mt)
#pragma unroll
      for (int q = 0; q < 16; ++q) { float pv = __expf(s[mt][q] - m_new); s[mt][q] = pv; rs += pv; }
    rs += __shfl_xor(rs, 32);
    l_run = l_run * alpha + rs;
    m_run = m_new;
#pragma unroll
    for (int q = 0; q < 16; ++q) { o[0][q] *= alpha; o[1][q] *= alpha; }
#pragma unroll
    for (int mt = 0; mt < 2; ++mt)
#pragma unroll
      for (int sx = 0; sx < 2; ++sx) {
        bf16x8 pf;
#pragma unroll
        for (int j = 0; j < 8; ++j) pf[j] = (short)f2bf(s[mt][8 * sx + j]);
#pragma unroll
        for (int dvt = 0; dvt < 2; ++dvt) {
          const bf16_t* vp = Vc + (dvt * 32 + r) * AL + mt * 32 + 16 * sx + 4 * h;
          s16x4 lo = *(const s16x4*)vp;
          s16x4 hi4 = *(const s16x4*)(vp + 8);
          bf16x8 a = __builtin_shufflevector(lo, hi4, 0, 1, 2, 3, 4, 5, 6, 7);
          o[dvt] = mfma(a, pf, o[dvt]);
        }
      }
      if (tn < ntile) {
      if (cur) { TILE_STORE(tn, Ks, Vt) } else { TILE_STORE(tn, Ks1, Vt1) }
    }
    __syncthreads();
    ti = tn;
    cur ^= 1;
  }
#undef TILE_NEXT
#undef TILE_LOAD
#undef TILE_STORE
#undef VT4
  const float inv = 1.f / l_run;
  const int tok = tokbase + q0 + r;
#pragma unroll
  for (int dvt = 0; dvt < 2; ++dvt)
#pragma unroll
    for (int g4 = 0; g4 < 4; ++g4) {
      const int dv = dvt * 32 + 8 * g4 + 4 * h;
      uint2 zz = zq[dvt][g4];
      float z0 = __uint_as_float(zz.x << 16), z1 = __uint_as_float(zz.x & 0xffff0000u);
      float z2 = __uint_as_float(zz.y << 16), z3 = __uint_as_float(zz.y & 0xffff0000u);
      float y0 = o[dvt][4 * g4 + 0] * inv * siluf(z0);
      float y1 = o[dvt][4 * g4 + 1] * inv * siluf(z1);
      float y2 = o[dvt][4 * g4 + 2] * inv * siluf(z2);
      float y3 = o[dvt][4 * g4 + 3] * inv * siluf(z3);
      *(uint2*)(Y + (size_t)tok * DM + hq * 64 + dv) = make_uint2(pack2(y0, y1), pack2(y2, y3));
    }
}

DI void conv_unit(const Params& p, int e, int u) {
  const int tid = otid();
  const bf16_t* P = (const bf16_t*)(p.ws + OFF_P);
  bf16_t* Y = (bf16_t*)(p.ws + OFF_HY);
  const int t0 = u * 16;
  const int c = tid * 2;
  int seg0, seg1;
  if (t0 < NTOK_P) { seg0 = t0 & ~255; seg1 = seg0 + 256; }
  else { seg0 = NTOK_P + ((t0 - NTOK_P) & ~4095); seg1 = seg0 + 4096; }
  const float* cw = p.in[I_CONVW] + (size_t)e * 3 * 512;
  const float w00 = cw[c], w01 = cw[c + 1], w10 = cw[512 + c], w11 = cw[512 + c + 1], w20 = cw[1024 + c], w21 = cw[1024 + c + 1];
  const float b0 = p.in[I_CONVB][e * 512 + c], b1 = p.in[I_CONVB][e * 512 + c + 1];
  auto prod = [&](int t, float& a, float& b) {
    if (t < seg0 || t >= seg1) { a = 0.f; b = 0.f; return; }
    unsigned xc = *(const unsigned*)(P + (size_t)t * LDP_O + PO_XC + c);
    unsigned cg_ = *(const unsigned*)(P + (size_t)t * LDP_O + PO_CG + c);
    a = __uint_as_float(xc << 16) * __uint_as_float(cg_ << 16);
    b = __uint_as_float(xc & 0xffff0000u) * __uint_as_float(cg_ & 0xffff0000u);
  };
  float pa0, pa1, pb0, pb1, pc0, pc1;
  prod(t0 - 1, pa0, pa1);
  prod(t0, pb0, pb1);
#pragma unroll
  for (int i = 0; i < 16; ++i) {
    const int t = t0 + i;
    prod(t + 1, pc0, pc1);
    unsigned bg = *(const unsigned*)(P + (size_t)t * LDP_O + PO_BG + c);
    unsigned zc = *(const unsigned*)(P + (size_t)t * LDP_O + PO_ZC + c);
    float y0 = __uint_as_float(bg << 16) * (w00 * pa0 + w10 * pb0 + w20 * pc0 + b0) * siluf(__uint_as_float(zc << 16));
    float y1 = __uint_as_float(bg & 0xffff0000u) * (w01 * pa1 + w11 * pb1 + w21 * pc1 + b1) * siluf(__uint_as_float(zc & 0xffff0000u));
    *(unsigned*)(Y + (size_t)t * DM + 512 + c) = pack2(y0, y1);
    pa0 = pb0; pa1 = pb1; pb0 = pc0; pb1 = pc1;
  }
}


#define QCTR(l, ph) ((unsigned*)(p.ws + OFF_BAR) + 3584 + 16 * ((l) * 4 + (ph)))
DI int next_unit(unsigned* ctr, volatile int* sh) {
  __syncthreads();
  if (threadIdx.x == 0) *sh = (int)atomicAdd(ctr, 1u);
  __syncthreads();
  return *sh;
}
#ifndef REP_A
#define REP_A 1
#endif
#ifndef REP_INPROJ
#define REP_INPROJ 1
#endif
#ifndef REP_EVEN
#define REP_EVEN 1
#endif
#ifndef REP_ODD
#define REP_ODD 1
#endif
#define REP_G1 1
#define REP_S1 1
#define REP_G3 1
#define REP_S3 1
#ifndef REP_SYNC
#define REP_SYNC 1
#endif
#define GSYNC() do { _Pragma("unroll 1") for (int rs_ = 0; rs_ < REP_SYNC; ++rs_) xcd_barrier(xb); } while (0)
__global__ void __launch_bounds__(256, 2) fwd_megakernel(Params p) {
  cg::grid_group grid = cg::this_grid();
  __shared__ __attribute__((aligned(16))) char smem[SMEM_BYTES];
  __shared__ uint4 xb_words;
  __shared__ int qsh;
  if (threadIdx.x == 0) xb_words = make_uint4(0u, 0u, 0u, 0u);
  __syncthreads();
  XcdBarrier xb = xcd_barrier_post((unsigned*)(p.ws + OFF_BAR), (volatile LAS unsigned*)&xb_words);
  if (p.ws == nullptr) grid.sync();
  phase0(p, smem);
  GSYNC();
#pragma unroll 1
  for (int l = 0; l < 4; ++l) {
    const int e = l >> 1;
#pragma unroll 1
    for (int rep = 0; rep < REP_A; ++rep) {
      phaseA(p, l);
      GSYNC();
    }
    const int odd = l & 1;
#pragma unroll 1
    for (int rep = 0; rep < REP_INPROJ; ++rep) {
      gemm_phase<EPI_P, 16>(p, l, (const bf16_t*)(p.ws + OFF_HY), DM, (const bf16_t*)(p.ws + OFF_WIN), DM, odd ? LDP_O / 128 : LDP_E / 128, odd ? LDP_O : LDP_E, smem);
      GSYNC();
    }
    if (!odd) {
#pragma unroll 1
      for (int rep = 0; rep < REP_EVEN; ++rep) {
        if (blockIdx.x >= (gridDim.x >> 1)) { __builtin_amdgcn_s_sleep(127); __builtin_amdgcn_s_sleep(127); }
        for (int u = next_unit(QCTR(l, 0), &qsh); u < 512 + 512; u = next_unit(QCTR(l, 0), &qsh)) {
          if (u < 512) { _Pragma("unroll 1") for (int r2 = 0; r2 < REP_G1; ++r2) gla_pass1_unit(p, e, u, smem); }
          else { _Pragma("unroll 1") for (int r2 = 0; r2 < REP_S1; ++r2) s5_pass1_unit(p, e, u - 512, smem); }
        }
        GSYNC();
        if (blockIdx.x >= (gridDim.x >> 1)) { __builtin_amdgcn_s_sleep(127); __builtin_amdgcn_s_sleep(127); }
        for (int u = next_unit(QCTR(l, 1), &qsh); u < 384 + 768; u = next_unit(QCTR(l, 1), &qsh)) {
          if (u < 384) { _Pragma("unroll 1") for (int r2 = 0; r2 < REP_G3; ++r2) gla_pass3_unit(p, e, u, smem); }
          else { _Pragma("unroll 1") for (int r2 = 0; r2 < REP_S3; ++r2) s5_pass3_unit(p, e, u - 384, smem); }
        }
        GSYNC();
        gemm_phase<EPI_GLU, 8>(p, l, (const bf16_t*)(p.ws + OFF_Z5), 512, (const bf16_t*)(p.ws + OFF_WGLU), 512, 4, 0, smem);
        GSYNC();
      }
    } else {
#pragma unroll 1
      for (int rep = 0; rep < REP_ODD; ++rep) {
        if (blockIdx.x >= (gridDim.x >> 1)) { __builtin_amdgcn_s_sleep(127); __builtin_amdgcn_s_sleep(127); }
        for (int u = next_unit(QCTR(l, 2), &qsh); u < 1536 + 1536; u = next_unit(QCTR(l, 2), &qsh)) {
          if (u < 1024) attn_unit(p, e, u + 512, smem);
          else if (u < 1536) attn_unit(p, e, u - 1024, smem);
          else conv_unit(p, e, u - 1536);
        }
        GSYNC();
      }
    }
    gemm_phase<EPI_RES, 16>(p, l, (const bf16_t*)(p.ws + OFF_HY), DM, (const bf16_t*)(p.ws + OFF_WOUT), DM, 8, 0, smem);
    if (l < 3) GSYNC();
  }
}

extern "C" void kernel_launch(void* const* d_in, const int* in_sizes, int n_in, void* d_out, int out_size,
                              void* d_ws, size_t ws_size, hipStream_t stream) {
  static int grid_blocks = 0;
  if (!grid_blocks) {
    int dev = 0, cus = 0, per_cu = 0;
    hipGetDevice(&dev);
    hipDeviceGetAttribute(&cus, hipDeviceAttributeMultiprocessorCount, dev);
    hipOccupancyMaxActiveBlocksPerMultiprocessor(&per_cu, fwd_megakernel, 256, 0);
    if (per_cu > 2) per_cu = 2;
    if (per_cu < 1) per_cu = 1;
    grid_blocks = cus * per_cu;
  }
  if (ws_size < WS_NEED || n_in < 34) { fprintf(stderr, "workspace too small\n"); return; }
  Params p{};
  for (int i = 0; i < 34; ++i) p.in[i] = (const float*)d_in[i];
  p.out = (float*)d_out;
  p.ws = (char*)d_ws;
  (void)hipMemsetAsync((char*)d_ws + OFF_BAR, 0, 16384, stream);
  void* args[] = {&p};
  hipError_t err = hipLaunchCooperativeKernel((void*)fwd_megakernel, dim3(grid_blocks), dim3(256), args, 0, stream);
  if (err != hipSuccess) fprintf(stderr, "cooperative launch failed: %s (grid %d)\n", hipGetErrorString(err), grid_blocks);
}
```

```cpp
#include <hip/hip_runtime.h>
#include <hip/hip_cooperative_groups.h>
#include <cstdio>
namespace cg = cooperative_groups;

typedef unsigned short bf16_t;
using bf16x8 = __attribute__((ext_vector_type(8))) short;
using s16x4  = __attribute__((ext_vector_type(4))) short;
using f32x16 = __attribute__((ext_vector_type(16))) float;
#define DI __device__ __forceinline__

#define NTOK    24576
#define NTOK_P  8192
#define DM      1024
#define LDP_E   2688
#define LDP_O   3328
#define EPSF    1e-6f

#define PE_Q   0
#define PE_K   256
#define PE_V   512
#define PE_ZG  1024
#define PE_U   1536
#define PE_ZS  2048
#define PE_LF  2560
#define PO_Q   0
#define PO_K   512
#define PO_V   640
#define PO_ZA  768
#define PO_XC  1280
#define PO_BG  1792
#define PO_CG  2304
#define PO_ZC  2816

#define OUT_GLA  25165824
#define OUT_S5R  29360128
#define OUT_S5I  29622272
#define OUT_CK   29884416
#define OUT_CV   31981568

#define OFF_WIN   0ull
#define OFF_WOUT  6815744ull
#define OFF_WGLU  8912896ull
#define OFF_MOD   9437184ull
#define OFF_LB    9682944ull
#define OFF_LB256 (OFF_LB + 65536ull)
#define OFF_BBT   (OFF_LB256 + 65536ull)
#define OFF_CM    (OFF_BBT + 524288ull)
#define OFF_ROPE  (OFF_CM + 524288ull)
#define OFF_S5ES  (OFF_ROPE + 8192ull)
#define OFF_GLAL  (OFF_S5ES + 2097152ull)
#define OFF_GLAD  (OFF_GLAL + 16777216ull)
#define OFF_HY    (OFF_GLAD + 131072ull)
#define OFF_P     (OFF_HY + 50331648ull)
#define OFF_Z5    (OFF_P + 132120576ull)
#define OFF_BAR   (OFF_P + 163577856ull)
#define WS_NEED   (OFF_BAR + 16384ull)

#define SMEM_BYTES 80896

struct Params {
  const float* in[34];
  float* out;
  char* ws;
};

enum { I_XP = 0, I_XS, I_C, I_SGLA, I_S5R, I_S5I, I_CK, I_CV, I_CCTX, I_NORMW, I_WADA, I_BADA, I_WINE, I_WOUTE,
       I_GW2, I_GB2, I_GON, I_LAMR, I_LAMI, I_LOGDT, I_BRE, I_BIM, I_CRE, I_CIM, I_S5D, I_WGLU, I_BGLU,
       I_WINO, I_WOUTO, I_QNW, I_KNW, I_SINK, I_CONVW, I_CONVB };

DI int otid() { int t = threadIdx.x; asm volatile("" : "+v"(t)); return t; }
typedef __bf16 hbf16x2 __attribute__((ext_vector_type(2)));
typedef float hf32x2 __attribute__((ext_vector_type(2)));
DI unsigned pack2(float a, float b) { hf32x2 v = {a, b}; return __builtin_bit_cast(unsigned, __builtin_convertvector(v, hbf16x2)); }
DI bf16_t f2bf(float x) { return (bf16_t)(pack2(x, x) & 0xffffu); }
DI float bf2f(bf16_t b) { return __uint_as_float(((unsigned)b) << 16); }
DI float siluf(float x) { return x * __builtin_amdgcn_rcpf(1.f + __expf(-x)); }
DI float sigmf(float x) { return __builtin_amdgcn_rcpf(1.f + __expf(-x)); }
DI int crow(int q, int h) { return (q & 3) + 8 * (q >> 2) + 4 * h; }
DI f32x16 mfma(bf16x8 a, bf16x8 b, f32x16 c) { return __builtin_amdgcn_mfma_f32_32x32x16_bf16(a, b, c, 0, 0, 0); }
DI f32x16 zero16() { f32x16 z; for (int i = 0; i < 16; ++i) z[i] = 0.f; return z; }

template <int K>
DI void mma_tile(f32x16& acc, const bf16_t* A, int lda, const bf16_t* Bt, int ldb, int lane) {
  const int r = lane & 31, h = lane >> 5;
#pragma unroll
  for (int s = 0; s < K / 16; ++s) {
    bf16x8 a = *(const bf16x8*)(A + r * lda + s * 16 + h * 8);
    bf16x8 b = *(const bf16x8*)(Bt + r * ldb + s * 16 + h * 8);
    acc = mfma(a, b, acc);
  }
}

#define XB_TMO      128
#define XB_XCNT(j)  (256  + 64 * (j))
#define XB_XSUB(j)  (1280 + 64 * (j))
#define XB_XGEN(j)  (2304 + 64 * (j))
#define XB_TOP      3328
#define XB_TOPGEN   3392
#define XCD_BAR_WORDS 3456
#define XB_SPIN_CAP (1u << 18)
#define LAS __attribute__((address_space(3)))

__device__ __forceinline__ unsigned xb_ld(unsigned* p)              { return __hip_atomic_load(p, __ATOMIC_RELAXED, __HIP_MEMORY_SCOPE_AGENT); }
__device__ __forceinline__ unsigned xb_add(unsigned* p, unsigned v) { return __hip_atomic_fetch_add(p, v, __ATOMIC_RELAXED, __HIP_MEMORY_SCOPE_AGENT); }
__device__ __forceinline__ unsigned xb_xcc_id() { return (unsigned)__builtin_amdgcn_s_getreg((3 << 11) | 20) & 0xFu; }
#define XB_SPIN(cond, bar) do { unsigned _sp = 0; while (cond) { __builtin_amdgcn_s_sleep(1); \
    if ((++_sp & 255u) == 0u) { if (xb_ld(&(bar)[XB_TMO])) break; if (_sp > XB_SPIN_CAP) { atomicAdd(&(bar)[XB_TMO], 1u); break; } } } } while (0)

struct XcdBarrier {
    unsigned* bar; unsigned x;
    volatile LAS unsigned* st;
};

__device__ __forceinline__ XcdBarrier xcd_barrier_post(unsigned* bar, volatile LAS unsigned* st) {
    XcdBarrier b; b.bar = bar; b.x = xb_xcc_id(); b.st = st;
    if (threadIdx.x == 0) (void)xb_add(&bar[XB_XCNT(b.x)], 1u);
    return b;
}
__device__ __forceinline__ void xcd_barrier_complete(unsigned* bar, unsigned x, unsigned& nloc, unsigned& nx) {
    const unsigned G = gridDim.x * gridDim.y * gridDim.z;
    unsigned sum, cnt, mine, sp = 0u;
    for (;;) {
        sum = 0u; cnt = 0u; mine = 0u;
#pragma unroll
        for (unsigned j = 0; j < 16; ++j) { const unsigned c = xb_ld(&bar[XB_XCNT(j)]); sum += c; cnt += (c > 0u) ? 1u : 0u; mine = (j == x) ? c : mine; }
        if (sum == G) break;
        __builtin_amdgcn_s_sleep(1);
        if ((++sp & 255u) == 0u) { if (xb_ld(&bar[XB_TMO])) break; if (sp > XB_SPIN_CAP) { atomicAdd(&bar[XB_TMO], 1u); break; } }
    }
    nloc = mine > 0u ? mine : 1u; nx = cnt > 0u ? cnt : 1u;
}

__device__ __forceinline__ void xcd_barrier(const XcdBarrier& b) {
    asm volatile("s_waitcnt vmcnt(0)" ::: "memory");
    __syncthreads();
    if (threadIdx.x == 0) {
        unsigned* bar = b.bar;
        __builtin_amdgcn_s_waitcnt(0);
        unsigned nloc = b.st[0], nx = b.st[1];
        if (nloc == 0u) { xcd_barrier_complete(bar, b.x, nloc, nx); b.st[0] = nloc; b.st[1] = nx; }
        const unsigned old = xb_add(&bar[XB_XSUB(b.x)], 1u);
        const unsigned gen = old / nloc;
        if (old + 1u == (gen + 1u) * nloc) {
            __builtin_amdgcn_fence(__ATOMIC_RELEASE, "agent");
            asm volatile("s_waitcnt vmcnt(0)" ::: "memory");
            const unsigned og = xb_add(&bar[XB_TOP], 1u);
            const unsigned tg = og / nx;
            if (og + 1u == (tg + 1u) * nx) xb_add(&bar[XB_TOPGEN], 1u);
            else XB_SPIN(xb_ld(&bar[XB_TOPGEN]) == tg, bar);
            __builtin_amdgcn_fence(__ATOMIC_ACQUIRE, "agent");
            xb_add(&bar[XB_XGEN(b.x)], 1u);
            asm volatile("s_waitcnt vmcnt(0)" ::: "memory");
        } else {
            XB_SPIN(xb_ld(&bar[XB_XGEN(b.x)]) == gen, bar);
            __builtin_amdgcn_fence(__ATOMIC_ACQUIRE, "agent");
            asm volatile("s_waitcnt vmcnt(0)" ::: "memory");
        }
    }
    __syncthreads();
}


DI void phase0(const Params& p, char* smem) {
  const int tid = otid();
  float* sc = (float*)smem;
  float* red = sc + 5 * 1024;
  float* MOD = (float*)(p.ws + OFF_MOD);
  const int NU = 384 + 128 + 1;
  for (int u = blockIdx.x; u < NU; u += gridDim.x) {
    if (u < 384) {
      const int l = u / 96, nc = u % 96;
      __syncthreads();
      for (int i = tid; i < 5 * 1024; i += 256) {
        int j = i >> 10, k = i & 1023;
        float v = (j == 0) ? p.in[I_CCTX][k] : p.in[I_C][(j - 1) * 1024 + k];
        sc[i] = v / (1.f + expf(-v));
      }
      __syncthreads();
      const int col = tid & 31, kg = tid >> 5;
      const float* w = p.in[I_WADA] + (size_t)l * 1024 * 3072 + nc * 32 + col;
      float a0 = 0, a1 = 0, a2 = 0, a3 = 0, a4 = 0;
#pragma unroll 16
      for (int k = kg; k < 1024; k += 8) {
        float wv = w[(size_t)k * 3072];
        a0 += sc[k] * wv; a1 += sc[1024 + k] * wv; a2 += sc[2048 + k] * wv; a3 += sc[3072 + k] * wv; a4 += sc[4096 + k] * wv;
      }
      red[(kg * 5 + 0) * 32 + col] = a0; red[(kg * 5 + 1) * 32 + col] = a1; red[(kg * 5 + 2) * 32 + col] = a2;
      red[(kg * 5 + 3) * 32 + col] = a3; red[(kg * 5 + 4) * 32 + col] = a4;
      __syncthreads();
      if (tid < 160) {
        int j = tid >> 5, c2 = tid & 31;
        float s = 0;
        for (int g = 0; g < 8; ++g) s += red[(g * 5 + j) * 32 + c2];
        int n = nc * 32 + c2;
        MOD[(l * 5 + j) * 3072 + n] = s + p.in[I_BADA][l * 3072 + n];
      }
    } else if (u < 384 + 128) {
      const int v = u - 384;
      const int e = v >> 6, dir = (v >> 5) & 1, g = v & 31;
      if (tid < 64) {
        const int pp = tid;
        const int idx = ((e * 2 + dir) * 32 + g) * 64 + pp;
        double dt = exp((double)p.in[I_LOGDT][(e * 2 + dir) * 32 + g]);
        double lr = (double)p.in[I_LAMR][idx], li = (double)p.in[I_LAMI][idx];
        double mag = exp(lr * dt);
        double ang = li * dt;
        double tw = 6.283185307179586476925286766559;
        double kq = rint(ang / tw);
        double ra = ang - kq * tw;
        double lbr = mag * cos(ra), lbi = mag * sin(ra);
        double den = lr * lr + li * li;
        double nr = lbr - 1.0, ni = lbi;
        double cr = (nr * lr + ni * li) / den, ci = (ni * lr - nr * li) / den;
        float* LB = (float*)(p.ws + OFF_LB);
        float* LB256 = (float*)(p.ws + OFF_LB256);
        LB[idx * 2] = (float)lbr; LB[idx * 2 + 1] = (float)lbi;
        double pr = lbr, pi = lbi;
        for (int i = 0; i < 8; ++i) { double t = pr * pr - pi * pi; pi = 2.0 * pr * pi; pr = t; }
        LB256[idx * 2] = (float)pr; LB256[idx * 2 + 1] = (float)pi;
        bf16_t* BBT = (bf16_t*)(p.ws + OFF_BBT) + (size_t)((e * 2 + dir) * 32 + g) * 128 * 16;
        const float* bre = p.in[I_BRE] + ((size_t)(e * 32 + g) * 64 + pp) * 16;
        const float* bim = p.in[I_BIM] + ((size_t)(e * 32 + g) * 64 + pp) * 16;
        for (int hh = 0; hh < 16; ++hh) {
          double br = bre[hh], bi = bim[hh];
          const int nre = (pp >> 5) * 64 + (pp & 31);
          BBT[nre * 16 + hh] = f2bf((float)(cr * br - ci * bi));
          BBT[(nre + 32) * 16 + hh] = f2bf((float)(cr * bi + ci * br));
        }
        if (dir == 0) {
          bf16_t* CM = (bf16_t*)(p.ws + OFF_CM) + (size_t)(e * 32 + g) * 32 * 128;
          for (int hh = 0; hh < 32; ++hh) {
            float cre = 0.f, cim = 0.f;
            if (hh < 16) {
              cre = p.in[I_CRE][((size_t)(e * 32 + g) * 16 + hh) * 64 + pp];
              cim = p.in[I_CIM][((size_t)(e * 32 + g) * 16 + hh) * 64 + pp];
            }
            CM[hh * 128 + 2 * pp] = f2bf(cre);
            CM[hh * 128 + 2 * pp + 1] = f2bf(-cim);
          }
        }
      }
    } else {
      float* RT = (float*)(p.ws + OFF_ROPE);
      for (int i = tid; i < 64 * 16; i += 256) {
        int pos = i >> 4, f = i & 15;
        double fr = exp(-(double)f / 16.0 * 9.2103403719761827360719658187375);
        double ang = (double)pos * fr;
        double tw = 6.283185307179586476925286766559;
        double ra = ang - rint(ang / tw) * tw;
        RT[i * 2] = (float)cos(ra); RT[i * 2 + 1] = (float)sin(ra);
      }
    }
  }
}

DI void convert_tile(const float* src, int nsrc, bf16_t* dst, int K, int n0, int k0, int mapmode, int tid) {
  const int n = n0 + (tid & 63), kq = tid >> 6;
  int sc = n;
  if (mapmode == 1) {
    if (n < 1024) sc = n;
    else if (n < 2560) sc = n + 32;
    else if (n < 2592) sc = n - 1536;
    else sc = -1;
  }
  unsigned w[8];
#pragma unroll
  for (int i = 0; i < 8; ++i) {
    int k = k0 + kq * 16 + 2 * i;
    float a = 0.f, b = 0.f;
    if (sc >= 0) { a = __builtin_nontemporal_load(src + (size_t)k * nsrc + sc); b = __builtin_nontemporal_load(src + (size_t)(k + 1) * nsrc + sc); }
    w[i] = pack2(a, b);
  }
  uint4* d = (uint4*)(dst + (size_t)n * K + k0 + kq * 16);
  d[0] = make_uint4(w[0], w[1], w[2], w[3]);
  d[1] = make_uint4(w[4], w[5], w[6], w[7]);
}

DI void phaseA(const Params& p, int l) {
  const int tid = otid();
  const int odd = l & 1, e = l >> 1;
  const int n_in = (odd ? 52 : 42) * 16;
  const int n_out = 256;
  const int n_glu = odd ? 0 : 64;
  const int n_norm = NTOK / 16;
  const int total = n_in + n_out + n_glu + n_norm;
  bf16_t* WIN = (bf16_t*)(p.ws + OFF_WIN);
  bf16_t* WOUT = (bf16_t*)(p.ws + OFF_WOUT);
  bf16_t* WGLU = (bf16_t*)(p.ws + OFF_WGLU);
  bf16_t* H = (bf16_t*)(p.ws + OFF_HY);
  const float* MOD = (const float*)(p.ws + OFF_MOD);
  for (int u = blockIdx.x; u < total; u += gridDim.x) {
    if (u < n_in) {
      int nt = u >> 4, kt = u & 15;
      if (odd) convert_tile(p.in[I_WINO] + (size_t)e * 1024 * 3328, 3328, WIN, 1024, nt * 64, kt * 64, 0, tid);
      else convert_tile(p.in[I_WINE] + (size_t)e * 1024 * 2592, 2592, WIN, 1024, nt * 64, kt * 64, 1, tid);
    } else if (u < n_in + n_out) {
      int v = u - n_in; int nt = v >> 4, kt = v & 15;
      const float* src = (odd ? p.in[I_WOUTO] : p.in[I_WOUTE]) + (size_t)e * 1024 * 1024;
      convert_tile(src, 1024, WOUT, 1024, nt * 64, kt * 64, 0, tid);
    } else if (u < n_in + n_out + n_glu) {
      int v = u - n_in - n_out; int nt = v >> 3, kt = v & 7;
      convert_tile(p.in[I_WGLU] + (size_t)e * 512 * 512, 512, WGLU, 512, nt * 64, kt * 64, 0, tid);
    } else {
      int v = u - n_in - n_out - n_glu;
      const int tok0 = v * 16 + (tid >> 6) * 4;
      const int lane = tid & 63;
      const float* x;
      if (l == 0) x = (tok0 < NTOK_P) ? p.in[I_XP] + (size_t)tok0 * DM : p.in[I_XS] + (size_t)(tok0 - NTOK_P) * DM;
      else x = p.out + (size_t)tok0 * DM;
      const int j = (tok0 < NTOK_P) ? 0 : 1 + ((tok0 - NTOK_P) >> 12);
      const float* mod = MOD + (l * 5 + j) * 3072;
      const float* nw = p.in[I_NORMW] + l * 1024;
      float4 xv[4][4];
#pragma unroll
      for (int rr = 0; rr < 4; ++rr)
#pragma unroll
        for (int i = 0; i < 4; ++i) {
          typedef float nt_f4 __attribute__((ext_vector_type(4)));
          nt_f4 t_ = __builtin_nontemporal_load((const nt_f4*)(x + (size_t)rr * DM + lane * 4 + 256 * i));
          xv[rr][i] = make_float4(t_[0], t_[1], t_[2], t_[3]);
        }
      float rstd[4];
#pragma unroll
      for (int rr = 0; rr < 4; ++rr) {
        float ss = 0.f;
#pragma unroll
        for (int i = 0; i < 4; ++i) ss += xv[rr][i].x * xv[rr][i].x + xv[rr][i].y * xv[rr][i].y + xv[rr][i].z * xv[rr][i].z + xv[rr][i].w * xv[rr][i].w;
#pragma unroll
        for (int o = 32; o >= 1; o >>= 1) ss += __shfl_xor(ss, o);
        rstd[rr] = rsqrtf(ss * (1.f / 1024.f) + EPSF);
      }
#pragma unroll
      for (int i = 0; i < 4; ++i) {
        const int k = lane * 4 + 256 * i;
        float4 w4 = *(const float4*)(nw + k);
        float4 sh = *(const float4*)(mod + k);
        float4 scl = *(const float4*)(mod + 1024 + k);
        const float c0 = w4.x * (1.f + scl.x), c1 = w4.y * (1.f + scl.y), c2 = w4.z * (1.f + scl.z), c3 = w4.w * (1.f + scl.w);
#pragma unroll
        for (int rr = 0; rr < 4; ++rr) {
          float h0 = xv[rr][i].x * rstd[rr] * c0 + sh.x;
          float h1 = xv[rr][i].y * rstd[rr] * c1 + sh.y;
          float h2 = xv[rr][i].z * rstd[rr] * c2 + sh.z;
          float h3 = xv[rr][i].w * rstd[rr] * c3 + sh.w;
          *(uint2*)(H + (size_t)(tok0 + rr) * DM + k) = make_uint2(pack2(h0, h1), pack2(h2, h3));
        }
      }
    }
  }
}

#define GLD 72
enum { EPI_P = 0, EPI_RES = 1, EPI_GLU = 2 };

template <int EPI, int KT>
DI void gemm_phase(const Params& p, int l, const bf16_t* A, int lda, const bf16_t* Bt, int ldb,
                           int NT, int ldp, char* smem) {
  const int tid = otid(), lane = tid & 63, w = tid >> 6;
  const int r = lane & 31, h = lane >> 5;
  const int wm = w >> 1, wn = w & 1;
  bf16_t* As = (bf16_t*)smem;
  bf16_t* Bs = As + 2 * 128 * GLD;
  const int lr = tid >> 3, lc = (tid & 7) * 8;
  const int MT = NTOK / 128;
  const int total = MT * NT;
  const float* MOD = (const float*)(p.ws + OFF_MOD);
  const int nslot = gridDim.x >> 3;
  if (blockIdx.x >= (gridDim.x >> 1)) { __builtin_amdgcn_s_sleep(56); }
  for (int k = 0;; ++k) {
    const int t = ((blockIdx.x & 7) + 8 * k) * nslot + (blockIdx.x >> 3);
    if (t >= total) break;
    const int band = t / (8 * NT), rem = t - band * 8 * NT;
    const int nt = rem >> 3, mt = band * 8 + (rem & 7);
    const int m0 = mt * 128, n0 = nt * 128;
    const bf16_t* Ag = A + (size_t)(m0 + lr) * lda + lc;
    const bf16_t* Bg = Bt + (size_t)(n0 + lr) * ldb + lc;
    uint4 xa0, xa1, xa2, xa3, xb0, xb1, xb2, xb3;
    uint4 ya0, ya1, ya2, ya3, yb0, yb1, yb2, yb3;
#define GLOADS(S, KOFS) \
    S##a0 = *(const uint4*)(Ag + (KOFS)); S##a1 = *(const uint4*)(Ag + (size_t)32 * lda + (KOFS)); \
    S##a2 = *(const uint4*)(Ag + (size_t)64 * lda + (KOFS)); S##a3 = *(const uint4*)(Ag + (size_t)96 * lda + (KOFS)); \
    S##b0 = *(const uint4*)(Bg + (KOFS)); S##b1 = *(const uint4*)(Bg + (size_t)32 * ldb + (KOFS)); \
    S##b2 = *(const uint4*)(Bg + (size_t)64 * ldb + (KOFS)); S##b3 = *(const uint4*)(Bg + (size_t)96 * ldb + (KOFS));
#define LSTORES(S, ST) \
    *(uint4*)(As + (ST) * 128 * GLD + (lr) * GLD + lc) = S##a0; *(uint4*)(As + (ST) * 128 * GLD + (lr + 32) * GLD + lc) = S##a1; \
    *(uint4*)(As + (ST) * 128 * GLD + (lr + 64) * GLD + lc) = S##a2; *(uint4*)(As + (ST) * 128 * GLD + (lr + 96) * GLD + lc) = S##a3; \
    *(uint4*)(Bs + (ST) * 128 * GLD + (lr) * GLD + lc) = S##b0; *(uint4*)(Bs + (ST) * 128 * GLD + (lr + 32) * GLD + lc) = S##b1; \
    *(uint4*)(Bs + (ST) * 128 * GLD + (lr + 64) * GLD + lc) = S##b2; *(uint4*)(Bs + (ST) * 128 * GLD + (lr + 96) * GLD + lc) = S##b3;
    bf16x8 fa0[4], fa1[4], fb0[4], fb1[4];
#define FRAGS(ST) { \
      const bf16_t* as = As + (ST) * 128 * GLD + (wm * 64 + r) * GLD + h * 8; \
      const bf16_t* bs = Bs + (ST) * 128 * GLD + (wn * 64 + r) * GLD + h * 8; \
      _Pragma("unroll") for (int s = 0; s < 4; ++s) { \
        fa0[s] = *(const bf16x8*)(as + s * 16); \
        fb0[s] = *(const bf16x8*)(bs + s * 16); \
        fa1[s] = *(const bf16x8*)(as + 32 * GLD + s * 16); \
        fb1[s] = *(const bf16x8*)(bs + 32 * GLD + s * 16); \
      } \
      __builtin_amdgcn_sched_barrier(0); }
#define MFMAS() { \
      _Pragma("unroll") for (int s = 0; s < 4; ++s) { \
        acc00 = mfma(fa0[s], fb0[s], acc00); acc01 = mfma(fa0[s], fb1[s], acc01); \
        acc10 = mfma(fa1[s], fb0[s], acc10); acc11 = mfma(fa1[s], fb1[s], acc11); \
      } \
      _Pragma("unroll") for (int g = 0; g < 8; ++g) { \
        __builtin_amdgcn_sched_group_barrier(0x008, 2, 0); \
        __builtin_amdgcn_sched_group_barrier(0x200, 1, 0); \
        __builtin_amdgcn_sched_group_barrier(0x020, 1, 0); \
      } }
    GLOADS(x, 0)
    LSTORES(x, 0)
    GLOADS(x, 64)
    GLOADS(y, 128)
    __syncthreads();
    f32x16 acc00 = zero16(), acc01 = zero16(), acc10 = zero16(), acc11 = zero16();
#pragma unroll
    for (int kt = 0; kt < KT; kt += 2) {
      FRAGS(0)
      LSTORES(x, 1)
      if (kt + 3 < KT) { GLOADS(x, (kt + 3) * 64) }
      MFMAS()
      __syncthreads();
      __builtin_amdgcn_sched_barrier(0);
      FRAGS(1)
      if (kt + 2 < KT) { LSTORES(y, 0) }
      if (kt + 4 < KT) { GLOADS(y, (kt + 4) * 64) }
      MFMAS()
      __syncthreads();
      __builtin_amdgcn_sched_barrier(0);
    }
#undef FRAGS
#undef MFMAS
#undef GLOADS
#undef LSTORES
    {
      float* Cs = (float*)smem;
      const int er = tid >> 4, ec = (tid & 15) * 8;
      const int jm = (m0 < NTOK_P) ? 0 : 1 + ((m0 - NTOK_P) >> 12);
      float4 px[8][2];
      uint4 pz[8][2];
      if (EPI == EPI_RES) {
        const float* xsrc;
        if (l == 0) xsrc = (m0 < NTOK_P) ? p.in[I_XP] : p.in[I_XS] - (size_t)NTOK_P * DM;
        else xsrc = p.out;
#pragma unroll
        for (int ps = 0; ps < 8; ++ps) {
          const float* xp_ = xsrc + (size_t)(m0 + ps * 16 + er) * DM + n0 + ec;
          px[ps][0] = *(const float4*)xp_; px[ps][1] = *(const float4*)(xp_ + 4);
        }
      } else if (EPI == EPI_GLU) {
        const bf16_t* Pz = (const bf16_t*)(p.ws + OFF_P);
        const bf16_t* Z5z = (const bf16_t*)(p.ws + OFF_Z5);
#pragma unroll
        for (int ps = 0; ps < 8; ++ps) {
          const size_t gr = (size_t)(m0 + ps * 16 + er);
          pz[ps][0] = *(const uint4*)(Z5z + gr * 512 + n0 + ec);
          pz[ps][1] = *(const uint4*)(Pz + gr * LDP_E + PE_ZS + n0 + ec);
        }
      }
#pragma unroll
      for (int q = 0; q < 16; ++q) {
        const int rr = wm * 64 + crow(q, h), cc = wn * 64 + r;
        Cs[rr * 132 + cc] = acc00[q];
        Cs[rr * 132 + cc + 32] = acc01[q];
        Cs[(rr + 32) * 132 + cc] = acc10[q];
        Cs[(rr + 32) * 132 + cc + 32] = acc11[q];
      }
      __syncthreads();
#pragma unroll
      for (int ps = 0; ps < 8; ++ps) {
        const int row = ps * 16 + er;
        const float4 c0 = *(const float4*)(Cs + row * 132 + ec);
        const float4 c1 = *(const float4*)(Cs + row * 132 + ec + 4);
        const size_t grow = (size_t)(m0 + row);
        const int gcol = n0 + ec;
        if (EPI == EPI_P) {
          bf16_t* P = (bf16_t*)(p.ws + OFF_P);
          *(uint4*)(P + grow * ldp + gcol) = make_uint4(pack2(c0.x, c0.y), pack2(c0.z, c0.w), pack2(c1.x, c1.y), pack2(c1.z, c1.w));
        } else if (EPI == EPI_RES) {
          const float* gate = MOD + (l * 5 + jm) * 3072 + 2048 + gcol;
          const float4 g0 = *(const float4*)gate, g1 = *(const float4*)(gate + 4);
          const float4 x0 = px[ps][0], x1 = px[ps][1];
          float4 o0, o1;
          o0.x = x0.x + g0.x * c0.x; o0.y = x0.y + g0.y * c0.y; o0.z = x0.z + g0.z * c0.z; o0.w = x0.w + g0.w * c0.w;
          o1.x = x1.x + g1.x * c1.x; o1.y = x1.y + g1.y * c1.y; o1.z = x1.z + g1.z * c1.z; o1.w = x1.w + g1.w * c1.w;
          *(float4*)(p.out + grow * DM + gcol) = o0;
          *(float4*)(p.out + grow * DM + gcol + 4) = o1;
        } else {
          const bf16_t* P = (const bf16_t*)(p.ws + OFF_P);
          const bf16_t* Z5 = (const bf16_t*)(p.ws + OFF_Z5);
          bf16_t* Y = (bf16_t*)(p.ws + OFF_HY);
          const float* bglu = p.in[I_BGLU] + (l >> 1) * 512 + gcol;
          const float4 b0 = *(const float4*)bglu, b1 = *(const float4*)(bglu + 4);
          const uint4 zv = pz[ps][0];
          const uint4 zs = pz[ps][1];
#define GLU1(ZW, SW, CA, CB, BA, BB) pack2(__uint_as_float((ZW) << 16) * sigmf((CA) + (BA)) * siluf(__uint_as_float((SW) << 16)), \
                                           __uint_as_float((ZW) & 0xffff0000u) * sigmf((CB) + (BB)) * siluf(__uint_as_float((SW) & 0xffff0000u)))
          uint4 o;
          o.x = GLU1(zv.x, zs.x, c0.x, c0.y, b0.x, b0.y);
          o.y = GLU1(zv.y, zs.y, c0.z, c0.w, b0.z, b0.w);
          o.z = GLU1(zv.z, zs.z, c1.x, c1.y, b1.x, b1.y);
          o.w = GLU1(zv.w, zs.w, c1.z, c1.w, b1.z, b1.w);
#undef GLU1
          *(uint4*)(Y + grow * DM + 512 + gcol) = o;
        }
      }
      __syncthreads();
    }
  }
}

#define GL 72
struct GlaSmem {
  bf16_t Qd[64 * GL];
  bf16_t Kn[64 * GL];
  bf16_t KdT[64 * GL];
  bf16_t Att[64 * GL];
  bf16_t VT[128 * GL];
  bf16_t ST[128 * GL];
  float lfS[64 * 16];
  float qtot[4 * 64];
  float Dl[64];
  float Gtot[64];
};
#define OLD 132
static_assert(sizeof(GlaSmem) <= SMEM_BYTES, "GLA smem");

template <bool FULL>
DI void gla_sweep(const Params& p, int e, int hd, int dir, int tok0, f32x16 (&sacc)[2], GlaSmem& S) {
  const int tid = otid(), lane = tid & 63, w = tid >> 6;
  const int r = lane & 31, h = lane >> 5;
  const bf16_t* P = (const bf16_t*)(p.ws + OFF_P);
  bf16_t* Y = (bf16_t*)(p.ws + OFF_HY);
  const int tq = tid >> 6;
  if (tid < 64) S.Gtot[tid] = 0.f;
  unsigned w2p[8];
  float bias;
  {
    const int d0 = tid & 63;
#pragma unroll
    for (int i = 0; i < 8; ++i)
      w2p[i] = pack2(p.in[I_GW2][((size_t)(e * 2 + dir) * 16 + 2 * i) * 256 + hd * 64 + d0],
                     p.in[I_GW2][((size_t)(e * 2 + dir) * 16 + 2 * i + 1) * 256 + hd * 64 + d0]);
    bias = p.in[I_GB2][(e * 2 + dir) * 256 + hd * 64 + d0];
  }
  __syncthreads();
  if (FULL) {
#pragma unroll
    for (int ni = 0; ni < 2; ++ni)
#pragma unroll
      for (int q = 0; q < 16; ++q) S.ST[(w * 32 + crow(q, h)) * GL + ni * 32 + r] = f2bf(sacc[ni][q]);
  }
  uint4 pq0, pq1, pk0, pk1;
  bf16_t plf[4];
  pq0 = pq1 = pk0 = pk1 = make_uint4(0, 0, 0, 0);
  plf[0] = plf[1] = plf[2] = plf[3] = 0;
#pragma unroll 1
  for (int cc = 0; cc < 4; ++cc) {
    const int c = dir ? 3 - cc : cc;
    const int ct0 = tok0 + c * 64;
    const int tv = tid & 63, cgp = tid >> 6;
    uint4 v0, v1, v2, v3;
    {
      const bf16_t* vsrc = P + (size_t)(ct0 + tv) * LDP_E + PE_V + hd * 128 + cgp * 32;
      v0 = *(const uint4*)(vsrc); v1 = *(const uint4*)(vsrc + 8); v2 = *(const uint4*)(vsrc + 16); v3 = *(const uint4*)(vsrc + 24);
    }
    {
      const int row = tid >> 2, c8 = (tid & 3) * 16;
      if (cc == 0) {
        const bf16_t* src = P + (size_t)(ct0 + row) * LDP_E + hd * 64 + c8;
        pk0 = *(const uint4*)(src + PE_K); pk1 = *(const uint4*)(src + PE_K + 8);
        if (FULL) { pq0 = *(const uint4*)(src + PE_Q); pq1 = *(const uint4*)(src + PE_Q + 8); }
#pragma unroll
        for (int i = 0; i < 4; ++i) {
          int idx = tid + 256 * i; int t = idx >> 4, rr = idx & 15;
          plf[i] = P[(size_t)(ct0 + t) * LDP_E + PE_LF + dir * 16 + rr];
        }
      }
#pragma unroll
      for (int i = 0; i < 4; ++i) S.lfS[tid + 256 * i] = bf2f(plf[i]);
      *(uint4*)(S.Kn + row * GL + c8) = pk0; *(uint4*)(S.Kn + row * GL + c8 + 8) = pk1;
      if (FULL) { *(uint4*)(S.Qd + row * GL + c8) = pq0; *(uint4*)(S.Qd + row * GL + c8 + 8) = pq1; }
      if (cc < 3) {
        const int cn = dir ? 2 - cc : cc + 1;
        const int cn0 = tok0 + cn * 64;
        const bf16_t* src = P + (size_t)(cn0 + row) * LDP_E + hd * 64 + c8;
        pk0 = *(const uint4*)(src + PE_K); pk1 = *(const uint4*)(src + PE_K + 8);
        if (FULL) { pq0 = *(const uint4*)(src + PE_Q); pq1 = *(const uint4*)(src + PE_Q + 8); }
#pragma unroll
        for (int i = 0; i < 4; ++i) {
          int idx = tid + 256 * i; int t = idx >> 4, rr = idx & 15;
          plf[i] = P[(size_t)(cn0 + t) * LDP_E + PE_LF + dir * 16 + rr];
        }
      }
    }
    __syncthreads();
    const int d = tid & 63;
    float w2r[16];
#pragma unroll
    for (int i = 0; i < 8; ++i) { w2r[2 * i] = __uint_as_float(w2p[i] << 16); w2r[2 * i + 1] = __uint_as_float(w2p[i] & 0xffff0000u); }
    float g[16];
    float run = 0.f;
#pragma unroll
    for (int i = 0; i < 16; ++i) {
      int t = tq * 16 + i;
      float x = bias;
#pragma unroll
      for (int rr = 0; rr < 16; ++rr) x += S.lfS[t * 16 + rr] * w2r[rr];
      float ls = fminf(x, 0.f) - __logf(1.f + __expf(-fabsf(x)));
      g[i] = ls * (1.f / 16.f);
      run += g[i];
    }
    S.qtot[tq * 64 + d] = run;
    __syncthreads();
    float q0 = S.qtot[d], q1 = S.qtot[64 + d], q2 = S.qtot[128 + d], q3 = S.qtot[192 + d];
    const float total = q0 + q1 + q2 + q3;
    float off;
    if (dir == 0) off = (tq > 0 ? q0 : 0.f) + (tq > 1 ? q1 : 0.f) + (tq > 2 ? q2 : 0.f);
    else off = (tq < 1 ? q1 : 0.f) + (tq < 2 ? q2 : 0.f) + (tq < 3 ? q3 : 0.f);
    float b[16];
    if (dir == 0) {
      float a = off;
#pragma unroll
      for (int i = 0; i < 16; ++i) { a += g[i]; b[i] = a; }
    } else {
      float a = off;
#pragma unroll
      for (int i = 15; i >= 0; --i) { a += g[i]; b[i] = a; }
    }
    if (tq == 0) { S.Dl[d] = __expf(total); S.Gtot[d] += total; }
    {
      unsigned kd[8];
      float kprev = 0.f;
#pragma unroll
      for (int i = 0; i < 16; ++i) {
        int t = tq * 16 + i;
        float kv = bf2f(S.Kn[t * GL + d]);
        if (FULL) {
          float qv = bf2f(S.Qd[t * GL + d]);
          S.Qd[t * GL + d] = f2bf(qv * 0.125f * __expf(b[i]));
          S.Kn[t * GL + d] = f2bf(kv * __expf(-b[i]));
        }
        float kdv = kv * __expf(total - b[i]);
        if (i & 1) kd[i >> 1] = pack2(kprev, kdv); else kprev = kdv;
      }
      uint4* dst = (uint4*)(S.KdT + d * GL + tq * 16);
      dst[0] = make_uint4(kd[0], kd[1], kd[2], kd[3]);
      dst[1] = make_uint4(kd[4], kd[5], kd[6], kd[7]);
    }
    {
      bf16_t* vd = S.VT + (cgp * 32) * GL + tv;
#define VTW(VV, B) vd[((B) + 0) * GL] = (bf16_t)(VV.x & 0xffffu); vd[((B) + 1) * GL] = (bf16_t)(VV.x >> 16); \
                   vd[((B) + 2) * GL] = (bf16_t)(VV.y & 0xffffu); vd[((B) + 3) * GL] = (bf16_t)(VV.y >> 16); \
                   vd[((B) + 4) * GL] = (bf16_t)(VV.z & 0xffffu); vd[((B) + 5) * GL] = (bf16_t)(VV.z >> 16); \
                   vd[((B) + 6) * GL] = (bf16_t)(VV.w & 0xffffu); vd[((B) + 7) * GL] = (bf16_t)(VV.w >> 16);
      VTW(v0, 0) VTW(v1, 8) VTW(v2, 16) VTW(v3, 24)
#undef VTW
    }
    __syncthreads();
    const int mi = w >> 1;
    f32x16 oacc[2];
    bf16_t* orec = Y + (size_t)(ct0 + mi * 32 + h * 16 + (r >> 1)) * DM + hd * 128 + (w & 1) * 64 + (r & 1) * 16;
    uint4 of0 = make_uint4(0, 0, 0, 0), of1 = of0, of2 = of0, of3 = of0, zg0 = of0, zg1 = of0, zg2 = of0, zg3 = of0;
    if (FULL && dir) {
      of0 = *(const uint4*)(orec); of1 = *(const uint4*)(orec + 8);
      of2 = *(const uint4*)(orec + 32); of3 = *(const uint4*)(orec + 40);
      const bf16_t* zg = P + (size_t)(ct0 + (tid >> 2)) * LDP_E + PE_ZG + hd * 128 + (tid & 3) * 32;
      zg0 = *(const uint4*)(zg); zg1 = *(const uint4*)(zg + 8); zg2 = *(const uint4*)(zg + 16); zg3 = *(const uint4*)(zg + 24);
    }
    if (FULL) {
      const int ni = w & 1;
      const bool skip = dir ? (ni < mi) : (ni > mi);
      f32x16 a = zero16();
      if (!skip) mma_tile<64>(a, S.Qd + mi * 32 * GL, GL, S.Kn + ni * 32 * GL, GL, lane);
#pragma unroll
      for (int q = 0; q < 16; ++q) {
        int i = mi * 32 + crow(q, h), j = ni * 32 + r;
        bool keep = dir ? (j >= i) : (j <= i);
        S.Att[i * GL + j] = f2bf(keep ? a[q] : 0.f);
      }
#pragma unroll
      for (int jj = 0; jj < 2; ++jj) {
        int nj = (w & 1) * 2 + jj;
        oacc[jj] = zero16();
        mma_tile<64>(oacc[jj], S.Qd + mi * 32 * GL, GL, S.ST + nj * 32 * GL, GL, lane);
      }
      __syncthreads();
#pragma unroll
      for (int jj = 0; jj < 2; ++jj) {
        int nj = (w & 1) * 2 + jj;
        mma_tile<64>(oacc[jj], S.Att + mi * 32 * GL, GL, S.VT + nj * 32 * GL, GL, lane);
      }
    }
#pragma unroll
    for (int ni = 0; ni < 2; ++ni) {
      float dec = S.Dl[ni * 32 + r];
#pragma unroll
      for (int q = 0; q < 16; ++q) sacc[ni][q] *= dec;
      mma_tile<64>(sacc[ni], S.VT + w * 32 * GL, GL, S.KdT + ni * 32 * GL, GL, lane);
    }
    __syncthreads();
    if (FULL) {
#pragma unroll
      for (int ni = 0; ni < 2; ++ni)
#pragma unroll
        for (int q = 0; q < 16; ++q) S.ST[(w * 32 + crow(q, h)) * GL + ni * 32 + r] = f2bf(sacc[ni][q]);
      if (dir == 0) {
#pragma unroll
        for (int jj = 0; jj < 2; ++jj) {
          *(uint4*)(orec + jj * 32) = make_uint4(pack2(oacc[jj][0], oacc[jj][1]), pack2(oacc[jj][2], oacc[jj][3]), pack2(oacc[jj][4], oacc[jj][5]), pack2(oacc[jj][6], oacc[jj][7]));
          *(uint4*)(orec + jj * 32 + 8) = make_uint4(pack2(oacc[jj][8], oacc[jj][9]), pack2(oacc[jj][10], oacc[jj][11]), pack2(oacc[jj][12], oacc[jj][13]), pack2(oacc[jj][14], oacc[jj][15]));
        }
      } else {
        float* Ob = (float*)S.Qd;
        {
          const unsigned ofw[16] = {of0.x, of0.y, of0.z, of0.w, of1.x, of1.y, of1.z, of1.w, of2.x, of2.y, of2.z, of2.w, of3.x, of3.y, of3.z, of3.w};
#pragma unroll
          for (int jj = 0; jj < 2; ++jj) {
            int cl = ((w & 1) * 2 + jj) * 32 + r;
#pragma unroll
            for (int q = 0; q < 16; ++q) {
              int tl = mi * 32 + crow(q, h);
              const unsigned wv = ofw[jj * 8 + (q >> 1)];
              float prev = (q & 1) ? __uint_as_float(wv & 0xffff0000u) : __uint_as_float(wv << 16);
              Ob[tl * OLD + cl] = oacc[jj][q] + prev;
            }
          }
        }
        __syncthreads();
        {
          const int tl = tid >> 2, qtr = tid & 3;
          float ss = 0.f;
#pragma unroll
          for (int i = 0; i < 32; ++i) { float v = Ob[tl * OLD + qtr * 32 + i]; ss += v * v; }
          ss += __shfl_xor(ss, 1);
          ss += __shfl_xor(ss, 2);
          const float rstd = rsqrtf(ss * (1.f / 128.f) + EPSF);
          const float* onw = p.in[I_GON] + e * 128 + qtr * 32;
          bf16_t* yo = Y + (size_t)(ct0 + tl) * DM + hd * 128 + qtr * 32;
          const unsigned zgw[16] = {zg0.x, zg0.y, zg0.z, zg0.w, zg1.x, zg1.y, zg1.z, zg1.w, zg2.x, zg2.y, zg2.z, zg2.w, zg3.x, zg3.y, zg3.z, zg3.w};
#pragma unroll
          for (int i = 0; i < 32; i += 2) {
            unsigned zz = zgw[i >> 1];
            float y0 = Ob[tl * OLD + qtr * 32 + i] * rstd * onw[i] * siluf(__uint_as_float(zz << 16));
            float y1 = Ob[tl * OLD + qtr * 32 + i + 1] * rstd * onw[i + 1] * siluf(__uint_as_float(zz & 0xffff0000u));
            *(unsigned*)(yo + i) = pack2(y0, y1);
          }
        }
        __syncthreads();
      }
    }
  }
}

DI void gla_pass1_unit(const Params& p, int e, int u, char* smem) {
  GlaSmem& S = *(GlaSmem*)smem;
  const int tid = otid(), lane = tid & 63, w = tid >> 6;
  const int r = lane & 31, h = lane >> 5;
  const int seg = u >> 3, hd = (u >> 1) & 3, dir = u & 1;
  const int tok0 = NTOK_P + seg * 256;
  f32x16 sacc[2];
  sacc[0] = zero16(); sacc[1] = zero16();
  __syncthreads();
  gla_sweep<false>(p, e, hd, dir, tok0, sacc, S);
  float* L = (float*)(p.ws + OFF_GLAL) + (size_t)((seg * 4 + hd) * 2 + dir) * 8192;
#pragma unroll
  for (int ni = 0; ni < 2; ++ni)
#pragma unroll
    for (int q = 0; q < 16; ++q) L[(w * 32 + crow(q, h)) * 64 + ni * 32 + r] = sacc[ni][q];
  if (tid < 64) {
    float* D = (float*)(p.ws + OFF_GLAD) + ((seg * 4 + hd) * 2 + dir) * 64;
    D[tid] = expf(S.Gtot[tid]);
  }
  __syncthreads();
}

DI void gla_pass3_unit(const Params& p, int e, int u, char* smem) {
  GlaSmem& S = *(GlaSmem*)smem;
  const int tid = otid(), lane = tid & 63, w = tid >> 6;
  const int r = lane & 31, h = lane >> 5;
  const int seg = ((u >> 2) + 32) % 96, hd = u & 3;
  const int tok0 = seg * 256;
  const bool samp = seg >= 32;
  const int sb = samp ? (seg - 32) >> 4 : 0, sl = samp ? (seg - 32) & 15 : 0;
  const float* Lb = (const float*)(p.ws + OFF_GLAL);
  const float* Db = (const float*)(p.ws + OFF_GLAD);
  for (int dir = 0; dir < 2; ++dir) {
    f32x16 sacc[2];
    sacc[0] = zero16(); sacc[1] = zero16();
    if (samp) {
      const float* s0 = p.in[I_SGLA] + (size_t)(((sb * 2 + e) * 2 + dir) * 4 + hd) * 8192;
#pragma unroll
      for (int ni = 0; ni < 2; ++ni)
#pragma unroll
        for (int q = 0; q < 16; ++q) sacc[ni][q] = s0[(ni * 32 + r) * 128 + w * 32 + crow(q, h)];
      const int nst = dir ? 15 - sl : sl;
      float Lc[32], dc[2];
      {
        const int sp0 = dir ? 15 : 0;
        const int sidx0 = ((sb * 16 + sp0) * 4 + hd) * 2 + dir;
        const float* L0 = Lb + (size_t)sidx0 * 8192;
        const float* D0 = Db + sidx0 * 64;
#pragma unroll
        for (int ni = 0; ni < 2; ++ni) {
          dc[ni] = D0[ni * 32 + r];
#pragma unroll
          for (int q = 0; q < 16; ++q) Lc[ni * 16 + q] = L0[(w * 32 + crow(q, h)) * 64 + ni * 32 + r];
        }
      }
#pragma unroll 1
      for (int k = 0; k < nst; ++k) {
        float Ln[32], dn[2];
        const int kn = (k + 1 < nst) ? k + 1 : k;
        const int sp = dir ? 15 - kn : kn;
        const int sidx = ((sb * 16 + sp) * 4 + hd) * 2 + dir;
        const float* L = Lb + (size_t)sidx * 8192;
        const float* D = Db + sidx * 64;
#pragma unroll
        for (int ni = 0; ni < 2; ++ni) {
          dn[ni] = D[ni * 32 + r];
#pragma unroll
          for (int q = 0; q < 16; ++q) Ln[ni * 16 + q] = L[(w * 32 + crow(q, h)) * 64 + ni * 32 + r];
        }
#pragma unroll
        for (int ni = 0; ni < 2; ++ni)
#pragma unroll
          for (int q = 0; q < 16; ++q) sacc[ni][q] = sacc[ni][q] * dc[ni] + Lc[ni * 16 + q];
#pragma unroll
        for (int i = 0; i < 32; ++i) Lc[i] = Ln[i];
        dc[0] = dn[0]; dc[1] = dn[1];
      }
    }
    __syncthreads();
    gla_sweep<true>(p, e, hd, dir, tok0, sacc, S);
    if (!samp) {
      float* o = p.out + OUT_GLA + (size_t)(((seg * 2 + e) * 2 + dir) * 4 + hd) * 8192;
#pragma unroll
      for (int ni = 0; ni < 2; ++ni)
#pragma unroll
        for (int q = 0; q < 16; ++q) o[(ni * 32 + r) * 128 + w * 32 + crow(q, h)] = sacc[ni][q];
    }
    __syncthreads();
  }
}

#define XLD 136
#define WSYNC() do { __builtin_amdgcn_fence(__ATOMIC_RELEASE, "wavefront"); __builtin_amdgcn_wave_barrier(); __builtin_amdgcn_fence(__ATOMIC_ACQUIRE, "wavefront"); } while (0)
DI void s5_sweep(const Params& p, int e, int g, int dir, int mode, int tok0, float& hr, float& hi, bf16_t* X) {
  const int lane = otid() & 63;
  const int r = lane & 31, h = lane >> 5;
  const bf16_t* P = (const bf16_t*)(p.ws + OFF_P);
  bf16_t* Z5 = (bf16_t*)(p.ws + OFF_Z5);
  bf16_t* Yb = (bf16_t*)(p.ws + OFF_HY);
  const float* LB = (const float*)(p.ws + OFF_LB) + (size_t)(((e * 2 + dir) * 32 + g) * 64 + lane) * 2;
  const float lbr = LB[0], lbi = LB[1];
  const bf16_t* BBT = (const bf16_t*)(p.ws + OFF_BBT) + (size_t)((e * 2 + dir) * 32 + g) * 128 * 16;
  const bf16_t* CM = (const bf16_t*)(p.ws + OFF_CM) + (size_t)(e * 32 + g) * 32 * 128;
  bf16x8 bfr[4];
#pragma unroll
  for (int j = 0; j < 4; ++j) bfr[j] = *(const bf16x8*)(BBT + (32 * j + r) * 16 + 8 * h);
  bf16x8 cfr[8];
#pragma unroll
  for (int s = 0; s < 8; ++s) cfr[s] = *(const bf16x8*)(CM + r * 128 + s * 16 + h * 8);
  bf16x8 dfr;
  {
    const short dv = (r < 16) ? (short)f2bf(p.in[I_S5D][e * 512 + g * 16 + r]) : (short)0;
#pragma unroll
    for (int j = 0; j < 8; ++j) dfr[j] = (8 * h + j == r) ? dv : (short)0;
  }
  const bf16_t* Ub = P + (size_t)(tok0 + r) * LDP_E + PE_U + g * 16 + 8 * h;
  bf16x8 a_cur = *(const bf16x8*)(Ub + (size_t)((dir ? 7 : 0) * 32) * LDP_E);
#pragma unroll 1
  for (int ss = 0; ss < 8; ++ss) {
    const int sc = dir ? 7 - ss : ss;
    const int t0 = tok0 + sc * 32;
    bf16x8 a_nxt = a_cur;
    if (ss < 7) a_nxt = *(const bf16x8*)(Ub + (size_t)((dir ? 6 - ss : ss + 1) * 32) * LDP_E);
    bf16_t* prec = Yb + (size_t)(t0 + 16 * h + (r & 15)) * DM + 512 + g * 16;
    uint4 pp0 = make_uint4(0, 0, 0, 0), pp1 = make_uint4(0, 0, 0, 0);
    if (mode == 2 && r < 16) { pp0 = *(const uint4*)prec; pp1 = *(const uint4*)(prec + 8); }
#pragma unroll
    for (int jp = 0; jp < 2; ++jp) {
      f32x16 are = mfma(a_cur, bfr[2 * jp], zero16());
      f32x16 aim = mfma(a_cur, bfr[2 * jp + 1], zero16());
#pragma unroll
      for (int q = 0; q < 16; ++q) *(unsigned*)(X + crow(q, h) * XLD + 2 * (32 * jp + r)) = pack2(are[q], aim[q]);
    }
    WSYNC();
#define S5STEP(T) { float br = __uint_as_float(wv[T] << 16), bi = __uint_as_float(wv[T] & 0xffff0000u); \
        float nr = lbr * hr - lbi * hi + br; float ni = lbr * hi + lbi * hr + bi; hr = nr; hi = ni; wv[T] = pack2(nr, ni); }
#pragma unroll
    for (int hf = 0; hf < 2; ++hf) {
      bf16_t* Xh = X + ((dir ? 1 - hf : hf) * 16) * XLD + 2 * lane;
      unsigned wv[16];
#pragma unroll
      for (int tt = 0; tt < 16; ++tt) wv[tt] = *(const unsigned*)(Xh + tt * XLD);
      if (dir == 0) {
#pragma unroll
        for (int tt = 0; tt < 16; ++tt) S5STEP(tt)
      } else {
#pragma unroll
        for (int tt = 15; tt >= 0; --tt) S5STEP(tt)
      }
#pragma unroll
      for (int tt = 0; tt < 16; ++tt) *(unsigned*)(Xh + tt * XLD) = wv[tt];
    }
#undef S5STEP
    WSYNC();
    if (mode >= 1) {
      f32x16 acc = zero16();
#pragma unroll
      for (int s = 0; s < 8; ++s) {
        bf16x8 xa = *(const bf16x8*)(X + r * XLD + s * 16 + h * 8);
        acc = mfma(xa, cfr[s], acc);
      }
      if (mode == 2) acc = mfma(a_cur, dfr, acc);
      if (r < 16) {
        if (mode == 1) {
          *(uint4*)prec = make_uint4(pack2(acc[0], acc[1]), pack2(acc[2], acc[3]), pack2(acc[4], acc[5]), pack2(acc[6], acc[7]));
          *(uint4*)(prec + 8) = make_uint4(pack2(acc[8], acc[9]), pack2(acc[10], acc[11]), pack2(acc[12], acc[13]), pack2(acc[14], acc[15]));
        } else {
          const unsigned pw[8] = {pp0.x, pp0.y, pp0.z, pp0.w, pp1.x, pp1.y, pp1.z, pp1.w};
          const int col = g * 16 + r;
#pragma unroll
          for (int q = 0; q < 16; ++q) {
            const float prev = (q & 1) ? __uint_as_float(pw[q >> 1] & 0xffff0000u) : __uint_as_float(pw[q >> 1] << 16);
            const float y = acc[q] + prev;
            const float t3 = 1.5957691216057308f * (y + 0.044715f * y * y * y);
            Z5[(size_t)(t0 + crow(q, h)) * 512 + col] = f2bf(y * sigmf(t3));
          }
        }
      }
    }
    WSYNC();
    a_cur = a_nxt;
  }
}

DI void s5_pass1_unit(const Params& p, int e, int u, char* smem) {
  const int tid = otid(), lane = tid & 63, w = tid >> 6;
  const int seg = u >> 3, g = (u & 7) * 4 + w;
  bf16_t* X = (bf16_t*)smem + w * 32 * XLD;
  float* ES = (float*)(p.ws + OFF_S5ES);
  for (int dir = 0; dir < 2; ++dir) {
    float hr = 0.f, hi = 0.f;
    s5_sweep(p, e, g, dir, 0, NTOK_P + seg * 256, hr, hi, X);
    size_t o = ((size_t)((seg * 32 + g) * 2 + dir) * 64 + lane) * 2;
    ES[o] = hr; ES[o + 1] = hi;
  }
}

DI void s5_pass3_unit(const Params& p, int e, int u, char* smem) {
  const int tid = otid(), lane = tid & 63, w = tid >> 6;
  const int seg = u >> 3, g = (u & 7) * 4 + w;
  bf16_t* X = (bf16_t*)smem + w * 32 * XLD;
  const bool samp = seg >= 32;
  const int sb = samp ? (seg - 32) >> 4 : 0, sl = samp ? (seg - 32) & 15 : 0;
  const float* ES = (const float*)(p.ws + OFF_S5ES);
  for (int dir = 0; dir < 2; ++dir) {
    float hr = 0.f, hi = 0.f;
    if (samp) {
      const size_t si = (size_t)(((sb * 2 + e) * 2 + dir) * 32 + g) * 64 + lane;
      hr = p.in[I_S5R][si]; hi = p.in[I_S5I][si];
      const float* L2 = (const float*)(p.ws + OFF_LB256) + (size_t)(((e * 2 + dir) * 32 + g) * 64 + lane) * 2;
      const float ar = L2[0], ai = L2[1];
      const int nst = dir ? 15 - sl : sl;
      float er[15], ei[15];
#pragma unroll
      for (int k = 0; k < 15; ++k) {
        const int kk = k < nst ? k : 0;
        const int sp = dir ? 15 - kk : kk;
        size_t o = ((size_t)(((sb * 16 + sp) * 32 + g) * 2 + dir) * 64 + lane) * 2;
        float2 ev = *(const float2*)(ES + o);
        er[k] = ev.x; ei[k] = ev.y;
      }
#pragma unroll
      for (int k = 0; k < 15; ++k) {
        if (k < nst) {
          float nr = ar * hr - ai * hi + er[k];
          float ni = ar * hi + ai * hr + ei[k];
          hr = nr; hi = ni;
        }
      }
    }
    s5_sweep(p, e, g, dir, dir + 1, seg * 256, hr, hi, X);
    if (!samp) {
      const size_t so = (size_t)(((seg * 2 + e) * 2 + dir) * 32 + g) * 64 + lane;
      p.out[OUT_S5R + so] = hr;
      p.out[OUT_S5I + so] = hi;
    }
  }
}

#define AL 72
template <int W>
DI void qk_prep(const bf16_t* src, const float* nw, bool rope, int pos, float mult, int sub, const float* RT,
                bf16_t* dst, float* fdst) {
  float x[4][W];
#pragma unroll
  for (int c = 0; c < 4; ++c) {
    if (W == 4) {
      uint2 v = *(const uint2*)(src + 16 * c + 4 * sub);
      x[c][0] = __uint_as_float(v.x << 16); x[c][1] = __uint_as_float(v.x & 0xffff0000u);
      x[c][2] = __uint_as_float(v.y << 16); x[c][3] = __uint_as_float(v.y & 0xffff0000u);
    } else {
      uint4 v = *(const uint4*)(src + 16 * c + 8 * sub);
      x[c][0] = __uint_as_float(v.x << 16); x[c][1] = __uint_as_float(v.x & 0xffff0000u);
      x[c][2] = __uint_as_float(v.y << 16); x[c][3] = __uint_as_float(v.y & 0xffff0000u);
      x[c][4 % W] = __uint_as_float(v.z << 16); x[c][5 % W] = __uint_as_float(v.z & 0xffff0000u);
      x[c][6 % W] = __uint_as_float(v.w << 16); x[c][7 % W] = __uint_as_float(v.w & 0xffff0000u);
    }
  }
  float ss = 0.f;
#pragma unroll
  for (int c = 0; c < 4; ++c)
#pragma unroll
    for (int i = 0; i < W; ++i) ss += x[c][i] * x[c][i];
  ss += __shfl_xor(ss, 1);
  if (W == 4) ss += __shfl_xor(ss, 2);
  const float rstd = rsqrtf(ss * (1.f / 64.f) + EPSF);
#pragma unroll
  for (int c = 0; c < 4; ++c)
#pragma unroll
    for (int i = 0; i < W; ++i) x[c][i] *= rstd * nw[16 * c + W * sub + i];
  if (rope) {
    const int row = pos >> 6, col = pos & 63;
#pragma unroll
    for (int i = 0; i < W; ++i) {
      const int f = W * sub + i;
      float cs = RT[(row * 16 + f) * 2], sn = RT[(row * 16 + f) * 2 + 1];
      float x1 = x[0][i], x2 = x[1][i];
      x[0][i] = x1 * cs - x2 * sn; x[1][i] = x2 * cs + x1 * sn;
      cs = RT[(col * 16 + f) * 2]; sn = RT[(col * 16 + f) * 2 + 1];
      x1 = x[2][i]; x2 = x[3][i];
      x[2][i] = x1 * cs - x2 * sn; x[3][i] = x2 * cs + x1 * sn;
    }
  }
#pragma unroll
  for (int c = 0; c < 4; ++c)
#pragma unroll
    for (int i = 0; i < W; ++i) {
      dst[16 * c + W * sub + i] = f2bf(x[c][i] * mult);
      if (fdst) fdst[16 * c + W * sub + i] = x[c][i];
    }
}

DI void attn_unit(const Params& p, int e, int u, char* smem) {
  const int tid = otid(), lane = tid & 63, w = tid >> 6;
  const int r = lane & 31, h = lane >> 5;
  bf16_t* Ks = (bf16_t*)smem;
  bf16_t* Vt = Ks + 64 * AL;
  bf16_t* Qs = Vt + 64 * AL;
  const bf16_t* P = (const bf16_t*)(p.ws + OFF_P);
  bf16_t* Y = (bf16_t*)(p.ws + OFF_HY);
  const float* RT = (const float*)(p.ws + OFF_ROPE);
  const bool lat = u >= 512;
  int b, kvh, qb;
  if (!lat) { b = u >> 4; kvh = (u >> 3) & 1; qb = u & 7; }
  else { int v = u - 512; b = v >> 8; kvh = (v >> 7) & 1; qb = v & 127; }
  const int tokbase = lat ? NTOK_P + b * 4096 : b * 256;
  const int q0 = qb * 32;
  const int hq = kvh * 4 + w;
  __syncthreads();
  const int kbase = lat ? (((q0 - 128) >> 6) << 6) : 0;
  const int ntile = lat ? 9 : 4;
  bf16_t* Ks1 = Qs + 4 * 32 * AL;
  bf16_t* Vt1 = Ks1 + 64 * AL;
  const int keyk = tid >> 2, s4 = tid & 3;
  const int keyv = tid & 63, cq = tid >> 6;
  const bool wr = (!lat) && (qb == 0);
  float knw[16];
#pragma unroll
  for (int c = 0; c < 4; ++c)
#pragma unroll
    for (int i = 0; i < 4; ++i) knw[c * 4 + i] = p.in[I_KNW][e * 64 + 16 * c + 4 * s4 + i];
  float ccs[4], csn[4];
#pragma unroll
  for (int i = 0; i < 4; ++i) { ccs[i] = RT[(keyk * 16 + 4 * s4 + i) * 2]; csn[i] = RT[(keyk * 16 + 4 * s4 + i) * 2 + 1]; }
  uint4 rk0, rk1, rk2, rk3, rv0, rv1, rv2, rv3;
  float rrc[4] = {1.f, 1.f, 1.f, 1.f}, rrs[4] = {0.f, 0.f, 0.f, 0.f};
  rk0 = rk1 = rk2 = rk3 = rv0 = rv1 = rv2 = rv3 = make_uint4(0, 0, 0, 0);
  int tlo = 0, thi = ntile - 1;
  if (lat) {
    tlo = kbase < 0 ? (-kbase) >> 6 : 0;
    thi = 4;
    while (kbase + thi * 64 >= 4096) --thi;
  }
#define TILE_NEXT(ti) (lat ? ((ti) < thi ? (ti) + 1 : ((ti) < 5 ? 5 : (ti) + 1)) : (ti) + 1)
#define TILE_LOAD(ti) { \
    const bool fc_ = lat && (ti) >= 5; \
    const int kt0_ = fc_ ? ((ti) - 5) * 64 : kbase + (ti) * 64; \
    if (fc_) { \
      const float* ck = p.in[I_CK] + ((size_t)((b * 2 + e) * 2 + kvh) * 256 + kt0_ + keyk) * 64 + 4 * s4; \
      const float* cv = p.in[I_CV] + ((size_t)((b * 2 + e) * 2 + kvh) * 256 + kt0_ + keyv) * 64 + cq * 16; \
      rk0 = *(const uint4*)(ck); rk1 = *(const uint4*)(ck + 16); rk2 = *(const uint4*)(ck + 32); rk3 = *(const uint4*)(ck + 48); \
      rv0 = *(const uint4*)(cv); rv1 = *(const uint4*)(cv + 4); rv2 = *(const uint4*)(cv + 8); rv3 = *(const uint4*)(cv + 12); \
    } else { \
      const bf16_t* ksrc = P + (size_t)(tokbase + kt0_ + keyk) * LDP_O + PO_K + kvh * 64 + 4 * s4; \
      const bf16_t* vsrc = P + (size_t)(tokbase + kt0_ + keyv) * LDP_O + PO_V + kvh * 64 + cq * 16; \
      uint2 t0_ = *(const uint2*)(ksrc), t1_ = *(const uint2*)(ksrc + 16), t2_ = *(const uint2*)(ksrc + 32), t3_ = *(const uint2*)(ksrc + 48); \
      rk0.x = t0_.x; rk0.y = t0_.y; rk1.x = t1_.x; rk1.y = t1_.y; rk2.x = t2_.x; rk2.y = t2_.y; rk3.x = t3_.x; rk3.y = t3_.y; \
      rv0 = *(const uint4*)(vsrc); rv1 = *(const uint4*)(vsrc + 8); \
      if (lat) { \
        const int row_ = kt0_ >> 6; \
        _Pragma("unroll") for (int i = 0; i < 4; ++i) { rrc[i] = RT[(row_ * 16 + 4 * s4 + i) * 2]; rrs[i] = RT[(row_ * 16 + 4 * s4 + i) * 2 + 1]; } \
      } \
    } }
#define VT4(VD, W0, W1) { (VD)[0] = (bf16_t)((W0) & 0xffffu); (VD)[AL] = (bf16_t)((W0) >> 16); (VD)[2 * AL] = (bf16_t)((W1) & 0xffffu); (VD)[3 * AL] = (bf16_t)((W1) >> 16); }
#define TILE_STORE(ti, KB, VB) { \
    const bool fc_ = lat && (ti) >= 5; \
    const int kt0_ = fc_ ? ((ti) - 5) * 64 : kbase + (ti) * 64; \
    if (fc_) { \
      bf16_t* kd = (KB) + keyk * AL + 4 * s4; \
      *(uint2*)(kd) = make_uint2(pack2(__uint_as_float(rk0.x), __uint_as_float(rk0.y)), pack2(__uint_as_float(rk0.z), __uint_as_float(rk0.w))); \
      *(uint2*)(kd + 16) = make_uint2(pack2(__uint_as_float(rk1.x), __uint_as_float(rk1.y)), pack2(__uint_as_float(rk1.z), __uint_as_float(rk1.w))); \
      *(uint2*)(kd + 32) = make_uint2(pack2(__uint_as_float(rk2.x), __uint_as_float(rk2.y)), pack2(__uint_as_float(rk2.z), __uint_as_float(rk2.w))); \
      *(uint2*)(kd + 48) = make_uint2(pack2(__uint_as_float(rk3.x), __uint_as_float(rk3.y)), pack2(__uint_as_float(rk3.z), __uint_as_float(rk3.w))); \
      bf16_t* vd = (VB) + (cq * 16) * AL + keyv; \
      VT4(vd, pack2(__uint_as_float(rv0.x), __uint_as_float(rv0.y)), pack2(__uint_as_float(rv0.z), __uint_as_float(rv0.w))) \
      VT4(vd + 4 * AL, pack2(__uint_as_float(rv1.x), __uint_as_float(rv1.y)), pack2(__uint_as_float(rv1.z), __uint_as_float(rv1.w))) \
      VT4(vd + 8 * AL, pack2(__uint_as_float(rv2.x), __uint_as_float(rv2.y)), pack2(__uint_as_float(rv2.z), __uint_as_float(rv2.w))) \
      VT4(vd + 12 * AL, pack2(__uint_as_float(rv3.x), __uint_as_float(rv3.y)), pack2(__uint_as_float(rv3.z), __uint_as_float(rv3.w))) \
    } else { \
      float x[4][4]; \
      const unsigned kw[8] = {rk0.x, rk0.y, rk1.x, rk1.y, rk2.x, rk2.y, rk3.x, rk3.y}; \
      _Pragma("unroll") for (int c = 0; c < 4; ++c) { \
        x[c][0] = __uint_as_float(kw[2 * c] << 16); x[c][1] = __uint_as_float(kw[2 * c] & 0xffff0000u); \
        x[c][2] = __uint_as_float(kw[2 * c + 1] << 16); x[c][3] = __uint_as_float(kw[2 * c + 1] & 0xffff0000u); } \
      float ss = 0.f; \
      _Pragma("unroll") for (int c = 0; c < 4; ++c) _Pragma("unroll") for (int i = 0; i < 4; ++i) ss += x[c][i] * x[c][i]; \
      ss += __shfl_xor(ss, 1); ss += __shfl_xor(ss, 2); \
      const float rstd = rsqrtf(ss * (1.f / 64.f) + EPSF); \
      _Pragma("unroll") for (int c = 0; c < 4; ++c) _Pragma("unroll") for (int i = 0; i < 4; ++i) x[c][i] *= rstd * knw[c * 4 + i]; \
      if (lat) { \
        _Pragma("unroll") for (int i = 0; i < 4; ++i) { \
          float x1 = x[0][i], x2 = x[1][i]; x[0][i] = x1 * rrc[i] - x2 * rrs[i]; x[1][i] = x2 * rrc[i] + x1 * rrs[i]; \
          x1 = x[2][i]; x2 = x[3][i]; x[2][i] = x1 * ccs[i] - x2 * csn[i]; x[3][i] = x2 * ccs[i] + x1 * csn[i]; } \
      } \
      bf16_t* kd = (KB) + keyk * AL + 4 * s4; \
      _Pragma("unroll") for (int c = 0; c < 4; ++c) *(uint2*)(kd + 16 * c) = make_uint2(pack2(x[c][0], x[c][1]), pack2(x[c][2], x[c][3])); \
      if (wr) { \
        float* fd = p.out + OUT_CK + ((size_t)((b * 2 + e) * 2 + kvh) * 256 + kt0_ + keyk) * 64 + 4 * s4; \
        _Pragma("unroll") for (int c = 0; c < 4; ++c) *(float4*)(fd + 16 * c) = make_float4(x[c][0], x[c][1], x[c][2], x[c][3]); \
        float* fv = p.out + OUT_CV + ((size_t)((b * 2 + e) * 2 + kvh) * 256 + kt0_ + keyv) * 64 + cq * 16; \
        *(float4*)(fv) = make_float4(__uint_as_float(rv0.x << 16), __uint_as_float(rv0.x & 0xffff0000u), __uint_as_float(rv0.y << 16), __uint_as_float(rv0.y & 0xffff0000u)); \
        *(float4*)(fv + 4) = make_float4(__uint_as_float(rv0.z << 16), __uint_as_float(rv0.z & 0xffff0000u), __uint_as_float(rv0.w << 16), __uint_as_float(rv0.w & 0xffff0000u)); \
        *(float4*)(fv + 8) = make_float4(__uint_as_float(rv1.x << 16), __uint_as_float(rv1.x & 0xffff0000u), __uint_as_float(rv1.y << 16), __uint_as_float(rv1.y & 0xffff0000u)); \
        *(float4*)(fv + 12) = make_float4(__uint_as_float(rv1.z << 16), __uint_as_float(rv1.z & 0xffff0000u), __uint_as_float(rv1.w << 16), __uint_as_float(rv1.w & 0xffff0000u)); \
      } \
      bf16_t* vd = (VB) + (cq * 16) * AL + keyv; \
      VT4(vd, rv0.x, rv0.y) VT4(vd + 4 * AL, rv0.z, rv0.w) VT4(vd + 8 * AL, rv1.x, rv1.y) VT4(vd + 12 * AL, rv1.z, rv1.w) \
    } }
  int cur = 0;
  TILE_LOAD(tlo)
  uint2 zq[2][4];
#pragma unroll
  for (int dvt = 0; dvt < 2; ++dvt)
#pragma unroll
    for (int g4 = 0; g4 < 4; ++g4)
      zq[dvt][g4] = *(const uint2*)(P + (size_t)(tokbase + q0 + r) * LDP_O + PO_ZA + hq * 64 + dvt * 32 + 8 * g4 + 4 * h);
  {
    const int qi = lane >> 1, sub = lane & 1;
    const bf16_t* src = P + (size_t)(tokbase + q0 + qi) * LDP_O + PO_Q + hq * 64;
    qk_prep<8>(src, p.in[I_QNW] + e * 64, lat, q0 + qi, 0.125f, sub, RT, Qs + (w * 32 + qi) * AL, nullptr);
  }
  __syncthreads();
  bf16x8 qf[4];
#pragma unroll
  for (int ks = 0; ks < 4; ++ks) qf[ks] = *(const bf16x8*)(Qs + (w * 32 + r) * AL + ks * 16 + h * 8);
  float m_run = p.in[I_SINK][e * 8 + hq];
  float l_run = 1.f;
  f32x16 o[2];
  o[0] = zero16(); o[1] = zero16();
  TILE_STORE(tlo, Ks, Vt)
  __syncthreads();
  for (int ti = tlo; ti < ntile;) {
    const bool fromcache = lat && ti >= 5;
    const int kt0 = fromcache ? (ti - 5) * 64 : kbase + ti * 64;
    const int tn = TILE_NEXT(ti);
    if (tn < ntile) { TILE_LOAD(tn) }
    const bf16_t* Kc = cur ? Ks1 : Ks;
    const bf16_t* Vc = cur ? Vt1 : Vt;
    f32x16 s[2];
#pragma unroll
    for (int mt = 0; mt < 2; ++mt) {
      s[mt] = zero16();
#pragma unroll
      for (int ks = 0; ks < 4; ++ks) {
        bf16x8 a = *(const bf16x8*)(Kc + (mt * 32 + r) * AL + ks * 16 + h * 8);
        s[mt] = mfma(a, qf[ks], s[mt]);
      }
    }
    if (lat && !fromcache) {
      const int qpos = q0 + r;
#pragma unroll
      for (int mt = 0; mt < 2; ++mt)
#pragma unroll
        for (int q = 0; q < 16; ++q) {
          int kpos = kt0 + mt * 32 + crow(q, h);
          int dd = kpos - qpos;
          if (dd > 128 || dd < -128) s[mt][q] = -1e30f;
        }
    }
    float mx = -3e38f;
#pragma unroll
    for (int mt = 0; mt < 2; ++mt)
#pragma unroll
      for (int q = 0; q < 16; ++q) mx = fmaxf(mx, s[mt][q]);
    mx = fmaxf(mx, __shfl_xor(mx, 32));
    const float m_new = fmaxf(m_run, mx);
    const float alpha = __expf(m_run - m_new);
    float rs = 0.f;
#pragma unroll
    for (int mt = 0; mt < 2; ++mt)
#pragma unroll
      for (int q = 0; q < 16; ++q) { float pv = __expf(s[mt][q] - m_new); s[mt][q] = pv; rs += pv; }
    rs += __shfl_xor(rs, 32);
    l_run = l_run * alpha + rs;
    m_run = m_new;
#pragma unroll
    for (int q = 0; q < 16; ++q) { o[0][q] *= alpha; o[1][q] *= alpha; }
#pragma unroll
    for (int mt = 0; mt < 2; ++mt)
#pragma unroll
      for (int sx = 0; sx < 2; ++sx) {
        bf16x8 pf;
#pragma unroll
        for (int j = 0; j < 8; ++j) pf[j] = (short)f2bf(s[mt][8 * sx + j]);
#pragma unroll
        for (int dvt = 0; dvt < 2; ++dvt) {
          const bf16_t* vp = Vc + (dvt * 32 + r) * AL + mt * 32 + 16 * sx + 4 * h;
          s16x4 lo = *(const s16x4*)vp;
          s16x4 hi4 = *(const s16x4*)(vp + 8);
          bf16x8 a = __builtin_shufflevector(lo, hi4, 0, 1, 2, 3, 4, 5, 6, 7);
          o[dvt] = mfma(a, pf, o[dvt]);
        }
      }
      if (tn < ntile) {
      if (cur) { TILE_STORE(tn, Ks, Vt) } else { TILE_STORE(tn, Ks1, Vt1) }
    }
    __syncthreads();
    ti = tn;
    cur ^= 1;
  }
#undef TILE_NEXT
#undef TILE_LOAD
#undef TILE_STORE
#undef VT4
  const float inv = 1.f / l_run;
  const int tok = tokbase + q0 + r;
#pragma unroll
  for (int dvt = 0; dvt < 2; ++dvt)
#pragma unroll
    for (int g4 = 0; g4 < 4; ++g4) {
      const int dv = dvt * 32 + 8 * g4 + 4 * h;
      uint2 zz = zq[dvt][g4];
      float z0 = __uint_as_float(zz.x << 16), z1 = __uint_as_float(zz.x & 0xffff0000u);
      float z2 = __uint_as_float(zz.y << 16), z3 = __uint_as_float(zz.y & 0xffff0000u);
      float y0 = o[dvt][4 * g4 + 0] * inv * siluf(z0);
      float y1 = o[dvt][4 * g4 + 1] * inv * siluf(z1);
      float y2 = o[dvt][4 * g4 + 2] * inv * siluf(z2);
      float y3 = o[dvt][4 * g4 + 3] * inv * siluf(z3);
      *(uint2*)(Y + (size_t)tok * DM + hq * 64 + dv) = make_uint2(pack2(y0, y1), pack2(y2, y3));
    }
}

DI void conv_unit(const Params& p, int e, int u) {
  const int tid = otid();
  const bf16_t* P = (const bf16_t*)(p.ws + OFF_P);
  bf16_t* Y = (bf16_t*)(p.ws + OFF_HY);
  const int t0 = u * 16;
  const int c = tid * 2;
  int seg0, seg1;
  if (t0 < NTOK_P) { seg0 = t0 & ~255; seg1 = seg0 + 256; }
  else { seg0 = NTOK_P + ((t0 - NTOK_P) & ~4095); seg1 = seg0 + 4096; }
  const float* cw = p.in[I_CONVW] + (size_t)e * 3 * 512;
  const float w00 = cw[c], w01 = cw[c + 1], w10 = cw[512 + c], w11 = cw[512 + c + 1], w20 = cw[1024 + c], w21 = cw[1024 + c + 1];
  const float b0 = p.in[I_CONVB][e * 512 + c], b1 = p.in[I_CONVB][e * 512 + c + 1];
  auto prod = [&](int t, float& a, float& b) {
    if (t < seg0 || t >= seg1) { a = 0.f; b = 0.f; return; }
    unsigned xc = *(const unsigned*)(P + (size_t)t * LDP_O + PO_XC + c);
    unsigned cg_ = *(const unsigned*)(P + (size_t)t * LDP_O + PO_CG + c);
    a = __uint_as_float(xc << 16) * __uint_as_float(cg_ << 16);
    b = __uint_as_float(xc & 0xffff0000u) * __uint_as_float(cg_ & 0xffff0000u);
  };
  float pa0, pa1, pb0, pb1, pc0, pc1;
  prod(t0 - 1, pa0, pa1);
  prod(t0, pb0, pb1);
#pragma unroll
  for (int i = 0; i < 16; ++i) {
    const int t = t0 + i;
    prod(t + 1, pc0, pc1);
    unsigned bg = *(const unsigned*)(P + (size_t)t * LDP_O + PO_BG + c);
    unsigned zc = *(const unsigned*)(P + (size_t)t * LDP_O + PO_ZC + c);
    float y0 = __uint_as_float(bg << 16) * (w00 * pa0 + w10 * pb0 + w20 * pc0 + b0) * siluf(__uint_as_float(zc << 16));
    float y1 = __uint_as_float(bg & 0xffff0000u) * (w01 * pa1 + w11 * pb1 + w21 * pc1 + b1) * siluf(__uint_as_float(zc & 0xffff0000u));
    *(unsigned*)(Y + (size_t)t * DM + 512 + c) = pack2(y0, y1);
    pa0 = pb0; pa1 = pb1; pb0 = pc0; pb1 = pc1;
  }
}


#define QCTR(l, ph) ((unsigned*)(p.ws + OFF_BAR) + 3584 + 16 * ((l) * 4 + (ph)))
DI int next_unit(unsigned* ctr, volatile int* sh) {
  __syncthreads();
  if (threadIdx.x == 0) *sh = (int)atomicAdd(ctr, 1u);
  __syncthreads();
  return *sh;
}
#ifndef REP_A
#define REP_A 1
#endif
#ifndef REP_INPROJ
#define REP_INPROJ 1
#endif
#ifndef REP_EVEN
#define REP_EVEN 1
#endif
#ifndef REP_ODD
#define REP_ODD 1
#endif
#define REP_G1 1
#define REP_S1 1
#define REP_G3 1
#define REP_S3 1
#ifndef REP_SYNC
#define REP_SYNC 1
#endif
#define GSYNC() do { _Pragma("unroll 1") for (int rs_ = 0; rs_ < REP_SYNC; ++rs_) xcd_barrier(xb); } while (0)
__global__ void __launch_bounds__(256, 2) fwd_megakernel(Params p) {
  cg::grid_group grid = cg::this_grid();
  __shared__ __attribute__((aligned(16))) char smem[SMEM_BYTES];
  __shared__ uint4 xb_words;
  __shared__ int qsh;
  if (threadIdx.x == 0) xb_words = make_uint4(0u, 0u, 0u, 0u);
  __syncthreads();
  XcdBarrier xb = xcd_barrier_post((unsigned*)(p.ws + OFF_BAR), (volatile LAS unsigned*)&xb_words);
  if (p.ws == nullptr) grid.sync();
  phase0(p, smem);
  GSYNC();
#pragma unroll 1
  for (int l = 0; l < 4; ++l) {
    const int e = l >> 1;
#pragma unroll 1
    for (int rep = 0; rep < REP_A; ++rep) {
      phaseA(p, l);
      GSYNC();
    }
    const int odd = l & 1;
#pragma unroll 1
    for (int rep = 0; rep < REP_INPROJ; ++rep) {
      gemm_phase<EPI_P, 16>(p, l, (const bf16_t*)(p.ws + OFF_HY), DM, (const bf16_t*)(p.ws + OFF_WIN), DM, odd ? LDP_O / 128 : LDP_E / 128, odd ? LDP_O : LDP_E, smem);
      GSYNC();
    }
    if (!odd) {
#pragma unroll 1
      for (int rep = 0; rep < REP_EVEN; ++rep) {
        if (blockIdx.x >= (gridDim.x >> 1)) { __builtin_amdgcn_s_sleep(127); __builtin_amdgcn_s_sleep(127); }
        for (int u = next_unit(QCTR(l, 0), &qsh); u < 512 + 512; u = next_unit(QCTR(l, 0), &qsh)) {
          if (u < 512) { _Pragma("unroll 1") for (int r2 = 0; r2 < REP_G1; ++r2) gla_pass1_unit(p, e, u, smem); }
          else { _Pragma("unroll 1") for (int r2 = 0; r2 < REP_S1; ++r2) s5_pass1_unit(p, e, u - 512, smem); }
        }
        GSYNC();
        if (blockIdx.x >= (gridDim.x >> 1)) { __builtin_amdgcn_s_sleep(127); __builtin_amdgcn_s_sleep(127); }
        for (int u = next_unit(QCTR(l, 1), &qsh); u < 384 + 768; u = next_unit(QCTR(l, 1), &qsh)) {
          if (u < 384) { _Pragma("unroll 1") for (int r2 = 0; r2 < REP_G3; ++r2) gla_pass3_unit(p, e, u, smem); }
          else { _Pragma("unroll 1") for (int r2 = 0; r2 < REP_S3; ++r2) s5_pass3_unit(p, e, u - 384, smem); }
        }
        GSYNC();
        gemm_phase<EPI_GLU, 8>(p, l, (const bf16_t*)(p.ws + OFF_Z5), 512, (const bf16_t*)(p.ws + OFF_WGLU), 512, 4, 0, smem);
        GSYNC();
      }
    } else {
#pragma unroll 1
      for (int rep = 0; rep < REP_ODD; ++rep) {
        if (blockIdx.x >= (gridDim.x >> 1)) { __builtin_amdgcn_s_sleep(127); __builtin_amdgcn_s_sleep(127); }
        for (int u = next_unit(QCTR(l, 2), &qsh); u < 1536 + 1536; u = next_unit(QCTR(l, 2), &qsh)) {
          if (u < 1024) attn_unit(p, e, u + 512, smem);
          else if (u < 1536) attn_unit(p, e, u - 1024, smem);
          else conv_unit(p, e, u - 1536);
        }
        GSYNC();
      }
    }
    gemm_phase<EPI_RES, 16>(p, l, (const bf16_t*)(p.ws + OFF_HY), DM, (const bf16_t*)(p.ws + OFF_WOUT), DM, 8, 0, smem);
    if (l < 3) GSYNC();
  }
}

extern "C" void kernel_launch(void* const* d_in, const int* in_sizes, int n_in, void* d_out, int out_size,
                              void* d_ws, size_t ws_size, hipStream_t stream) {
  static int grid_blocks = 0;
  if (!grid_blocks) {
    int dev = 0, cus = 0, per_cu = 0;
    hipGetDevice(&dev);
    hipDeviceGetAttribute(&cus, hipDeviceAttributeMultiprocessorCount, dev);
    hipOccupancyMaxActiveBlocksPerMultiprocessor(&per_cu, fwd_megakernel, 256, 0);
    if (per_cu > 2) per_cu = 2;
    if (per_cu < 1) per_cu = 1;
    grid_blocks = cus * per_cu;
  }
  if (ws_size < WS_NEED || n_in < 34) { fprintf(stderr, "workspace too small\n"); return; }
  Params p{};
  for (int i = 0; i < 34; ++i) p.in[i] = (const float*)d_in[i];
  p.out = (float*)d_out;
  p.ws = (char*)d_ws;
  (void)hipMemsetAsync((char*)d_ws + OFF_BAR, 0, 16384, stream);
  void* args[] = {&p};
  hipError_t err = hipLaunchCooperativeKernel((void*)fwd_megakernel, dim3(grid_blocks), dim3(256), args, 0, stream);
  if (err != hipSuccess) fprintf(stderr, "cooperative launch failed: %s (grid %d)\n", hipGetErrorString(err), grid_blocks);
}
```
